# Optimizing an MI355X kernel written in HIP

```python
import math
import jax, jax.numpy as jnp
from jax import lax
import numpy as np

D_MODEL = 1024
BATCH = 16
SEQ = 2048
DEPTH = 1
DEC_BATCH = 128
DEC_SEQ = 8
PAST_LEN = 8192
PAGE_SIZE = 128

N_META = 16
N_HEADS = 8
QK_NOPE = 64
QK_ROPE = 32
QK_HEAD = QK_NOPE + QK_ROPE
V_HEAD = D_MODEL // N_HEADS
Q_LORA = 3 * D_MODEL // 8
KV_LORA = D_MODEL // 4
POOL_WIDTH = D_MODEL // 2
POOL_WINDOWS = (2, 4, 8, 16)
POOL_GROUPS = len(POOL_WINDOWS)
POOL_GROUP_WIDTH = POOL_WIDTH // POOL_GROUPS
POOL_GROUP_OUT = D_MODEL // POOL_GROUPS
POOL_STATE = max(POOL_WINDOWS) - 1
D_FF = 4 * D_MODEL
ROPE_BASE = 10000.0
EPS = 1e-6
Q_BLOCK = 128
SCALE = QK_HEAD ** -0.5
IN_WIDTHS = (POOL_WIDTH, Q_LORA, KV_LORA, QK_ROPE, 2 * D_MODEL)
D_IN = sum(IN_WIDTHS)
IN_SPLITS = tuple(int(s) for s in np.cumsum(IN_WIDTHS)[:-1])

kernel_name = "hybrid_pool_mla_decoder_step"


def rms_norm(x, g):
    xf = x.astype(jnp.float32)
    y = xf * lax.rsqrt(jnp.mean(xf * xf, axis=-1, keepdims=True) + EPS)
    return (y * g.astype(jnp.float32)).astype(x.dtype)


def head_gain(g_nope, g_rope_pair):
    return jnp.concatenate([g_nope, g_rope_pair, g_rope_pair])


def rope_tables(pos):
    inv = ROPE_BASE ** (-jnp.arange(0, QK_ROPE, 2, dtype=jnp.float32) / QK_ROPE)
    ang = pos.astype(jnp.float32)[:, None] * inv[None, :]
    cos = jnp.concatenate([jnp.cos(ang), jnp.cos(ang)], axis=-1)
    sin = jnp.concatenate([jnp.sin(ang), jnp.sin(ang)], axis=-1)
    return cos, sin


def apply_rope(x, cos, sin):
    xf = x.astype(jnp.float32)
    x1, x2 = xf[..., :QK_ROPE // 2], xf[..., QK_ROPE // 2:]
    rot = jnp.concatenate([-x2, x1], axis=-1)
    return (xf * cos + rot * sin).astype(x.dtype)


def mixer_inputs(xn, pos, w_in, g_q_lat, w_uq, g_kv_lat, g_qn_nope, g_qn_rope):
    proj = xn @ w_in
    u_pool, q_lat, c_kv, k_r, gate_logits = jnp.split(proj, IN_SPLITS, axis=-1)
    cos, sin = rope_tables(pos)
    q = rms_norm(q_lat, g_q_lat) @ w_uq
    q = q.reshape(*xn.shape[:-1], N_HEADS, QK_HEAD)
    q = jnp.concatenate([q[..., :QK_NOPE], apply_rope(q[..., QK_NOPE:], cos[:, None, :], sin[:, None, :])], axis=-1)
    q = rms_norm(q, head_gain(g_qn_nope, g_qn_rope))
    c_kv = rms_norm(c_kv, g_kv_lat)
    k_r = apply_rope(k_r, cos, sin)
    return u_pool, q, c_kv, k_r, gate_logits


def mla_keys(c_kv, k_r, w_uk, g_kn_nope, g_kn_rope):
    k_nope = jnp.einsum('...tr,rhd->...thd', c_kv, w_uk)
    k_rope = jnp.broadcast_to(k_r[..., None, :], k_nope.shape[:-1] + (QK_ROPE,))
    k = jnp.concatenate([k_nope, k_rope], axis=-1)
    return rms_norm(k, head_gain(g_kn_nope, g_kn_rope))


def prompt_attention(q, c_kv, k_r, w_uk, w_uv, g_kn_nope, g_kn_rope):
    B, T = q.shape[0], q.shape[1]
    k = mla_keys(c_kv, k_r, w_uk, g_kn_nope, g_kn_rope)
    v = jnp.einsum('btr,rhv->bthv', c_kv, w_uv)
    n_blk = -(-T // Q_BLOCK)
    pad = n_blk * Q_BLOCK - T
    qb = jnp.pad(q, ((0, 0), (0, pad), (0, 0), (0, 0)))
    qb = qb.reshape(B, n_blk, Q_BLOCK, N_HEADS, QK_HEAD).transpose(1, 0, 2, 3, 4)
    k_pos = jnp.arange(T)

    def block(args):
        qi, blk = args
        q_pos = blk * Q_BLOCK + jnp.arange(Q_BLOCK)
        s = jnp.einsum('bqhd,bkhd->bhqk', qi, k, preferred_element_type=jnp.float32) * SCALE
        s = jnp.where(k_pos[None, :] <= q_pos[:, None], s, -jnp.inf)
        p = jax.nn.softmax(s, axis=-1).astype(v.dtype)
        return jnp.einsum('bhqk,bkhv->bqhv', p, v)

    o = lax.map(block, (qb, jnp.arange(n_blk)))
    o = o.transpose(1, 0, 2, 3, 4).reshape(B, n_blk * Q_BLOCK, N_HEADS * V_HEAD)
    return o[:, :T]


def sample_attention(q, c_new, kr_new, cache_kv_latent, cache_k_rope, page_table,
                     w_uk, w_uv, g_kn_nope, g_kn_rope):
    past = page_table.shape[1] * PAGE_SIZE
    S = q.shape[1]
    k_pos = jnp.arange(past + S)
    q_pos = past + jnp.arange(S)
    mask = k_pos[None, :] <= q_pos[:, None]

    def one_seq(args):
        pt, qi, ci, kri = args
        c_all = jnp.concatenate([cache_kv_latent[pt].reshape(past, KV_LORA).astype(ci.dtype), ci], axis=0)
        kr_all = jnp.concatenate([cache_k_rope[pt].reshape(past, QK_ROPE).astype(kri.dtype), kri], axis=0)
        k = mla_keys(c_all, kr_all, w_uk, g_kn_nope, g_kn_rope)
        s = jnp.einsum('qhd,khd->hqk', qi, k, preferred_element_type=jnp.float32) * SCALE
        s = jnp.where(mask[None], s, -jnp.inf)
        p = jax.nn.softmax(s, axis=-1).astype(c_all.dtype)
        ctx = jnp.einsum('hqk,kr->qhr', p, c_all)
        return jnp.einsum('qhr,rhv->qhv', ctx, w_uv).reshape(S, N_HEADS * V_HEAD)

    return lax.map(one_seq, (page_table, q, c_new, kr_new))


def pool_mixer(u, prefix, pos, w_pool_map, pool_scale):
    B, T = u.shape[0], u.shape[1]
    full = jnp.concatenate([prefix, u], axis=1).astype(jnp.float32)
    cs = jnp.concatenate([jnp.zeros((B, 1, POOL_WIDTH), jnp.float32), jnp.cumsum(full, axis=1)], axis=1)
    start = POOL_STATE + 1
    means = []
    for g, w in enumerate(POOL_WINDOWS):
        c0, c1 = g * POOL_GROUP_WIDTH, (g + 1) * POOL_GROUP_WIDTH
        win = cs[:, start:start + T, c0:c1] - cs[:, start - w:start - w + T, c0:c1]
        cnt = jnp.minimum(w, pos + 1).astype(jnp.float32)[None, :, None]
        means.append(win / cnt)
    d = (jnp.concatenate(means, axis=-1) - u.astype(jnp.float32)).astype(u.dtype)
    d = d.reshape(B, T, POOL_GROUPS, POOL_GROUP_WIDTH)
    out = jnp.einsum('btgc,gcd->btgd', d, w_pool_map).reshape(B, T, D_MODEL)
    return out * pool_scale


def merge_and_mlp(x, pool_out, attn_out, gate_logits, w_o, g_mlp, w_ff1, w_ff2):
    g = jax.nn.sigmoid(gate_logits.astype(jnp.float32)).astype(x.dtype)
    g_pool, g_att = g[..., :D_MODEL], g[..., D_MODEL:]
    h = x + (g_pool * pool_out + g_att * attn_out) @ w_o
    z = jax.nn.relu(rms_norm(h, g_mlp) @ w_ff1)
    return h + (z * z) @ w_ff2


def setup_inputs(seed: int = 0) -> dict:
    key = jax.random.key(seed)
    ks = jax.random.split(key, 26)
    n_pages = PAST_LEN // PAGE_SIZE
    n_used = DEC_BATCH * n_pages
    n_phys = n_used + n_used // 4
    f32 = jnp.float32

    def nrm(k, shape, scale):
        return jax.random.normal(k, shape, f32) * scale

    def gain(k, n):
        return 1.0 + 0.1 * jax.random.normal(k, (n,), f32)

    page_table = jax.random.permutation(ks[5], n_phys)[:n_used].reshape(DEC_BATCH, n_pages).astype(jnp.int32)
    return {
        "x_prompt": nrm(ks[0], (BATCH, SEQ, D_MODEL), 1.0),
        "x_sample": nrm(ks[1], (DEC_BATCH, DEC_SEQ, D_MODEL), 1.0),
        "cache_kv_latent": nrm(ks[2], (n_phys, PAGE_SIZE, KV_LORA), 1.0),
        "cache_k_rope": nrm(ks[3], (n_phys, PAGE_SIZE, QK_ROPE), 1.0),
        "state_pool": nrm(ks[4], (DEC_BATCH, POOL_STATE, POOL_WIDTH), 1.0),
        "page_table": page_table,
        "meta_tokens": nrm(ks[6], (N_META, D_MODEL), 1.0),
        "g_attn": gain(ks[7], D_MODEL),
        "w_in": nrm(ks[8], (D_MODEL, D_IN), D_MODEL ** -0.5),
        "g_q_lat": gain(ks[9], Q_LORA),
        "w_uq": nrm(ks[10], (Q_LORA, N_HEADS * QK_HEAD), Q_LORA ** -0.5),
        "g_kv_lat": gain(ks[11], KV_LORA),
        "g_qn_nope": gain(ks[12], QK_NOPE),
        "g_qn_rope": gain(ks[13], QK_ROPE // 2),
        "w_uk": nrm(ks[14], (KV_LORA, N_HEADS, QK_NOPE), KV_LORA ** -0.5),
        "g_kn_nope": gain(ks[15], QK_NOPE),
        "g_kn_rope": gain(ks[16], QK_ROPE // 2),
        "w_uv": nrm(ks[17], (KV_LORA, N_HEADS, V_HEAD), KV_LORA ** -0.5),
        "w_pool_map": nrm(ks[18], (POOL_GROUPS, POOL_GROUP_WIDTH, POOL_GROUP_OUT), POOL_GROUP_WIDTH ** -0.5),
        "pool_scale": gain(ks[19], D_MODEL),
        "w_o": nrm(ks[20], (D_MODEL, D_MODEL), D_MODEL ** -0.5),
        "g_mlp": gain(ks[21], D_MODEL),
        "w_ff1": nrm(ks[22], (D_MODEL, D_FF), D_MODEL ** -0.5),
        "w_ff2": nrm(ks[23], (D_FF, D_MODEL), D_FF ** -0.5),
    }


def reference(x_prompt, x_sample, cache_kv_latent, cache_k_rope, state_pool, page_table,
              meta_tokens, g_attn, w_in, g_q_lat, w_uq, g_kv_lat, g_qn_nope, g_qn_rope,
              w_uk, g_kn_nope, g_kn_rope, w_uv, w_pool_map, pool_scale, w_o, g_mlp, w_ff1, w_ff2):
    B = x_prompt.shape[0]
    meta = jnp.broadcast_to(meta_tokens.astype(x_prompt.dtype)[None], (B, N_META, D_MODEL))
    xp = jnp.concatenate([meta, x_prompt], axis=1)
    T = xp.shape[1]
    pos_p = jnp.arange(T)
    xn_p = rms_norm(xp, g_attn)
    u_p, q_p, c_p, kr_p, gl_p = mixer_inputs(xn_p, pos_p, w_in, g_q_lat, w_uq, g_kv_lat, g_qn_nope, g_qn_rope)
    pool_p = pool_mixer(u_p, jnp.zeros((B, POOL_STATE, POOL_WIDTH), u_p.dtype), pos_p, w_pool_map, pool_scale)
    att_p = prompt_attention(q_p, c_p, kr_p, w_uk, w_uv, g_kn_nope, g_kn_rope)
    y_full = merge_and_mlp(xp, pool_p, att_p, gl_p, w_o, g_mlp, w_ff1, w_ff2)
    y_prompt = y_full[:, N_META:]
    pool_state_prompt = u_p[:, T - POOL_STATE:]

    past = page_table.shape[1] * PAGE_SIZE
    S = x_sample.shape[1]
    pos_s = past + jnp.arange(S)
    xn_s = rms_norm(x_sample, g_attn)
    u_s, q_s, c_s, kr_s, gl_s = mixer_inputs(xn_s, pos_s, w_in, g_q_lat, w_uq, g_kv_lat, g_qn_nope, g_qn_rope)
    prefix = state_pool.astype(u_s.dtype)
    pool_s = pool_mixer(u_s, prefix, pos_s, w_pool_map, pool_scale)
    att_s = sample_attention(q_s, c_s, kr_s, cache_kv_latent, cache_k_rope, page_table,
                             w_uk, w_uv, g_kn_nope, g_kn_rope)
    y_sample = merge_and_mlp(x_sample, pool_s, att_s, gl_s, w_o, g_mlp, w_ff1, w_ff2)
    pool_state_sample = jnp.concatenate([prefix, u_s], axis=1)[:, -POOL_STATE:]

    return (y_prompt, y_sample, c_p, kr_p, pool_state_prompt, c_s, kr_s, pool_state_sample)
```

```cpp
#include <hip/hip_runtime.h>
#include <cstdio>
#include <cstdint>
#define USE_PG8 1
namespace pg8 {
#define PG8_LAS __attribute__((address_space(3)))
typedef unsigned short bf16_t;
typedef short bf16x8 __attribute__((ext_vector_type(8)));
typedef float f32x4 __attribute__((ext_vector_type(4)));
typedef unsigned u32x4 __attribute__((ext_vector_type(4)));
constexpr int BM = 256, BK = 64, HALF = 128, HTB = HALF * BK * 2  , STAGE_BYTES = 8 * HTB, NXCD = 8, WGM = 8;

__host__ __device__ __forceinline__ int lds_byte(int r, int c) { const int st = (r >> 4) * 2 + (c >> 5), rr = r & 15, cc = c & 31, ob = rr * 64 + cc * 2; return st * 1024 + (ob ^ (((ob >> 9) & 1) << 5)); }
__host__ __device__ __forceinline__ void stage_rc(int b, int& R, int& C) { const int st = b / 1024, sb = b % 1024, swz = sb ^ (((sb >> 9) & 1) << 5); R = (st >> 1) * 16 + swz / 64; C = (st & 1) * 32 + (swz % 64) / 2; }
__host__ __device__ __forceinline__ int perm32(int rho) { const int n = rho >> 4, i = rho & 15; return 8 * (i >> 2) + 4 * n + (i & 3); }

struct Unit { int pm, pn; };
struct Gemm { const bf16_t* A; const bf16_t* Bt; int M, N, K; };

struct StaticOrder {
    int nM, nN, nwg, G, c;
    __host__ __device__ void init(int M, int N, int G_, int c_) { nM = M / BM; nN = N / BM; nwg = nM * nN; G = G_; c = c_; }
    __host__ __device__ bool next(int i, Unit& u) const {
        const long L = (long)i * G + c; if (L >= nwg) return false;
        int wgid = (int)L; { const int q = nwg / NXCD, r = nwg % NXCD, xcd = wgid % NXCD, off = wgid / NXCD; wgid = (xcd < r ? xcd * (q + 1) : r * (q + 1) + (xcd - r) * q) + off; }
        const int nig = WGM * nN, gid = wgid / nig, fm = gid * WGM, gsz = (nM - fm) < WGM ? (nM - fm) : WGM;
        u.pm = fm + ((wgid % nig) % gsz); u.pn = (wgid % nig) / gsz; return true;
    }
    __device__ __forceinline__ void a_ready(const Unit&) const {}
    __device__ __forceinline__ void done(const Unit&) const {}
};

template <class Epi, class Sched, bool ALIGN_EPI = false, bool SP2 = false>
__device__ __forceinline__ void gemm_phase(PG8_LAS unsigned char* lds, const Gemm g, const Sched& S, const Epi& E) {
    const int tid = threadIdx.x, wid = __builtin_amdgcn_readfirstlane(tid >> 6), lane = tid & 63, wr = wid >> 2, wc = wid & 3, fr = lane & 15, fq = lane >> 4;
    const int K = g.K, nt = K / BK;
    unsigned voffA[2], voffB[2];
#pragma unroll
    for (int i = 0; i < 2; ++i) { int R, C; stage_rc(tid * 16 + i * 8192, R, C); const int Rb = Epi::PERM ? ((R & ~31) + perm32(R & 31)) : R;
        voffA[i] = (unsigned)(R * K + C) * 2u; voffB[i] = (unsigned)(Rb * K + C) * 2u; }
    const size_t kstep = (size_t)(BK * 2);
    const size_t hstep = (size_t)HALF * K * 2;
    const size_t tstep = 2 * hstep;
    const unsigned ldsw = (unsigned)wid * 1024u;
    const int aoff = lds_byte(wr * 64 + fr, fq * 8), boff = lds_byte(wc * 32 + fr, fq * 8);
#define PG8_SA(b, h) (((b) * 2 + (h)) * HTB)
#define PG8_SB(b, h) ((4 + (b) * 2 + (h)) * HTB)
#define PG8_STAGE(bufoff, gbase, voff) do { _Pragma("unroll") for (int _i = 0; _i < 2; ++_i) \
        __builtin_amdgcn_global_load_lds((const unsigned*)((const char*)(gbase) + (voff)[_i]), (PG8_LAS unsigned*)(lds + (bufoff) + ldsw + _i * 8192), 16, 0, 0); } while (0)
#define PG8_LDA(dst, b, h) do { _Pragma("unroll") for (int m = 0; m < 4; ++m) _Pragma("unroll") for (int k = 0; k < 2; ++k) dst[m][k] = *(const PG8_LAS bf16x8*)(lds + PG8_SA(b, h) + aoff + m * 2048 + k * 1024); } while (0)
#define PG8_LDB(dst, b, h) do { _Pragma("unroll") for (int n = 0; n < 2; ++n) _Pragma("unroll") for (int k = 0; k < 2; ++k) dst[n][k] = *(const PG8_LAS bf16x8*)(lds + PG8_SB(b, h) + boff + n * 2048 + k * 1024); } while (0)
#define PG8_MMA(ai, bj, At, Bt) do { __builtin_amdgcn_s_setprio(1); _Pragma("unroll") for (int m = 0; m < 4; ++m) _Pragma("unroll") for (int n = 0; n < 2; ++n) _Pragma("unroll") for (int k = 0; k < 2; ++k) \
        acc[ai][bj][m][n] = __builtin_amdgcn_mfma_f32_16x16x32_bf16(Bt[n][k], At[m][k], acc[ai][bj][m][n], 0, 0, 0); __builtin_amdgcn_s_setprio(0); } while (0)
#ifdef SAFE_WAITS
#define PG8_WAIT_V(n) asm volatile("s_waitcnt vmcnt(0)" ::: "memory")
#else
#define PG8_WAIT_V(n) asm volatile("s_waitcnt vmcnt(" #n ")" ::: "memory")
#endif
#define PG8_WAIT_L(n) asm volatile("s_waitcnt lgkmcnt(" #n ")" ::: "memory")
#define PG8_BAR __builtin_amdgcn_s_barrier()
#define PG8_SCHED __builtin_amdgcn_sched_barrier(0)
    Unit cur, nxt; int ui = 0;
    if (!S.next(0, cur)) return;
    f32x4 acc[2][2][4][2];
#pragma unroll
    for (int a = 0; a < 2; ++a)
#pragma unroll
        for (int b = 0; b < 2; ++b)
#pragma unroll
            for (int m = 0; m < 4; ++m)
#pragma unroll
                for (int n = 0; n < 2; ++n) acc[a][b][m][n] = (f32x4){0.f, 0.f, 0.f, 0.f};
    bf16x8 At[4][2], B0[2][2], B1[2][2];
    const char* cA = (const char*)g.A + (size_t)cur.pm * tstep; const char* cB = (const char*)g.Bt + (size_t)cur.pn * tstep;
    S.a_ready(cur);
    if constexpr (SP2) {
        PG8_STAGE(PG8_SB(0, 0), cB, voffB); PG8_STAGE(PG8_SB(0, 1), cB + hstep, voffB); PG8_STAGE(PG8_SA(0, 0), cA, voffA); PG8_STAGE(PG8_SA(0, 1), cA + hstep, voffA);
        if (wr == 1) PG8_BAR;
        PG8_WAIT_V(2); PG8_BAR;
        PG8_STAGE(PG8_SB(1, 0), cB + kstep, voffB); PG8_STAGE(PG8_SA(1, 0), cA + kstep, voffA); PG8_STAGE(PG8_SB(1, 1), cB + hstep + kstep, voffB);
        PG8_WAIT_V(6); PG8_BAR;
    } else {
        PG8_STAGE(PG8_SB(0, 0), cB, voffB); PG8_STAGE(PG8_SA(0, 0), cA, voffA); PG8_STAGE(PG8_SB(0, 1), cB + hstep, voffB); PG8_STAGE(PG8_SA(0, 1), cA + hstep, voffA);
        if (wr == 1) PG8_BAR;
        PG8_WAIT_V(4); PG8_BAR;
        PG8_STAGE(PG8_SB(1, 0), cB + kstep, voffB); PG8_STAGE(PG8_SA(1, 0), cA + kstep, voffA); PG8_STAGE(PG8_SB(1, 1), cB + hstep + kstep, voffB);
        PG8_WAIT_V(6); PG8_BAR;
    }
    for (;;) {
        const bool has_next = S.next(ui + 1, nxt);
        const char* nA = has_next ? (const char*)g.A + (size_t)nxt.pm * tstep : cA; const char* nB = has_next ? (const char*)g.Bt + (size_t)nxt.pn * tstep : cB;
        for (int t = 0; t < nt; t += 2) {
            const bool last = (t == nt - 2);
            const char* a1 = cA + (size_t)(t + 1) * kstep;
            const char* a2 = last ? nA : cA + (size_t)(t + 2) * kstep; const char* b2 = last ? nB : cB + (size_t)(t + 2) * kstep;
            const char* a3 = a2 + kstep; const char* b3 = b2 + kstep;
            if (last && has_next) S.a_ready(nxt);
            if constexpr (SP2) {
            PG8_LDB(B0, 0, 0); PG8_LDB(B1, 0, 1); PG8_SCHED; PG8_LDA(At, 0, 0); PG8_STAGE(PG8_SA(1, 1), a1 + hstep, voffA);
            PG8_WAIT_V(8); PG8_WAIT_L(0); PG8_BAR; PG8_MMA(0, 0, At, B0); PG8_MMA(0, 1, At, B1); PG8_BAR; PG8_SCHED;
            PG8_LDA(At, 0, 1); PG8_STAGE(PG8_SB(0, 0), b2, voffB); PG8_STAGE(PG8_SB(0, 1), b2 + hstep, voffB); PG8_STAGE(PG8_SA(0, 0), a2, voffA);
            PG8_WAIT_V(8); PG8_WAIT_L(0); PG8_BAR; PG8_MMA(1, 0, At, B0); PG8_MMA(1, 1, At, B1); PG8_BAR; PG8_SCHED;
            PG8_LDB(B0, 1, 0); PG8_LDB(B1, 1, 1); PG8_SCHED; PG8_LDA(At, 1, 0); PG8_STAGE(PG8_SA(0, 1), a2 + hstep, voffA);
            PG8_WAIT_V(8); PG8_WAIT_L(0); PG8_BAR; PG8_MMA(0, 0, At, B0); PG8_MMA(0, 1, At, B1); PG8_BAR; PG8_SCHED;
            PG8_LDA(At, 1, 1); PG8_STAGE(PG8_SB(1, 0), b3, voffB); PG8_STAGE(PG8_SB(1, 1), b3 + hstep, voffB); PG8_STAGE(PG8_SA(1, 0), a3, voffA);
            PG8_WAIT_V(8); PG8_WAIT_L(0); PG8_BAR; PG8_MMA(1, 0, At, B0); PG8_MMA(1, 1, At, B1); PG8_BAR; PG8_SCHED;
            } else {
            PG8_LDB(B0, 0, 0); PG8_SCHED; PG8_LDA(At, 0, 0); PG8_STAGE(PG8_SA(1, 1), a1 + hstep, voffA);
            PG8_WAIT_L(8); PG8_BAR; PG8_WAIT_L(0); PG8_MMA(0, 0, At, B0); PG8_BAR; PG8_SCHED;
            PG8_LDB(B1, 0, 1); PG8_STAGE(PG8_SB(0, 0), b2, voffB);
            PG8_BAR; PG8_WAIT_L(0); PG8_MMA(0, 1, At, B1); PG8_BAR;
            PG8_LDA(At, 0, 1); PG8_STAGE(PG8_SA(0, 0), a2, voffA);
            PG8_BAR; PG8_WAIT_L(0); PG8_MMA(1, 0, At, B0); PG8_BAR; PG8_SCHED;
            PG8_STAGE(PG8_SB(0, 1), b2 + hstep, voffB);
            PG8_WAIT_V(6); PG8_BAR; PG8_MMA(1, 1, At, B1); PG8_BAR;
            PG8_LDB(B0, 1, 0); PG8_SCHED; PG8_LDA(At, 1, 0); PG8_STAGE(PG8_SA(0, 1), a2 + hstep, voffA);
            PG8_WAIT_L(8); PG8_BAR; PG8_WAIT_L(0); PG8_MMA(0, 0, At, B0); PG8_BAR; PG8_SCHED;
            PG8_LDB(B1, 1, 1); PG8_STAGE(PG8_SB(1, 0), b3, voffB);
            PG8_BAR; PG8_WAIT_L(0); PG8_MMA(0, 1, At, B1); PG8_BAR;
            PG8_LDA(At, 1, 1); PG8_STAGE(PG8_SA(1, 0), a3, voffA);
            PG8_BAR; PG8_WAIT_L(0); PG8_MMA(1, 0, At, B0); PG8_BAR; PG8_SCHED;
            PG8_STAGE(PG8_SB(1, 1), b3 + hstep, voffB);
            PG8_WAIT_V(6); PG8_BAR; PG8_MMA(1, 1, At, B1); PG8_BAR;
            }
        }
        if constexpr (ALIGN_EPI) { if (wr == 0) PG8_BAR; }
        if constexpr (!Epi::AFTER_DRAIN) { E(acc, cur, wr, wc, fr, fq); S.done(cur); }
        if (!has_next) break;
#pragma unroll
        for (int a = 0; a < 2; ++a)
#pragma unroll
            for (int b = 0; b < 2; ++b)
#pragma unroll
                for (int m = 0; m < 4; ++m)
#pragma unroll
                    for (int n = 0; n < 2; ++n) acc[a][b][m][n] = (f32x4){0.f, 0.f, 0.f, 0.f};
        cur = nxt; cA = nA; cB = nB; ++ui;
        if constexpr (ALIGN_EPI) { if (wr == 1) PG8_BAR; }
    }
    PG8_WAIT_V(0);
    if constexpr (!ALIGN_EPI) { if (wr == 0) PG8_BAR; }
    PG8_BAR;
    if constexpr (Epi::AFTER_DRAIN) { E.fused(acc, cur, wr, wc, fr, fq, lds, wid, lane); S.done(cur); }
#undef PG8_SA
#undef PG8_SB
#undef PG8_STAGE
#undef PG8_LDA
#undef PG8_LDB
#undef PG8_MMA
#undef PG8_WAIT_V
#undef PG8_WAIT_L
#undef PG8_BAR
#undef PG8_SCHED
}
}
#ifndef PG8_SP2
#define PG8_SP2 true
#endif
#ifndef PG8_ALIGN
#define PG8_ALIGN true
#endif
constexpr int NWAVES = 8;
constexpr int DM = 1024, NBATCH = 16, SEQ = 2048, NMETA = 16, TT = SEQ + NMETA, DBATCH = 128, DSEQ = 8, PAST = 8192, PAGE = 128, NPAGES = 64;
constexpr int NHEAD = 8, QKN = 64, QKR = 32, QKH = 96, VHD = 128, QLORA = 384, KVL = 256, PW = 512, DFF = 4096, DIN = 3232;
constexpr int MP = NBATCH * SEQ, MS = DBATCH * DSEQ, MC = MP + MS, MCX = MC + 256;
constexpr int NIN = 3328, PFW = 1280;
constexpr int RB = NBATCH * TT;
constexpr float EPS = 1e-6f;
constexpr float SCALE_L2E = 0.10206207261596575f * 1.4426950408889634f;
constexpr size_t O_YP = 0, O_YS = O_YP + (size_t)MP * DM, O_CP = O_YS + (size_t)MS * DM, O_KRP = O_CP + (size_t)RB * KVL, O_PSP = O_KRP + (size_t)RB * QKR,
                 O_CS = O_PSP + (size_t)NBATCH * 15 * PW, O_KRS = O_CS + (size_t)MS * KVL, O_PSS = O_KRS + (size_t)MS * QKR, O_END = O_PSS + (size_t)DBATCH * 15 * PW;
static_assert(O_END == 45514752, "d_out size");
constexpr size_t al256(size_t x) { return (x + 255) & ~(size_t)255; }
constexpr size_t WS_CTL = 0, CTL_BYTES = 1u << 20;
constexpr size_t WS_WIN = CTL_BYTES;
constexpr size_t WS_WUQ = WS_WIN + al256((size_t)NIN * DM * 2);
constexpr size_t WS_WKV = WS_WUQ + al256((size_t)768 * 384 * 2);
constexpr size_t WS_WUK = WS_WKV + al256((size_t)1536 * 256 * 2);
constexpr size_t WS_WPL = WS_WUK + al256((size_t)512 * 256 * 2);
constexpr size_t WS_WO = WS_WPL + al256((size_t)1024 * 512 * 2);
constexpr size_t WS_W1 = WS_WO + al256((size_t)DM * DM * 2);
constexpr size_t WS_W2 = WS_W1 + al256((size_t)DFF * DM * 2);
constexpr size_t WS_ROPE = WS_W2 + al256((size_t)DFF * DM * 2);
constexpr size_t WS_XNM = WS_ROPE + al256((size_t)2072 * 32 * 4);
constexpr size_t WS_PFM = WS_XNM + al256(16 * 1024 * 2);
constexpr size_t WS_CM = WS_PFM + al256(16 * 1280 * 4);
constexpr size_t WS_KRM = WS_CM + al256(16 * 256 * 4);
constexpr size_t WS_KSM = WS_KRM + al256(16 * 32 * 4);
constexpr size_t WS_XN = WS_KSM + 256;
constexpr size_t WS_PF = WS_XN + al256((size_t)MCX * DM * 2);
constexpr size_t WS_GATE = WS_PF + al256((size_t)MCX * PFW * 4);
constexpr size_t WS_CB = WS_GATE + al256((size_t)MCX * 2048 * 2);
constexpr size_t WS_KRG = WS_CB + al256((size_t)MC * 256 * 2);
constexpr size_t WS_KSS = WS_KRG + al256((size_t)(RB + 64) * 32 * 2);
constexpr size_t WS_QL = WS_KSS + al256((size_t)(RB + 64) * 4);
constexpr size_t WS_DP = WS_QL + al256((size_t)MC * 384 * 2);
constexpr size_t WS_QR = WS_DP + al256((size_t)MC * 512 * 2);
constexpr size_t WS_KH = WS_QR + al256((size_t)MC * 768 * 2);
constexpr size_t WS_VH = WS_KH + al256((size_t)(RB + 64) * 768 * 2);
constexpr size_t WS_PG = WS_VH + al256((size_t)(RB + 64) * 1024 * 2);
constexpr size_t WS_AM = WS_PG + al256((size_t)MC * DM * 2);
constexpr size_t WS_SAC = WS_AM + al256((size_t)MC * DM * 2);
constexpr size_t WS_SAL = WS_SAC + al256((size_t)256 * 64 * 256 * 4);
constexpr size_t WS_H = WS_SAL + al256((size_t)256 * 64 * 4);
constexpr size_t WS_HN = WS_H + al256((size_t)MC * DM * 4);
constexpr size_t WS_Z = WS_HN + al256((size_t)MC * DM * 2);
constexpr size_t WS_END = WS_Z + al256((size_t)MC * DFF * 2);
constexpr int CW_TMO = 0, CW_CODE = 1, CW_BAR = 4096;
#ifdef SMALL_LDS
constexpr int RING_OFF = 0, RING_BYTES = 147456;
#else
constexpr int RING_OFF = 0, RING_BYTES = 161792;
#endif
constexpr int LDSCTL_OFF = RING_BYTES, MISC_OFF = LDSCTL_OFF + 320;
constexpr int LDS_BYTES = RING_BYTES + 512;
static_assert(LDS_BYTES <= 163840, "LDS");

#define GAS __attribute__((address_space(1)))
#define LAS __attribute__((address_space(3)))
typedef unsigned short bf16;
typedef unsigned v4u __attribute__((ext_vector_type(4)));
typedef unsigned v2u __attribute__((ext_vector_type(2)));
typedef float f32x4 __attribute__((ext_vector_type(4)));
typedef float f32x2 __attribute__((ext_vector_type(2)));
typedef float f32x16 __attribute__((ext_vector_type(16)));
typedef short bf16x8 __attribute__((ext_vector_type(8)));
typedef short s16x4 __attribute__((ext_vector_type(4)));
typedef GAS unsigned gu32;
#define RLX_AGENT __ATOMIC_RELAXED, __HIP_MEMORY_SCOPE_AGENT
#define LDS_WAIT() asm volatile("s_waitcnt lgkmcnt(0)" ::: "memory")
#define VM_WAIT() asm volatile("s_waitcnt vmcnt(0)" ::: "memory")
#define SBAR() __builtin_amdgcn_sched_barrier(0)
__device__ __forceinline__ unsigned f2bf(float f) { unsigned u = __builtin_bit_cast(unsigned, f); return (u + 0x7fffu + ((u >> 16) & 1u)) >> 16; }
typedef float f32x2_t __attribute__((ext_vector_type(2))); typedef __bf16 bf16x2_t __attribute__((ext_vector_type(2)));
__device__ __forceinline__ unsigned pk2(float lo, float hi) { const f32x2_t v = {lo, hi}; const bf16x2_t b = __builtin_convertvector(v, bf16x2_t); return __builtin_bit_cast(unsigned, b); }
__device__ __forceinline__ float bflo(unsigned u) { return __builtin_bit_cast(float, u << 16); }
__device__ __forceinline__ float bfhi(unsigned u) { return __builtin_bit_cast(float, u & 0xffff0000u); }
template <int CTRL> __device__ __forceinline__ float dppf(float v) { return __builtin_bit_cast(float, __builtin_amdgcn_update_dpp(0, __builtin_bit_cast(int, v), CTRL, 0xf, 0xf, true)); }
__device__ __forceinline__ float sum_x16(float v) { const unsigned u = __float_as_uint(v); auto r = __builtin_amdgcn_permlane16_swap(u, u, false, false); return __uint_as_float(r[0]) + __uint_as_float(r[1]); }
__device__ __forceinline__ float sum_x32(float v) { const unsigned u = __float_as_uint(v); auto r = __builtin_amdgcn_permlane32_swap(u, u, false, false); return __uint_as_float(r[0]) + __uint_as_float(r[1]); }
__device__ __forceinline__ float max_x16(float v) { const unsigned u = __float_as_uint(v); auto r = __builtin_amdgcn_permlane16_swap(u, u, false, false); return fmaxf(__uint_as_float(r[0]), __uint_as_float(r[1])); }
__device__ __forceinline__ float max_x32(float v) { const unsigned u = __float_as_uint(v); auto r = __builtin_amdgcn_permlane32_swap(u, u, false, false); return fmaxf(__uint_as_float(r[0]), __uint_as_float(r[1])); }
__device__ __forceinline__ float sum_quad(float v) { v += dppf<0xB1>(v); v += dppf<0x4E>(v); return v; }
__device__ __forceinline__ float sum_oct(float v) { v = sum_quad(v); v += dppf<0x141>(v); return v; }
__device__ __forceinline__ float sum_row16(float v) { v = sum_oct(v); v += dppf<0x140>(v); return v; }
__device__ __forceinline__ float wave_sum(float v) { return sum_x32(sum_x16(sum_row16(v))); }
__device__ __forceinline__ float wave_max(float v) { v = fmaxf(v, dppf<0xB1>(v)); v = fmaxf(v, dppf<0x4E>(v)); v = fmaxf(v, dppf<0x141>(v)); v = fmaxf(v, dppf<0x140>(v)); return max_x32(max_x16(v)); }
__device__ __forceinline__ float frsqrt(float x) { return 1.0f / sqrtf(x); }
__constant__ double ROPE_INV[16] = { 1.0, 0.5623413251903491, 0.31622776601683794, 0.1778279410038923, 0.1, 0.05623413251903491, 0.03162277660168379, 0.01778279410038923,
    0.01, 0.005623413251903491, 0.0031622776601683794, 0.001778279410038923, 0.001, 0.0005623413251903491, 0.00031622776601683794, 0.0001778279410038923 };
#define XB_TMO      128
#define XB_XCNT(j)  (256  + 64 * (j))
#define XB_XSUB(j)  (1280 + 64 * (j))
#define XB_XGEN(j)  (2304 + 64 * (j))
#define XB_TOP      3328
#define XB_TOPGEN   3392
#define XCD_BAR_WORDS 3456
#define XB_SPIN_CAP (1u << 18)

__device__ __forceinline__ unsigned xb_ld(unsigned* p)              { return __hip_atomic_load(p, __ATOMIC_RELAXED, __HIP_MEMORY_SCOPE_AGENT); }
__device__ __forceinline__ unsigned xb_add(unsigned* p, unsigned v) { return __hip_atomic_fetch_add(p, v, __ATOMIC_RELAXED, __HIP_MEMORY_SCOPE_AGENT); }
__device__ __forceinline__ unsigned xb_xcc_id() { return (unsigned)__builtin_amdgcn_s_getreg((3 << 11) | 20) & 0xFu; }
#define XB_SPIN(cond, bar) do { unsigned _sp = 0; while (cond) { __builtin_amdgcn_s_sleep(1); \
    if ((++_sp & 255u) == 0u) { if (xb_ld(&(bar)[XB_TMO])) break; if (_sp > XB_SPIN_CAP) { atomicAdd(&(bar)[XB_TMO], 1u); break; } } } } while (0)

struct XcdBarrier {
    unsigned* bar; unsigned x;
    volatile LAS unsigned* st;
};

__device__ __forceinline__ XcdBarrier xcd_barrier_post(unsigned* bar, volatile LAS unsigned* st) {
    XcdBarrier b; b.bar = bar; b.x = xb_xcc_id(); b.st = st;
    if (threadIdx.x == 0) (void)xb_add(&bar[XB_XCNT(b.x)], 1u);
    return b;
}
__device__ __forceinline__ void xcd_barrier_complete(unsigned* bar, unsigned x, unsigned& nloc, unsigned& nx) {
    const unsigned G = gridDim.x * gridDim.y * gridDim.z;
    unsigned sum, cnt, mine, sp = 0u;
    for (;;) {
        sum = 0u; cnt = 0u; mine = 0u;
#pragma unroll
        for (unsigned j = 0; j < 16; ++j) { const unsigned c = xb_ld(&bar[XB_XCNT(j)]); sum += c; cnt += (c > 0u) ? 1u : 0u; mine = (j == x) ? c : mine; }
        if (sum == G) break;
        __builtin_amdgcn_s_sleep(1);
        if ((++sp & 255u) == 0u) { if (xb_ld(&bar[XB_TMO])) break; if (sp > XB_SPIN_CAP) { atomicAdd(&bar[XB_TMO], 1u); break; } }
    }
    nloc = mine > 0u ? mine : 1u; nx = cnt > 0u ? cnt : 1u;
}

__device__ __forceinline__ void xcd_barrier(const XcdBarrier& b) {
    asm volatile("s_waitcnt vmcnt(0)" ::: "memory");
    __syncthreads();
    if (threadIdx.x == 0) {
        unsigned* bar = b.bar;
        __builtin_amdgcn_s_waitcnt(0);
        unsigned nloc = b.st[0], nx = b.st[1];
        if (nloc == 0u) { xcd_barrier_complete(bar, b.x, nloc, nx); b.st[0] = nloc; b.st[1] = nx; }
        const unsigned old = xb_add(&bar[XB_XSUB(b.x)], 1u);
        const unsigned gen = old / nloc;
        if (old + 1u == (gen + 1u) * nloc) {
            __builtin_amdgcn_fence(__ATOMIC_RELEASE, "agent");
            asm volatile("s_waitcnt vmcnt(0)" ::: "memory");
            const unsigned og = xb_add(&bar[XB_TOP], 1u);
            const unsigned tg = og / nx;
            if (og + 1u == (tg + 1u) * nx) xb_add(&bar[XB_TOPGEN], 1u);
            else XB_SPIN(xb_ld(&bar[XB_TOPGEN]) == tg, bar);
            __builtin_amdgcn_fence(__ATOMIC_ACQUIRE, "agent");
            xb_add(&bar[XB_XGEN(b.x)], 1u);
            asm volatile("s_waitcnt vmcnt(0)" ::: "memory");
        } else {
            XB_SPIN(xb_ld(&bar[XB_XGEN(b.x)]) == gen, bar);
            __builtin_amdgcn_fence(__ATOMIC_ACQUIRE, "agent");
            asm volatile("s_waitcnt vmcnt(0)" ::: "memory");
        }
    }
    __syncthreads();
}
struct Frame {
    LAS unsigned char* lds;
    volatile LAS unsigned* MISC;
    gu32* ctl;
    int tid, lane, wave, vcu, G;
    const float *x_prompt, *x_sample, *cache_c, *cache_kr, *state_pool; const int* page_table;
    const float *meta_tokens, *g_attn, *w_in, *g_q_lat, *w_uq, *g_kv_lat, *g_qn_nope, *g_qn_rope, *w_uk, *g_kn_nope, *g_kn_rope, *w_uv, *w_pool_map, *pool_scale, *w_o, *g_mlp, *w_ff1, *w_ff2;
    float* out; unsigned char* ws;
};
#define WSP(T, off) ((T*)(F.ws + (off)))

__device__ __forceinline__ void p0_tr_block(const float* W, int ldw, bf16* dst, bf16* dst2, int pitch, bool zero, LAS float* scr, int lane) {
    const int c = lane & 7;
    if (zero) {
#pragma unroll
        for (int j = 0; j < 4; ++j) { const int n = (lane >> 3) + 8 * j; *(GAS v4u*)(dst + (size_t)n * pitch + 8 * c) = (v4u){0u, 0u, 0u, 0u}; }
        return;
    }
#pragma unroll 8
    for (int i = 0; i < 32; ++i) { const int kk = 2 * i + (lane >> 5); scr[kk * 33 + (lane & 31)] = W[(size_t)kk * ldw + (lane & 31)]; }
    LDS_WAIT(); asm volatile("" ::: "memory");
#pragma unroll
    for (int j = 0; j < 4; ++j) { const int n = (lane >> 3) + 8 * j; const LAS float* s = scr + (8 * c) * 33 + n;
        v4u o; o.x = pk2(s[0 * 33], s[1 * 33]); o.y = pk2(s[2 * 33], s[3 * 33]); o.z = pk2(s[4 * 33], s[5 * 33]); o.w = pk2(s[6 * 33], s[7 * 33]);
        *(GAS v4u*)(dst + (size_t)n * pitch + 8 * c) = o;
        if (dst2) *(GAS v4u*)(dst2 + (size_t)n * pitch + 8 * c) = o; }
    LDS_WAIT(); asm volatile("" ::: "memory");
}
__device__ __forceinline__ int in_row(int n0) { return n0 < 512 ? 256 + n0 : (n0 < 896 ? 768 + (n0 - 512) : (n0 < 1152 ? n0 - 896 : (n0 < 1184 ? n0 : 1280 + (n0 - 1184)))); }

__device__ __forceinline__ void p0_prologue(Frame& F) {
    LAS float* scr = (LAS float*)(F.lds + RING_OFF + F.wave * 16384);
    const int gw = F.vcu * NWAVES + F.wave, NGW = F.G * NWAVES, lane = F.lane;
    bf16* Win_t = WSP(bf16, WS_WIN); bf16* Wuq_t = WSP(bf16, WS_WUQ); bf16* Wkv_t = WSP(bf16, WS_WKV); bf16* Wuk_t = WSP(bf16, WS_WUK); bf16* Wpl_t = WSP(bf16, WS_WPL);
    bf16* Wo_t = WSP(bf16, WS_WO); bf16* W1_t = WSP(bf16, WS_W1); bf16* W2_t = WSP(bf16, WS_W2);
    constexpr int I_1 = 16 * 128, I_2 = 64 * 32, I_IN = 16 * 101, I_O = 16 * 32, I_PL = 8 * 32, I_UQ = 6 * 24, I_UV = 4 * 32, I_UK = 4 * 16, I_INZ = 16 * 3;
    constexpr int NITEMS = I_1 + I_2 + I_IN + I_O + I_PL + I_UQ + I_UV + I_UK + I_INZ;
    for (int it = gw; it < NITEMS; it += NGW) {
        int r = it; const float* W; int ldw, pitch; bf16* dst; bf16* dst2 = nullptr; bool zero = false;
        if (r < I_1) { const int kb = r / 128, nb = r % 128; W = F.w_ff1 + (size_t)(64 * kb) * DFF + 32 * nb; ldw = DFF; pitch = DM; dst = W1_t + (size_t)(32 * nb) * DM + 64 * kb; }
        else if ((r -= I_1) < I_2) { const int kb = r / 32, nb = r % 32; W = F.w_ff2 + (size_t)(64 * kb) * DM + 32 * nb; ldw = DM; pitch = DFF; dst = W2_t + (size_t)(32 * nb) * DFF + 64 * kb; }
        else if ((r -= I_2) < I_IN) { const int kb = r / 101, nb = r % 101; W = F.w_in + (size_t)(64 * kb) * DIN + 32 * nb; ldw = DIN; pitch = DM; dst = Win_t + (size_t)in_row(32 * nb) * DM + 64 * kb; }
        else if ((r -= I_IN) < I_O) { const int kb = r / 32, nb = r % 32; W = F.w_o + (size_t)(64 * kb) * DM + 32 * nb; ldw = DM; pitch = DM; dst = Wo_t + (size_t)(32 * nb) * DM + 64 * kb; }
        else if ((r -= I_O) < I_PL) { const int kb = r / 32, nb = r % 32, g = nb / 8;
            pitch = PW; dst = Wpl_t + (size_t)(32 * nb) * PW + 64 * kb; ldw = 256; zero = (kb / 2 != g);
            W = F.w_pool_map + (size_t)g * 128 * 256 + (size_t)(64 * (kb & 1)) * 256 + (32 * nb - 256 * g); }
        else if ((r -= I_PL) < I_UQ) { const int kb = r / 24, nb = r % 24; W = F.w_uq + (size_t)(64 * kb) * 768 + 32 * nb; ldw = 768; pitch = QLORA; dst = Wuq_t + (size_t)(32 * nb) * QLORA + 64 * kb; }
        else if ((r -= I_UQ) < I_UV) { const int kb = r / 32, nb = r % 32; W = F.w_uv + (size_t)(64 * kb) * 1024 + 32 * nb; ldw = 1024; pitch = KVL; dst = Wkv_t + (size_t)(512 + 32 * nb) * KVL + 64 * kb; }
        else if ((r -= I_UV) < I_UK) { const int kb = r / 16, nb = r % 16, h = nb >> 1, d0 = (nb & 1) * 32; W = F.w_uk + (size_t)(64 * kb) * 512 + 32 * nb; ldw = 512; pitch = KVL;
            dst = Wkv_t + (size_t)(256 * (h >> 2) + 128 * (d0 >> 5) + 32 * (h & 3)) * KVL + 64 * kb; dst2 = Wuk_t + (size_t)(32 * nb) * KVL + 64 * kb; }
        else { r -= I_UK; const int kb = r / 3, nb = r % 3; W = F.w_in; ldw = DIN; pitch = DM; dst = Win_t + (size_t)(1184 + 32 * nb) * DM + 64 * kb; zero = true; }
        p0_tr_block(W, ldw, dst, dst2, pitch, zero, scr, lane);
    }
    bf16* XN = WSP(bf16, WS_XN);
    f32x4 g4[4];
#pragma unroll
    for (int j = 0; j < 4; ++j) g4[j] = *((const GAS f32x4*)F.g_attn + lane + 64 * j);
    for (int m = gw; m < MC + NMETA; m += NGW) {
        const float* xrow = m < MP ? F.x_prompt + (size_t)m * DM : (m < MC ? F.x_sample + (size_t)(m - MP) * DM : F.meta_tokens + (size_t)(m - MC) * DM);
        bf16* orow = XN + (size_t)m * DM;
        const GAS f32x4* xr = (const GAS f32x4*)xrow + lane;
        f32x4 v[4]; float s = 0.f;
#pragma unroll
        for (int j = 0; j < 4; ++j) { v[j] = xr[64 * j]; s += (v[j].x * v[j].x + v[j].y * v[j].y) + (v[j].z * v[j].z + v[j].w * v[j].w); }
        const float rstd = frsqrt(wave_sum(s) * (1.f / DM) + EPS);
        GAS v2u* o8 = (GAS v2u*)orow + lane;
#pragma unroll
        for (int j = 0; j < 4; ++j) { v2u o; o.x = pk2(v[j].x * rstd * g4[j].x, v[j].y * rstd * g4[j].y); o.y = pk2(v[j].z * rstd * g4[j].z, v[j].w * rstd * g4[j].w); o8[64 * j] = o; }
    }
    { GAS v4u* zp = (GAS v4u*)(XN + (size_t)(MC + NMETA) * DM);
      for (int e = (F.vcu * NWAVES * 64) + F.tid; e < (MCX - MC - NMETA) * DM / 8; e += F.G * NWAVES * 64) zp[e] = (v4u){0u, 0u, 0u, 0u}; }
    float* ROPE = WSP(float, WS_ROPE);
    for (int e = (F.vcu * NWAVES * 64) + F.tid; e < 2072 * 16; e += F.G * NWAVES * 64) {
        const int p = e >> 4, i = e & 15; const int pos = p < TT ? p : PAST + (p - TT);
        const double ang = (double)pos * ROPE_INV[i];
        const double k = __builtin_rint(ang * 0.15915494309189535);
        const double r = __builtin_fma(-k, 6.283185307179586, ang) - k * 2.4492935982947064e-16;
        const float rf = (float)r;
        ROPE[p * 32 + i] = cosf(rf); ROPE[p * 32 + 16 + i] = sinf(rf);
    }
    { GAS v4u* kp = (GAS v4u*)(WSP(bf16, WS_KH) + (size_t)RB * 768); GAS v4u* vp = (GAS v4u*)(WSP(bf16, WS_VH) + (size_t)RB * 1024);
      for (int e = (F.vcu * NWAVES * 64) + F.tid; e < 64 * 768 / 8 + 64 * 1024 / 8; e += F.G * NWAVES * 64) { if (e < 64 * 768 / 8) kp[e] = (v4u){0u, 0u, 0u, 0u}; else vp[e - 64 * 768 / 8] = (v4u){0u, 0u, 0u, 0u}; } }
}

__device__ __forceinline__ void p1_meta(Frame& F) {
    const int gw = F.vcu * NWAVES + F.wave, NGW = F.G * NWAVES, lane = F.lane;
    const bf16* Win_t = WSP(bf16, WS_WIN); const bf16* XNM = WSP(bf16, WS_XNM); float* PFM = WSP(float, WS_PFM);
    for (int t = gw; t < 800; t += NGW) {
        const int n = t < 768 ? t : 1152 + (t - 768);
        const GAS v4u* wp = (const GAS v4u*)(Win_t + (size_t)n * DM + lane * 16);
        const v4u w0 = wp[0], w1 = wp[1];
        float wf[16];
        wf[0] = bflo(w0.x); wf[1] = bfhi(w0.x); wf[2] = bflo(w0.y); wf[3] = bfhi(w0.y); wf[4] = bflo(w0.z); wf[5] = bfhi(w0.z); wf[6] = bflo(w0.w); wf[7] = bfhi(w0.w);
        wf[8] = bflo(w1.x); wf[9] = bfhi(w1.x); wf[10] = bflo(w1.y); wf[11] = bfhi(w1.y); wf[12] = bflo(w1.z); wf[13] = bfhi(w1.z); wf[14] = bflo(w1.w); wf[15] = bfhi(w1.w);
        float mine = 0.f;
#pragma unroll 4
        for (int i = 0; i < 16; ++i) {
            const GAS v4u* xp = (const GAS v4u*)(XNM + (size_t)i * DM + lane * 16);
            const v4u x0 = xp[0], x1 = xp[1];
            float a = bflo(x0.x) * wf[0] + bfhi(x0.x) * wf[1] + bflo(x0.y) * wf[2] + bfhi(x0.y) * wf[3] + bflo(x0.z) * wf[4] + bfhi(x0.z) * wf[5] + bflo(x0.w) * wf[6] + bfhi(x0.w) * wf[7]
                    + bflo(x1.x) * wf[8] + bfhi(x1.x) * wf[9] + bflo(x1.y) * wf[10] + bfhi(x1.y) * wf[11] + bflo(x1.z) * wf[12] + bfhi(x1.z) * wf[13] + bflo(x1.w) * wf[14] + bfhi(x1.w) * wf[15];
            a = wave_sum(a);
            mine = (lane == i) ? a : mine;
        }
        if (lane < 16) PFM[lane * PFW + n] = mine;
    }
}

__device__ __forceinline__ void p2_rows(Frame& F) {
    const int gw = F.vcu * NWAVES + F.wave, NGW = F.G * NWAVES, lane = F.lane;
    const float* PF = WSP(float, WS_PF); const float* PFM = WSP(float, WS_PFM); const float* ROPE = WSP(float, WS_ROPE);
    bf16* CB = WSP(bf16, WS_CB); bf16* KRG = WSP(bf16, WS_KRG); float* KSS = WSP(float, WS_KSS); bf16* QL = WSP(bf16, WS_QL);
    float* CM = WSP(float, WS_CM); float* KRM = WSP(float, WS_KRM); float* KSM = WSP(float, WS_KSM);
    const f32x4 gkv = *((const GAS f32x4*)F.g_kv_lat + lane);
    const f32x4 gqa = *((const GAS f32x4*)F.g_q_lat + lane);
    const f32x2 gqb = *((const GAS f32x2*)(F.g_q_lat + 256) + lane);
    const float gkr = F.g_kn_rope[lane & 15];
    for (int m = gw; m < MC + NMETA; m += NGW) {
        const bool meta = m >= MC, samp = !meta && m >= MP;
        const float* pf = PF + (size_t)m * PFW;
        const int pos = meta ? m - MC : (samp ? PAST + ((m - MP) & 7) : (m & (SEQ - 1)) + NMETA);
        const int ridx = pos < TT ? pos : TT + (pos - PAST);
        const f32x4 c4 = *((const GAS f32x4*)pf + lane);
        float x1 = 0.f, x2 = 0.f, cs = 1.f, sn = 0.f;
        if (lane < 16) { x1 = pf[1152 + lane]; x2 = pf[1152 + 16 + lane]; cs = ROPE[ridx * 32 + lane]; sn = ROPE[ridx * 32 + 16 + lane]; }
        f32x4 qa = (f32x4){0.f, 0.f, 0.f, 0.f}; f32x2 qb = (f32x2){0.f, 0.f};
        if (!meta) { qa = *((const GAS f32x4*)(pf + 768) + lane); qb = *((const GAS f32x2*)(pf + 1024) + lane); }
        float sc = (c4.x * c4.x + c4.y * c4.y) + (c4.z * c4.z + c4.w * c4.w), sk = x1 * x1 + x2 * x2, sq = (qa.x * qa.x + qa.y * qa.y) + (qa.z * qa.z + qa.w * qa.w) + (qb.x * qb.x + qb.y * qb.y);
        sc = wave_sum(sc); sk = wave_sum(sk); sq = wave_sum(sq);
        const float rc = frsqrt(sc * (1.f / KVL) + EPS), rq = frsqrt(sq * (1.f / QLORA) + EPS);
        const f32x4 cn = (f32x4){c4.x * rc * gkv.x, c4.y * rc * gkv.y, c4.z * rc * gkv.z, c4.w * rc * gkv.w};
        const float o1 = x1 * cs - x2 * sn, o2 = x2 * cs + x1 * sn;
        if (meta) {
            const int i = m - MC;
            *((GAS f32x4*)(CM + (size_t)i * KVL) + lane) = cn;
            if (lane < 16) { KRM[i * 32 + lane] = o1 * gkr; KRM[i * 32 + 16 + lane] = o2 * gkr; }
            if (lane == 0) KSM[i] = sk;
#pragma unroll 4
            for (int b = 0; b < NBATCH; ++b) { const size_t R = (size_t)b * TT + i;
                *((GAS f32x4*)(F.out + O_CP + R * KVL) + lane) = cn;
                if (lane < 16) { F.out[O_KRP + R * QKR + lane] = o1; F.out[O_KRP + R * QKR + 16 + lane] = o2;
                    KRG[R * 32 + lane] = (bf16)f2bf(o1 * gkr); KRG[R * 32 + 16 + lane] = (bf16)f2bf(o2 * gkr); }
                if (lane == 0) KSS[R] = sk; }
        } else {
            v2u cb; cb.x = pk2(cn.x, cn.y); cb.y = pk2(cn.z, cn.w);
            *((GAS v2u*)(CB + (size_t)m * KVL) + lane) = cb;
            if (!samp) { const size_t R = (size_t)m + NMETA * ((m >> 11) + 1);
                *((GAS f32x4*)(F.out + O_CP + R * KVL) + lane) = cn;
                if (lane < 16) { F.out[O_KRP + R * QKR + lane] = o1; F.out[O_KRP + R * QKR + 16 + lane] = o2;
                    KRG[R * 32 + lane] = (bf16)f2bf(o1 * gkr); KRG[R * 32 + 16 + lane] = (bf16)f2bf(o2 * gkr); }
                if (lane == 0) KSS[R] = sk;
            } else { const size_t R = (size_t)(m - MP);
                *((GAS f32x4*)(F.out + O_CS + R * KVL) + lane) = cn;
                if (lane < 16) { F.out[O_KRS + R * QKR + lane] = o1; F.out[O_KRS + R * QKR + 16 + lane] = o2; } }
            v2u qo; qo.x = pk2(qa.x * rq * gqa.x, qa.y * rq * gqa.y); qo.y = pk2(qa.z * rq * gqa.z, qa.w * rq * gqa.w);
            *((GAS v2u*)(QL + (size_t)m * QLORA) + lane) = qo;
            *((GAS unsigned*)(QL + (size_t)m * QLORA + 256) + lane) = pk2(qb.x * rq * gqb.x, qb.y * rq * gqb.y);
        }
    }
}
__device__ __forceinline__ void p2_pool(Frame& F) {
    const int gw = F.vcu * NWAVES + F.wave, NGW = F.G * NWAVES, lane = F.lane;
    const float* PF = WSP(float, WS_PF); const float* PFM = WSP(float, WS_PFM); bf16* DP = WSP(bf16, WS_DP);
    const int w = 2 << (lane >> 4); const float iw = 1.0f / (float)w; const int col = 256 + 8 * lane;
    for (int t = gw; t < MP / 32; t += NGW) {
        const int b = t >> 6, t0 = (t & 63) * 32;
        const float* base = PF + (size_t)b * SEQ * PFW + col;
#define UROW(tp) (((tp) >= 0) ? base + (size_t)(tp) * PFW : PF + (size_t)(MC + (tp) + NMETA) * PFW + col)
        f32x4 ra = (f32x4){0.f, 0.f, 0.f, 0.f}, rb = ra;
#pragma unroll 5
        for (int j = 1; j < 16; ++j) { const float* p = UROW(t0 - j); const f32x4 a = *(const GAS f32x4*)p, bq = *(const GAS f32x4*)(p + 4); if (j < w) { ra += a; rb += bq; } }
#pragma unroll 4
        for (int r = 0; r < 32; ++r) {
            const float* pc = UROW(t0 + r); const float* po = UROW(t0 + r - w + 1);
            const f32x4 ca = *(const GAS f32x4*)pc, cb = *(const GAS f32x4*)(pc + 4), oa = *(const GAS f32x4*)po, ob = *(const GAS f32x4*)(po + 4);
            ra += ca; rb += cb;
            const f32x4 da = ra * iw - ca, db = rb * iw - cb;
            v4u o; o.x = pk2(da.x, da.y); o.y = pk2(da.z, da.w); o.z = pk2(db.x, db.y); o.w = pk2(db.z, db.w);
            *((GAS v4u*)(DP + (size_t)(b * SEQ + t0 + r) * PW) + lane) = o;
            ra -= oa; rb -= ob;
        }
#undef UROW
    }
    for (int db = gw; db < DBATCH; db += NGW) {
        const float* sp = F.state_pool + (size_t)db * 15 * PW + 8 * lane; const float* base = PF + (size_t)(MP + db * DSEQ) * PFW + col;
#define UROW(s) (((s) >= 0) ? base + (size_t)(s) * PFW : sp + (size_t)(15 + (s)) * PW)
        f32x4 ra = (f32x4){0.f, 0.f, 0.f, 0.f}, rb = ra;
#pragma unroll 5
        for (int j = 1; j < 16; ++j) { const float* p = UROW(-j); const f32x4 a = *(const GAS f32x4*)p, bq = *(const GAS f32x4*)(p + 4); if (j < w) { ra += a; rb += bq; } }
#pragma unroll
        for (int r = 0; r < DSEQ; ++r) {
            const float* pc = UROW(r); const float* po = UROW(r - w + 1);
            const f32x4 ca = *(const GAS f32x4*)pc, cb = *(const GAS f32x4*)(pc + 4), oa = *(const GAS f32x4*)po, ob = *(const GAS f32x4*)(po + 4);
            ra += ca; rb += cb;
            const f32x4 da = ra * iw - ca, dbv = rb * iw - cb;
            v4u o; o.x = pk2(da.x, da.y); o.y = pk2(da.z, da.w); o.z = pk2(dbv.x, dbv.y); o.w = pk2(dbv.z, dbv.w);
            *((GAS v4u*)(DP + (size_t)(MP + db * DSEQ + r) * PW) + lane) = o;
            ra -= oa; rb -= ob;
        }
#undef UROW
    }
    const int gt = F.vcu * NWAVES * 64 + F.tid, NGT = F.G * NWAVES * 64;
    for (int e = gt; e < NBATCH * 15 * (PW / 4); e += NGT) { const int c4 = e & 127, j = (e >> 7) % 15, b = e / (128 * 15);
        *((GAS f32x4*)(F.out + O_PSP) + e) = *((const GAS f32x4*)(PF + (size_t)(b * SEQ + SEQ - 15 + j) * PFW + 256) + c4); }
    for (int e = gt; e < DBATCH * 15 * (PW / 4); e += NGT) { const int c4 = e & 127, j = (e >> 7) % 15, db = e / (128 * 15);
        const f32x4 v = j < 7 ? *((const GAS f32x4*)(F.state_pool + (size_t)(db * 15 + 8 + j) * PW) + c4) : *((const GAS f32x4*)(PF + (size_t)(MP + db * DSEQ + j - 7) * PFW + 256) + c4);
        *((GAS f32x4*)(F.out + O_PSS) + e) = v; }
}
using pg8::Unit;
__device__ __forceinline__ float sigmoidf_fast(float x) { return __builtin_amdgcn_rcpf(1.0f + __builtin_amdgcn_exp2f(-1.4426950408889634f * x)); }

struct EpiInProj {
    static constexpr bool PERM = true, AFTER_DRAIN = false;
    float* PF; bf16* GATE;
    __device__ __forceinline__ void operator()(const f32x4 (&acc)[2][2][4][2], const Unit& u, int wr, int wc, int fr, int fq) const {
        const int row0 = u.pm * 256 + wr * 64 + fr, cw = wc * 32 + 8 * fq;
        if (u.pn < 5) {
#pragma unroll
            for (int ai = 0; ai < 2; ++ai)
#pragma unroll
                for (int m = 0; m < 4; ++m) { float* rowp = PF + (size_t)(row0 + ai * 128 + m * 16) * PFW + u.pn * 256 + cw;
#pragma unroll
                    for (int bj = 0; bj < 2; ++bj) { *(GAS f32x4*)(rowp + bj * 128) = acc[ai][bj][m][0]; *(GAS f32x4*)(rowp + bj * 128 + 4) = acc[ai][bj][m][1]; } }
        } else {
#pragma unroll
            for (int ai = 0; ai < 2; ++ai)
#pragma unroll
                for (int m = 0; m < 4; ++m) { bf16* rowp = GATE + (size_t)(row0 + ai * 128 + m * 16) * 2048 + (u.pn - 5) * 256 + cw;
#pragma unroll
                    for (int bj = 0; bj < 2; ++bj) { const f32x4 v0 = acc[ai][bj][m][0], v1 = acc[ai][bj][m][1]; v4u w;
                        w.x = pk2(sigmoidf_fast(v0[0]), sigmoidf_fast(v0[1])); w.y = pk2(sigmoidf_fast(v0[2]), sigmoidf_fast(v0[3]));
                        w.z = pk2(sigmoidf_fast(v1[0]), sigmoidf_fast(v1[1])); w.w = pk2(sigmoidf_fast(v1[2]), sigmoidf_fast(v1[3]));
                        *(GAS v4u*)(rowp + bj * 128) = w; } }
        }
    }
};
struct EpiInProjScalar {
    static constexpr bool PERM = true, AFTER_DRAIN = false;
    float* PF; bf16* GATE;
    __device__ __forceinline__ void operator()(const f32x4 (&acc)[2][2][4][2], const Unit& u, int wr, int wc, int fr, int fq) const {
        const int row0 = u.pm * 256 + wr * 64 + fr, cw = wc * 32 + 8 * fq;
#pragma unroll
        for (int ai = 0; ai < 2; ++ai)
#pragma unroll
            for (int m = 0; m < 4; ++m)
#pragma unroll
                for (int bj = 0; bj < 2; ++bj)
#pragma unroll
                    for (int n = 0; n < 2; ++n)
#pragma unroll
                        for (int e = 0; e < 4; ++e) { const size_t r = (size_t)(row0 + ai * 128 + m * 16); const int c = u.pn * 256 + bj * 128 + cw + 4 * n + e; const float v = acc[ai][bj][m][n][e];
                            if (c < PFW) PF[r * PFW + c] = v; else GATE[r * 2048 + (c - PFW)] = (bf16)f2bf(sigmoidf_fast(v)); }
    }
};
struct EpiPlainBf16 {
    static constexpr bool PERM = true, AFTER_DRAIN = false;
    bf16* O; int ldc;
    __device__ __forceinline__ void operator()(const f32x4 (&acc)[2][2][4][2], const Unit& u, int wr, int wc, int fr, int fq) const {
        const int row0 = u.pm * 256 + wr * 64 + fr, col0 = u.pn * 256 + wc * 32 + 8 * fq;
#pragma unroll
        for (int ai = 0; ai < 2; ++ai)
#pragma unroll
            for (int m = 0; m < 4; ++m) { bf16* rowp = O + (size_t)(row0 + ai * 128 + m * 16) * ldc + col0;
#pragma unroll
                for (int bj = 0; bj < 2; ++bj) { const f32x4 v0 = acc[ai][bj][m][0], v1 = acc[ai][bj][m][1]; v4u w;
                    w.x = pk2(v0[0], v0[1]); w.y = pk2(v0[2], v0[3]); w.z = pk2(v1[0], v1[1]); w.w = pk2(v1[2], v1[3]); *(GAS v4u*)(rowp + bj * 128) = w; } }
    }
};
struct EpiKV {
    static constexpr bool PERM = true, AFTER_DRAIN = false;
    bf16* KH; bf16* VH; const bf16* KRG; const float* KSS; const float* gkn;
    __device__ __forceinline__ void operator()(const f32x4 (&acc)[2][2][4][2], const Unit& u, int wr, int wc, int fr, int fq) const {
        const int row0 = u.pm * 256 + wr * 64 + fr, roff = NMETA * ((u.pm >> 3) + 1);
        if (u.pn < 2) {
            const int head = u.pn * 4 + wc;
            f32x4 g[2][2];
#pragma unroll
            for (int bj = 0; bj < 2; ++bj)
#pragma unroll
                for (int n = 0; n < 2; ++n) g[bj][n] = *(const GAS f32x4*)(gkn + 32 * bj + 8 * fq + 4 * n);
#pragma unroll
            for (int ai = 0; ai < 2; ++ai)
#pragma unroll
                for (int m = 0; m < 4; ++m) { const size_t R = (size_t)(row0 + ai * 128 + m * 16 + roff);
                    float ss = 0.f;
#pragma unroll
                    for (int bj = 0; bj < 2; ++bj)
#pragma unroll
                        for (int n = 0; n < 2; ++n) { const f32x4 v = acc[ai][bj][m][n]; ss += (v[0] * v[0] + v[1] * v[1]) + (v[2] * v[2] + v[3] * v[3]); }
                    ss = sum_x32(sum_x16(ss));
                    const float rstd = frsqrt((ss + KSS[R]) * (1.f / QKH) + EPS);
                    bf16* kp = KH + R * 768 + head * QKH;
#pragma unroll
                    for (int bj = 0; bj < 2; ++bj) { const f32x4 v0 = acc[ai][bj][m][0] * g[bj][0] * rstd, v1 = acc[ai][bj][m][1] * g[bj][1] * rstd; v4u w;
                        w.x = pk2(v0[0], v0[1]); w.y = pk2(v0[2], v0[3]); w.z = pk2(v1[0], v1[1]); w.w = pk2(v1[2], v1[3]); *(GAS v4u*)(kp + 32 * bj + 8 * fq) = w; }
                    const v4u kr = *(const GAS v4u*)(KRG + R * 32 + 8 * fq); v4u w;
                    w.x = pk2(bflo(kr.x) * rstd, bfhi(kr.x) * rstd); w.y = pk2(bflo(kr.y) * rstd, bfhi(kr.y) * rstd); w.z = pk2(bflo(kr.z) * rstd, bfhi(kr.z) * rstd); w.w = pk2(bflo(kr.w) * rstd, bfhi(kr.w) * rstd);
                    *(GAS v4u*)(kp + 64 + 8 * fq) = w; }
        } else {
            const int col0 = (u.pn - 2) * 256 + wc * 32 + 8 * fq;
#pragma unroll
            for (int ai = 0; ai < 2; ++ai)
#pragma unroll
                for (int m = 0; m < 4; ++m) { bf16* rowp = VH + (size_t)(row0 + ai * 128 + m * 16 + roff) * 1024 + col0;
#pragma unroll
                    for (int bj = 0; bj < 2; ++bj) { const f32x4 v0 = acc[ai][bj][m][0], v1 = acc[ai][bj][m][1]; v4u w;
                        w.x = pk2(v0[0], v0[1]); w.y = pk2(v0[2], v0[3]); w.z = pk2(v1[0], v1[1]); w.w = pk2(v1[2], v1[3]); *(GAS v4u*)(rowp + bj * 128) = w; } }
        }
    }
};
struct EpiPool {
    static constexpr bool PERM = true, AFTER_DRAIN = false;
    bf16* PG; const bf16* GATE; const float* pscale;
    __device__ __forceinline__ void operator()(const f32x4 (&acc)[2][2][4][2], const Unit& u, int wr, int wc, int fr, int fq) const {
        const int row0 = u.pm * 256 + wr * 64 + fr, col0 = u.pn * 256 + wc * 32 + 8 * fq;
        f32x4 ps[2][2];
#pragma unroll
        for (int bj = 0; bj < 2; ++bj)
#pragma unroll
            for (int n = 0; n < 2; ++n) ps[bj][n] = *(const GAS f32x4*)(pscale + col0 + bj * 128 + 4 * n);
#pragma unroll
        for (int ai = 0; ai < 2; ++ai)
#pragma unroll
            for (int m = 0; m < 4; ++m) { const size_t r = (size_t)(row0 + ai * 128 + m * 16);
#pragma unroll
                for (int bj = 0; bj < 2; ++bj) { const v4u gt = *(const GAS v4u*)(GATE + r * 2048 + col0 + bj * 128);
                    const f32x4 v0 = acc[ai][bj][m][0] * ps[bj][0], v1 = acc[ai][bj][m][1] * ps[bj][1]; v4u w;
                    w.x = pk2(v0[0] * bflo(gt.x), v0[1] * bfhi(gt.x)); w.y = pk2(v0[2] * bflo(gt.y), v0[3] * bfhi(gt.y)); w.z = pk2(v1[0] * bflo(gt.z), v1[1] * bfhi(gt.z)); w.w = pk2(v1[2] * bflo(gt.w), v1[3] * bfhi(gt.w));
                    *(GAS v4u*)(PG + r * DM + col0 + bj * 128) = w; } }
    }
};
struct EpiResF32 {
    static constexpr bool PERM = true, AFTER_DRAIN = false;
    float* C; const float* R0; const float* R1; int split_pm;
    __device__ __forceinline__ void operator()(const f32x4 (&acc)[2][2][4][2], const Unit& u, int wr, int wc, int fr, int fq) const {
        const int row0 = u.pm * 256 + wr * 64 + fr, col0 = u.pn * 256 + wc * 32 + 8 * fq;
        const float* rb = u.pm < split_pm ? R0 : R1 - (size_t)split_pm * 256 * DM;
#pragma unroll
        for (int ai = 0; ai < 2; ++ai)
#pragma unroll
            for (int m = 0; m < 4; ++m) { const size_t o = (size_t)(row0 + ai * 128 + m * 16) * DM + col0;
#pragma unroll
                for (int bj = 0; bj < 2; ++bj) { const f32x4 r0 = *(const GAS f32x4*)(rb + o + bj * 128), r1 = *(const GAS f32x4*)(rb + o + bj * 128 + 4);
                    *(GAS f32x4*)(C + o + bj * 128) = acc[ai][bj][m][0] + r0; *(GAS f32x4*)(C + o + bj * 128 + 4) = acc[ai][bj][m][1] + r1; } }
    }
};
struct EpiRelu2 {
    static constexpr bool PERM = true, AFTER_DRAIN = false;
    bf16* Z;
    __device__ __forceinline__ void operator()(const f32x4 (&acc)[2][2][4][2], const Unit& u, int wr, int wc, int fr, int fq) const {
        const int row0 = u.pm * 256 + wr * 64 + fr, col0 = u.pn * 256 + wc * 32 + 8 * fq;
#pragma unroll
        for (int ai = 0; ai < 2; ++ai)
#pragma unroll
            for (int m = 0; m < 4; ++m) { bf16* rowp = Z + (size_t)(row0 + ai * 128 + m * 16) * DFF + col0;
#pragma unroll
                for (int bj = 0; bj < 2; ++bj) { f32x4 v0 = acc[ai][bj][m][0], v1 = acc[ai][bj][m][1];
#pragma unroll
                    for (int j = 0; j < 4; ++j) { const float a = fmaxf(v0[j], 0.f), b = fmaxf(v1[j], 0.f); v0[j] = a * a; v1[j] = b * b; }
                    v4u w; w.x = pk2(v0[0], v0[1]); w.y = pk2(v0[2], v0[3]); w.z = pk2(v1[0], v1[1]); w.w = pk2(v1[2], v1[3]); *(GAS v4u*)(rowp + bj * 128) = w; } }
    }
};
namespace pa {
constexpr int SHM = 16384;
#define PA_KSWZ(row, colB) ((row) * 256 + ((colB) ^ (((row) & 7) << 4)))
__device__ __forceinline__ int v_st(int k, int c) { const int kk = (k & ~0xC) | ((k & 4) << 1) | ((k & 8) >> 1); return ((kk >> 3) * 4 + (c >> 5)) * 512 + ((kk & 7) * 32 + (c & 31)) * 2; }
__device__ __forceinline__ int v_rd_base(int lane) { return ((lane & 3) << 3) | (((lane >> 2) & 3) << 6) | (((lane >> 4) & 1) << 5) | (((lane >> 5) & 1) << 8); }
constexpr int v_rd_off(int d0, int ks, int half) { return d0 * 512 + ks * 4096 + half * 2048; }
__device__ __forceinline__ int crow(int r, int hi) { return (r & 3) + 8 * (r >> 2) + 4 * hi; }

template <int KB>
__device__ __forceinline__ void qkt(f32x16& p0, f32x16& p1, const char* K_lds, int r32, int hi, const bf16x8* qr) {
    p0 = f32x16{}; p1 = f32x16{};
    const char* kb[4];
#pragma unroll
    for (int dd = 0; dd < 4; ++dd) kb[dd] = K_lds + KB * SHM + PA_KSWZ(r32, (dd * 16 + hi * 8) * 2);
#pragma unroll
    for (int d0 = 0; d0 < 6; ++d0) { const char* a = kb[d0 & 3] + (d0 >> 2) * 128;
        const bf16x8 b0 = *reinterpret_cast<const bf16x8*>(a);
        const bf16x8 b1 = *reinterpret_cast<const bf16x8*>(a + 32 * 256);
        p0 = __builtin_amdgcn_mfma_f32_32x32x16_bf16(b0, qr[d0], p0, 0, 0, 0);
        p1 = __builtin_amdgcn_mfma_f32_32x32x16_bf16(b1, qr[d0], p1, 0, 0, 0); }
}
template <int VB>
__device__ __forceinline__ void pv_tile(f32x16* o, int vb0, bf16x8 pa0, bf16x8 pa1, bf16x8 pa2, bf16x8 pa3) {
#define TRRD(dst, off) asm volatile("ds_read_b64_tr_b16 %0, %1 offset:%2" : "=&v"(dst) : "v"(vb0), "i"(off) : "memory")
#define PV_D0(d0) do { s16x4 l0, l1, l2, l3, h0, h1, h2, h3; constexpr int b_ = VB * SHM + v_rd_off(d0, 0, 0); \
        TRRD(l0, b_); TRRD(h0, b_ + 2048); TRRD(l1, b_ + 4096); TRRD(h1, b_ + 6144); TRRD(l2, b_ + 8192); TRRD(h2, b_ + 10240); TRRD(l3, b_ + 12288); TRRD(h3, b_ + 14336); \
        asm volatile("s_waitcnt lgkmcnt(0)" ::: "memory"); SBAR(); \
        o[d0] = __builtin_amdgcn_mfma_f32_32x32x16_bf16(pa0, (bf16x8){l0[0], l0[1], l0[2], l0[3], h0[0], h0[1], h0[2], h0[3]}, o[d0], 0, 0, 0); \
        o[d0] = __builtin_amdgcn_mfma_f32_32x32x16_bf16(pa1, (bf16x8){l1[0], l1[1], l1[2], l1[3], h1[0], h1[1], h1[2], h1[3]}, o[d0], 0, 0, 0); \
        o[d0] = __builtin_amdgcn_mfma_f32_32x32x16_bf16(pa2, (bf16x8){l2[0], l2[1], l2[2], l2[3], h2[0], h2[1], h2[2], h2[3]}, o[d0], 0, 0, 0); \
        o[d0] = __builtin_amdgcn_mfma_f32_32x32x16_bf16(pa3, (bf16x8){l3[0], l3[1], l3[2], l3[3], h3[0], h3[1], h3[2], h3[3]}, o[d0], 0, 0, 0); } while (0)
    PV_D0(0); PV_D0(1); PV_D0(2); PV_D0(3);
#undef PV_D0
#undef TRRD
}
__device__ __forceinline__ void mask_tile(f32x16& p0, f32x16& p1, int dq) {
    const float NEG = -__builtin_inff();
#pragma unroll
    for (int r = 0; r < 16; ++r) { const int c = (r & 3) + 8 * (r >> 2);
        if (dq - c < 0) p0[r] = NEG;
        if (dq - c - 32 < 0) p1[r] = NEG; }
}
__device__ __forceinline__ void exp_half(f32x16& p, float b2) {
#pragma unroll
    for (int r = 0; r < 16; ++r) p[r] = __builtin_amdgcn_exp2f(p[r] - b2);
}
__device__ __forceinline__ void finish(f32x16& p0, f32x16& p1, float b2, float& l_reg, bf16x8& pa0, bf16x8& pa1, bf16x8& pa2, bf16x8& pa3) {
    exp_half(p1, b2);
    float ps = 0.f;
#pragma unroll
    for (int r = 0; r < 16; ++r) ps += p0[r];
#pragma unroll
    for (int r = 0; r < 16; ++r) ps += p1[r];
    ps = sum_x32(ps);
    l_reg += ps;
#define PK4(P, B_, OUT) do { unsigned a0 = pk2(P[B_ + 0], P[B_ + 1]), a1 = pk2(P[B_ + 2], P[B_ + 3]); unsigned b0 = pk2(P[B_ + 4], P[B_ + 5]), b1 = pk2(P[B_ + 6], P[B_ + 7]); \
        auto r0 = __builtin_amdgcn_permlane32_swap(a0, b0, false, false); auto r1 = __builtin_amdgcn_permlane32_swap(a1, b1, false, false); \
        v4u w = {r0[0], r1[0], r0[1], r1[1]}; OUT = *reinterpret_cast<bf16x8*>(&w); } while (0)
    PK4(p0, 0, pa0); PK4(p0, 8, pa1); PK4(p1, 0, pa2); PK4(p1, 8, pa3);
#undef PK4
}
struct Ctx { const bf16* QR; const bf16* KH; const bf16* VH; const bf16* PG; const bf16* GATE; bf16* AM; const float* ROPE; const float* gqn; const float* gqr; float b2; };

__device__ __forceinline__ void unit(const Ctx& C, int b, int h, int j, char* lds) {
    int tid = threadIdx.x; asm volatile("" : "+v"(tid));
    const int wid = __builtin_amdgcn_readfirstlane(tid >> 6), lane = tid & 63, r32 = lane & 31, hi = lane >> 5;
    const int P0 = NMETA + 256 * j, NT = 4 * j + 5;
    const int m0 = b * SEQ + 256 * j;
    char* V_lds = lds; char* K_lds = lds + 2 * SHM; float* li_l = (float*)(lds + 4 * SHM) + wid * 64;
    const bf16* Kh = C.KH + (size_t)b * TT * 768 + h * QKH; const bf16* Vh = C.VH + (size_t)b * TT * 1024 + h * VHD;
    bf16x8 qr[6];
    { const int mrow = m0 + wid * 32 + r32, pos = P0 + wid * 32 + r32;
      const bf16* qp = C.QR + (size_t)mrow * 768 + h * QKH + hi * 8;
      float f[6][8]; float ss = 0.f;
#pragma unroll
      for (int d0 = 0; d0 < 6; ++d0) { const v4u q = *(const GAS v4u*)(qp + d0 * 16);
          f[d0][0] = bflo(q.x); f[d0][1] = bfhi(q.x); f[d0][2] = bflo(q.y); f[d0][3] = bfhi(q.y); f[d0][4] = bflo(q.z); f[d0][5] = bfhi(q.z); f[d0][6] = bflo(q.w); f[d0][7] = bfhi(q.w);
#pragma unroll
          for (int e = 0; e < 8; ++e) ss += f[d0][e] * f[d0][e]; }
      ss = sum_x32(ss);
      const float rs = frsqrt(ss * (1.f / QKH) + EPS) * SCALE_L2E;
      const float* rp = C.ROPE + (size_t)pos * 32 + hi * 8;
#pragma unroll
      for (int e = 0; e < 8; ++e) { const float cs = rp[e], sn = rp[16 + e], x1 = f[4][e], x2 = f[5][e], g = C.gqr[hi * 8 + e] * rs;
          f[4][e] = (x1 * cs - x2 * sn) * g; f[5][e] = (x2 * cs + x1 * sn) * g; }
#pragma unroll
      for (int d0 = 0; d0 < 4; ++d0)
#pragma unroll
          for (int e = 0; e < 8; ++e) f[d0][e] *= C.gqn[d0 * 16 + hi * 8 + e] * rs;
#pragma unroll
      for (int d0 = 0; d0 < 6; ++d0) { v4u w; w.x = pk2(f[d0][0], f[d0][1]); w.y = pk2(f[d0][2], f[d0][3]); w.z = pk2(f[d0][4], f[d0][5]); w.w = pk2(f[d0][6], f[d0][7]); qr[d0] = *reinterpret_cast<bf16x8*>(&w); }
    }
    const int sr = tid >> 4, sc = (tid & 15) * 8, vst0 = v_st(sr, sc), vst1 = v_st(32 + sr, sc), kws = PA_KSWZ(sr, sc * 2);
    const int vb0 = (int)(uintptr_t)V_lds + v_rd_base(lane);
    const int qpos = P0 + wid * 32 + r32 - 4 * hi, qlo = P0 + wid * 32;
    const float b2 = C.b2;
    bf16x8 st_v0, st_v1, st_k0, st_k1;
    const unsigned kvo = (unsigned)(sr * 768 + sc) * 2u, vvo = (unsigned)(sr * 1024 + sc) * 2u;
#define SLOAD(k0) do { const char* kt_ = (const char*)Kh + (size_t)(k0) * 1536; const char* vt_ = (const char*)Vh + (size_t)(k0) * 2048; \
        st_v0 = *(const GAS bf16x8*)(vt_ + vvo); st_v1 = *(const GAS bf16x8*)(vt_ + 65536 + vvo); st_k0 = *(const GAS bf16x8*)(kt_ + kvo); st_k1 = *(const GAS bf16x8*)(kt_ + 49152 + kvo); } while (0)
#define SWRITE(bf) do { *(bf16x8*)(V_lds + (bf) * SHM + vst0) = st_v0; *(bf16x8*)(V_lds + (bf) * SHM + vst1) = st_v1; *(bf16x8*)(K_lds + (bf) * SHM + kws) = st_k0; *(bf16x8*)(K_lds + (bf) * SHM + kws + 32 * 256) = st_k1; } while (0)
#define MASKT(PX0, PX1, t) do { const int kb_ = (t) * 64; if (kb_ + 63 > qlo) mask_tile(PX0, PX1, qpos - kb_); } while (0)
    float l_reg = 0.f; f32x16 o[4] = {};
    f32x16 pA0, pA1, pB0, pB1; bf16x8 pa0, pa1, pa2, pa3;
    SLOAD(0); VM_WAIT(); SWRITE(0); SBAR();
    SLOAD(64);
    __syncthreads();
    SBAR(); qkt<0>(pA0, pA1, K_lds, r32, hi, qr);
    MASKT(pA0, pA1, 0); exp_half(pA0, b2);
    VM_WAIT(); SWRITE(1);
    __syncthreads();
#define HALF_STEP(PX0, PX1, PY0, PY1, t, KB, VB, SB) do { \
        SBAR(); qkt<KB>(PX0, PX1, K_lds, r32, hi, qr); \
        finish(PY0, PY1, b2, l_reg, pa0, pa1, pa2, pa3); SBAR(); \
        if ((t) + 1 < NT) { SLOAD(((t) + 1) * 64); SBAR(); } \
        pv_tile<VB>(o, vb0, pa0, pa1, pa2, pa3); MASKT(PX0, PX1, (t)); exp_half(PX0, b2); \
        __syncthreads(); \
        if ((t) + 1 < NT) { VM_WAIT(); SWRITE(SB); } \
        __syncthreads(); } while (0)
    for (int t = 1; t + 1 < NT; t += 2) {
        HALF_STEP(pB0, pB1, pA0, pA1, t, 1, 0, 0);
        HALF_STEP(pA0, pA1, pB0, pB1, t + 1, 0, 1, 1);
    }
    finish(pA0, pA1, b2, l_reg, pa0, pa1, pa2, pa3); SBAR();
    pv_tile<0>(o, vb0, pa0, pa1, pa2, pa3);
    if (hi == 0) li_l[r32] = l_reg;
    asm volatile("s_waitcnt lgkmcnt(0)" ::: "memory");
    float rli[16];
#pragma unroll
    for (int r = 0; r < 16; ++r) rli[r] = __builtin_amdgcn_rcpf(li_l[crow(r, hi)]);
#pragma unroll
    for (int r = 0; r < 16; ++r) { const size_t mrow = (size_t)(m0 + wid * 32 + crow(r, hi));
#pragma unroll
        for (int d0 = 0; d0 < 4; ++d0) { const int col = h * VHD + d0 * 32 + r32;
            const float g = bflo((unsigned)C.GATE[mrow * 2048 + DM + col]), pg = bflo((unsigned)C.PG[mrow * DM + col]);
            C.AM[mrow * DM + col] = (bf16)f2bf(pg + g * (o[d0][r] * rli[r])); } }
    __syncthreads();
#undef HALF_STEP
#undef MASKT
#undef SWRITE
#undef SLOAD
}
}
namespace sa {
constexpr int CT_BYTES = 32768, KRT_PITCH = 80, KRT_BYTES = 64 * KRT_PITCH, PL_PITCH = 144, PL_BYTES = 64 * PL_PITCH;
constexpr int OFF_CT = 0, OFF_KRT = 3 * CT_BYTES, OFF_KSS = OFF_KRT + 3 * KRT_BYTES, OFF_PL = OFF_KSS + 3 * 256, OFF_PT = OFF_PL + 2 * PL_BYTES, OFF_QF = OFF_PT + 256, OFF_LS = OFF_QF + 8 * 1536, OFF_END = OFF_LS + 8 * 1024;
#ifndef SMALL_LDS
static_assert(OFF_END <= RING_BYTES, "sample attention LDS");
#endif
__device__ __forceinline__ unsigned off_b(unsigned row, unsigned ch) { return 256u * row + 16u * (ch ^ (((row & 3) << 2) | ((row >> 2) & 3))); }
typedef float f32x4_t __attribute__((ext_vector_type(4)));
struct Ctx { const float* cache_c; const float* cache_kr; const int* page_table; const float* new_c; const float* new_kr; const bf16* QR; const bf16* Wuk_t; const float* ROPE;
             const float *gqn, *gqr, *gkn, *gkr; float* SAC; float* SAL; float b2; };

typedef short v4i16_t __attribute__((ext_vector_type(4)));
__device__ __forceinline__ s16x4 tr_read(unsigned addr) { return __builtin_bit_cast(s16x4, __builtin_amdgcn_ds_read_tr16_b64_v4i16((__attribute__((address_space(3))) v4i16_t*)(uintptr_t)addr)); }

__device__ __forceinline__ void item(const Ctx& C, int db, int hf, LAS unsigned char* lds) {
    int tid = threadIdx.x; asm volatile("" : "+v"(tid));
    const int wid = __builtin_amdgcn_readfirstlane(tid >> 6), lane = tid & 63, fr = lane & 15, fq = lane >> 4;
    const int h = wid;
    volatile LAS int* pt = (volatile LAS int*)(lds + OFF_PT);
    { const int* ptg = C.page_table + db * NPAGES + hf * 32; asm volatile("" : "+s"(ptg)); if (tid < 32) pt[tid] = ptg[tid]; }
    {
        bf16x8 Aq0, Aq1, Aqr;
        const int s = fr & 7; const int mrow = MP + db * DSEQ + s;
        const bf16* qrb = C.QR; asm volatile("" : "+s"(qrb));
        const bf16* qp = qrb + (size_t)mrow * 768 + h * QKH;
        float qn[2][8], qro[8], ss = 0.f;
#pragma unroll
        for (int ii = 0; ii < 2; ++ii)
#pragma unroll
            for (int j = 0; j < 8; ++j) { const int d = 16 * (2 * ii + (j >> 2)) + 4 * fq + (j & 3); const float v = bflo((unsigned)qp[d]); qn[ii][j] = v; ss += v * v; }
        const float* rp = C.ROPE + (size_t)(TT + s) * 32;
#pragma unroll
        for (int j = 0; j < 8; ++j) { const int i = 8 * fq + j, i2 = i & 15; const float own = bflo((unsigned)qp[64 + i]), oth = bflo((unsigned)qp[64 + (i ^ 16)]);
            ss += own * own;
            const float cs = rp[i2], sn = rp[16 + i2];
            qro[j] = (i < 16) ? own * cs - oth * sn : own * cs + oth * sn; }
        ss = sum_x32(sum_x16(ss));
        const float rs = (fr < 8) ? frsqrt(ss * (1.f / QKH) + EPS) * SCALE_L2E : 0.f;
#pragma unroll
        for (int ii = 0; ii < 2; ++ii)
#pragma unroll
            for (int j = 0; j < 8; ++j) { const int d = 16 * (2 * ii + (j >> 2)) + 4 * fq + (j & 3); qn[ii][j] *= rs * C.gqn[d] * C.gkn[d]; }
#pragma unroll
        for (int j = 0; j < 8; ++j) { const int i2 = (8 * fq + j) & 15; qro[j] *= rs * C.gqr[i2] * C.gkr[i2]; }
        v4u w; w.x = pk2(qn[0][0], qn[0][1]); w.y = pk2(qn[0][2], qn[0][3]); w.z = pk2(qn[0][4], qn[0][5]); w.w = pk2(qn[0][6], qn[0][7]); Aq0 = *reinterpret_cast<bf16x8*>(&w);
        w.x = pk2(qn[1][0], qn[1][1]); w.y = pk2(qn[1][2], qn[1][3]); w.z = pk2(qn[1][4], qn[1][5]); w.w = pk2(qn[1][6], qn[1][7]); Aq1 = *reinterpret_cast<bf16x8*>(&w);
        w.x = pk2(qro[0], qro[1]); w.y = pk2(qro[2], qro[3]); w.z = pk2(qro[4], qro[5]); w.w = pk2(qro[6], qro[7]); Aqr = *reinterpret_cast<bf16x8*>(&w);
        if (fr < 8) { LAS bf16x8* qf = (LAS bf16x8*)(lds + OFF_QF + wid * 1536) + fq * 8 + fr; qf[0] = Aq0; qf[32] = Aq1; qf[64] = Aqr; }
        { float z_ = 0.f; asm volatile("" : "+v"(z_)); *((LAS f32x4*)(lds + OFF_LS + wid * 1024) + lane) = (f32x4){z_, z_, z_, z_}; }
    }
    __syncthreads();
    bf16x8 Wf[4][8];
    { const bf16* wp = C.Wuk_t + (size_t)(h * 64 + fr) * KVL + 8 * fq;
#pragma unroll
      for (int i = 0; i < 4; ++i)
#pragma unroll
          for (int ks = 0; ks < 8; ++ks) Wf[i][ks] = *(const GAS bf16x8*)(wp + (size_t)(16 * i) * KVL + 32 * ks); }
    const int NTL = hf ? 65 : 64;
    const unsigned xr = ((fr & 3) << 2) | ((fr >> 2) & 3);
#define SA_STAGE(tt) do { const int t_ = (tt), bf_ = t_ % 3; \
        LAS unsigned char* ct_ = lds + OFF_CT + bf_ * CT_BYTES + (lane >> 5) * 16384; const unsigned co_ = ((lane & 31) >> 1), cb_ = 8 * (lane & 1); \
        LAS unsigned char* kr_ = lds + OFF_KRT + bf_ * KRT_BYTES + (tid >> 3) * KRT_PITCH + (tid & 7) * 8; LAS float* ks_ = (LAS float*)(lds + OFF_KSS + bf_ * 256 + (tid >> 3) * 4); \
        if (t_ < 64) { const size_t phys = (size_t)pt[t_ >> 1]; const float* cp = C.cache_c + (phys * PAGE + (t_ & 1) * 64) * KVL; const float* kp = C.cache_kr + (phys * PAGE + (t_ & 1) * 64) * QKR; \
            f32x4 cst[8]; \
            _Pragma("unroll") for (int i = 0; i < 8; ++i) cst[i] = __builtin_nontemporal_load((const GAS f32x4*)(cp + (size_t)(i * 8 + wid) * KVL) + lane); \
            const f32x4 kst = __builtin_nontemporal_load((const GAS f32x4*)kp + tid); \
            _Pragma("unroll") for (int i = 0; i < 8; ++i) { v2u w_; w_.x = pk2(cst[i].x, cst[i].y); w_.y = pk2(cst[i].z, cst[i].w); *(LAS v2u*)(ct_ + off_b(i * 8 + wid, co_) + cb_) = w_; } \
            { v2u w_; w_.x = pk2(kst.x, kst.y); w_.y = pk2(kst.z, kst.w); *(LAS v2u*)kr_ = w_; \
              float s_ = (kst.x * kst.x + kst.y * kst.y) + (kst.z * kst.z + kst.w * kst.w); s_ = sum_oct(s_); if ((tid & 7) == 0) *ks_ = s_; } } \
        else {   \
            int ln_ = lane, td_ = tid; asm volatile("" : "+v"(ln_), "+v"(td_));   \
            const f32x4 c0_ = *((const GAS f32x4*)(C.new_c + (size_t)(db * DSEQ + wid) * KVL) + ln_); \
            { v2u w_; w_.x = pk2(c0_.x, c0_.y); w_.y = pk2(c0_.z, c0_.w); *(LAS v2u*)(ct_ + off_b(wid, co_) + cb_) = w_; } \
            _Pragma("unroll") for (int i = 1; i < 8; ++i) { v2u z_; z_.x = 0u; z_.y = 0u; *(LAS v2u*)(ct_ + off_b(i * 8 + wid, co_) + cb_) = z_; } \
            float s_ = 0.f; v2u w_; w_.x = 0u; w_.y = 0u; \
            if (td_ < 64) { const f32x4 kst = *((const GAS f32x4*)(C.new_kr + (size_t)db * DSEQ * QKR) + td_); w_.x = pk2(kst.x, kst.y); w_.y = pk2(kst.z, kst.w); s_ = (kst.x * kst.x + kst.y * kst.y) + (kst.z * kst.z + kst.w * kst.w); } \
            *(LAS v2u*)kr_ = w_; s_ = sum_oct(s_); if ((tid & 7) == 0) *ks_ = s_; } } while (0)
    f32x4 ctx[4][2];
#pragma unroll
    for (int rt = 0; rt < 4; ++rt) { ctx[rt][0] = (f32x4){0.f, 0.f, 0.f, 0.f}; ctx[rt][1] = (f32x4){0.f, 0.f, 0.f, 0.f}; }
    SA_STAGE(0);
    __syncthreads();
    const float b2 = C.b2;
    const int hh = wid >> 2, c0 = 2 * (wid & 3);
    for (int t = 0; t < NTL; ++t) {
        const int bf = t % 3, pb = t & 1;
        if (t + 1 < NTL) SA_STAGE(t + 1);
        const LAS unsigned char* ct = lds + OFF_CT + bf * CT_BYTES;
#pragma unroll 1
        for (int kg = 0; kg < 4; ++kg) {
            f32x4 X[4];
#pragma unroll
            for (int i = 0; i < 4; ++i) X[i] = (f32x4){0.f, 0.f, 0.f, 0.f};
            const LAS unsigned char* rb = ct + 256 * (kg * 16 + fr);
#pragma unroll
            for (int ks = 0; ks < 8; ++ks) {
                const bf16x8 bfr = *(const LAS bf16x8*)(rb + (ks >> 2) * 16384 + 16 * (((ks & 3) * 4 + fq) ^ xr));
#pragma unroll
                for (int i = 0; i < 4; ++i) X[i] = __builtin_amdgcn_mfma_f32_16x16x32_bf16(Wf[i][ks], bfr, X[i], 0, 0, 0);
            }
            float ss = 0.f;
#pragma unroll
            for (int i = 0; i < 4; ++i) ss += (X[i].x * X[i].x + X[i].y * X[i].y) + (X[i].z * X[i].z + X[i].w * X[i].w);
            ss = sum_x32(sum_x16(ss));
            const float krss = *(const LAS float*)(lds + OFF_KSS + bf * 256 + (kg * 16 + fr) * 4);
            const float rstd = frsqrt((ss + krss) * (1.f / QKH) + EPS);
            v4u w0, w1; w0.x = pk2(X[0].x, X[0].y); w0.y = pk2(X[0].z, X[0].w); w0.z = pk2(X[1].x, X[1].y); w0.w = pk2(X[1].z, X[1].w);
            w1.x = pk2(X[2].x, X[2].y); w1.y = pk2(X[2].z, X[2].w); w1.z = pk2(X[3].x, X[3].y); w1.w = pk2(X[3].z, X[3].w);
            const bf16x8 krf = *(const LAS bf16x8*)(lds + OFF_KRT + bf * KRT_BYTES + (kg * 16 + fr) * KRT_PITCH + fq * 16);
            f32x4 S = (f32x4){0.f, 0.f, 0.f, 0.f};
            const LAS bf16x8* qf = (const LAS bf16x8*)(lds + OFF_QF + wid * 1536) + fq * 8 + (fr & 7); const bf16x8 zf = (bf16x8){0, 0, 0, 0, 0, 0, 0, 0};
            const bf16x8 Aq0 = fr < 8 ? qf[0] : zf, Aq1 = fr < 8 ? qf[32] : zf, Aqr = fr < 8 ? qf[64] : zf;
            S = __builtin_amdgcn_mfma_f32_16x16x32_bf16(Aq0, *reinterpret_cast<bf16x8*>(&w0), S, 0, 0, 0);
            S = __builtin_amdgcn_mfma_f32_16x16x32_bf16(Aq1, *reinterpret_cast<bf16x8*>(&w1), S, 0, 0, 0);
            S = __builtin_amdgcn_mfma_f32_16x16x32_bf16(Aqr, krf, S, 0, 0, 0);
            f32x4 p;
#pragma unroll
            for (int e = 0; e < 4; ++e) p[e] = __builtin_amdgcn_exp2f(S[e] * rstd - b2);
            if (t == 64) {
                const int kk = kg * 16 + fr;
#pragma unroll
                for (int e = 0; e < 4; ++e) if (kk > 4 * fq + e) p[e] = 0.f;
            }
            if (fq < 2) {
                LAS f32x4* lsp = (LAS f32x4*)(lds + OFF_LS + wid * 1024) + lane; *lsp = *lsp + p;
                LAS bf16* pl = (LAS bf16*)(lds + OFF_PL + pb * PL_BYTES + (h * 8 + 4 * fq) * PL_PITCH) + kg * 16 + fr;
#pragma unroll
                for (int e = 0; e < 4; ++e) pl[e * (PL_PITCH / 2)] = (bf16)f2bf(p[e]);
            }
        }
        __syncthreads();
        const unsigned ctb = (unsigned)(uintptr_t)(lds + OFF_CT + bf * CT_BYTES) + hh * 16384;
        const LAS unsigned char* plb = lds + OFF_PL + pb * PL_BYTES + fr * PL_PITCH + fq * 16;
#pragma unroll
        for (int ks = 0; ks < 2; ++ks) {
            bf16x8 Bf[2];
#pragma unroll
            for (int cb = 0; cb < 2; ++cb) {
                s16x4 tv[2];
#pragma unroll
                for (int tq = 0; tq < 2; ++tq) { const unsigned row = 32 * ks + 8 * fq + 4 * tq + ((lane & 15) >> 2), pp = lane & 3;
                    tv[tq] = tr_read(ctb + off_b(row, 2 * (c0 + cb) + (pp >> 1)) + 8 * (pp & 1)); }
                Bf[cb] = (bf16x8){tv[0][0], tv[0][1], tv[0][2], tv[0][3], tv[1][0], tv[1][1], tv[1][2], tv[1][3]};
            }
#pragma unroll
            for (int rt = 0; rt < 4; ++rt) {
                const bf16x8 A = *(const LAS bf16x8*)(plb + rt * 16 * PL_PITCH + ks * 64);
                ctx[rt][0] = __builtin_amdgcn_mfma_f32_16x16x32_bf16(A, Bf[0], ctx[rt][0], 0, 0, 0);
                ctx[rt][1] = __builtin_amdgcn_mfma_f32_16x16x32_bf16(A, Bf[1], ctx[rt][1], 0, 0, 0);
            }
        }
    }
    const int it = db * 2 + hf;
    f32x4 lsum = *((LAS f32x4*)(lds + OFF_LS + wid * 1024) + lane);
    lsum.x = sum_row16(lsum.x); lsum.y = sum_row16(lsum.y); lsum.z = sum_row16(lsum.z); lsum.w = sum_row16(lsum.w);
    if (fr == 0 && fq < 2) *(GAS f32x4*)(C.SAL + (size_t)it * 64 + h * 8 + 4 * fq) = lsum;
    float* cp = C.SAC + (size_t)it * 64 * 256;
#pragma unroll
    for (int rt = 0; rt < 4; ++rt)
#pragma unroll
        for (int cb = 0; cb < 2; ++cb)
#pragma unroll
            for (int e = 0; e < 4; ++e) cp[(size_t)(rt * 16 + 4 * fq + e) * 256 + hh * 128 + 16 * (c0 + cb) + fr] = ctx[rt][cb][e];
    __syncthreads();
#undef SA_STAGE
}
}
namespace g2 {
using pg8::Unit; using pg8::Gemm;
constexpr int TILE_BYTES = 32768, BUF_BYTES = 65536;
template <class Epi, class Sched>
__device__ __forceinline__ void gemm_phase(LAS unsigned char* lds, const Gemm g, const Sched& S, const Epi& E) {
    int tid = threadIdx.x; asm volatile("" : "+v"(tid));
    const int wid = __builtin_amdgcn_readfirstlane(tid >> 6), lane = tid & 63, wr = wid >> 2, wc = wid & 3, fr = lane & 15, fq = lane >> 4;
    const int K = g.K, nt = K / 64;
    Unit cur, nxt;
    if (!S.next(0, cur)) return;
    const int srow = tid >> 3, sch = tid & 7;
    const int rb0 = Epi::PERM ? ((srow & ~31) + pg8::perm32(srow & 31)) : srow;
    const unsigned goffA0 = (unsigned)(srow * K + sch * 8) * 2u, goffB0 = (unsigned)(rb0 * K + sch * 8) * 2u, loff0 = (unsigned)(srow * 128 + ((sch ^ (srow & 7)) << 4));
    const size_t rstep = (size_t)64 * K * 2;
    const size_t tstep = (size_t)256 * K * 2;
    const unsigned cx0 = (unsigned)(((0 + fq) ^ (fr & 7)) << 4), cx1 = (unsigned)(((4 + fq) ^ (fr & 7)) << 4);
    const unsigned abase = (unsigned)((64 * wr + fr) * 128), bbase = (unsigned)(TILE_BYTES + (32 * wc + fr) * 128);
    v4u sa[4], sb[4];
#define G2_LOAD(pa, pb, kt) do { const char* a_ = (pa) + (size_t)(kt) * 128; const char* b_ = (pb) + (size_t)(kt) * 128; \
        _Pragma("unroll") for (int i = 0; i < 4; ++i) { sa[i] = *(const GAS v4u*)(a_ + i * rstep + goffA0); sb[i] = *(const GAS v4u*)(b_ + i * rstep + goffB0); } } while (0)
#define G2_WRITE(buf) do { LAS unsigned char* d_ = lds + (buf) * BUF_BYTES; \
        _Pragma("unroll") for (int i = 0; i < 4; ++i) { *(LAS v4u*)(d_ + i * 8192 + loff0) = sa[i]; *(LAS v4u*)(d_ + TILE_BYTES + i * 8192 + loff0) = sb[i]; } } while (0)
    pg8::f32x4 acc[2][2][4][2];
#define G2_ZERO() do { _Pragma("unroll") for (int a = 0; a < 2; ++a) _Pragma("unroll") for (int b = 0; b < 2; ++b) _Pragma("unroll") for (int m = 0; m < 4; ++m) _Pragma("unroll") for (int n = 0; n < 2; ++n) acc[a][b][m][n] = (pg8::f32x4){0.f, 0.f, 0.f, 0.f}; } while (0)
    G2_ZERO();
    const char* cA = (const char*)g.A + (size_t)cur.pm * tstep; const char* cB = (const char*)g.Bt + (size_t)cur.pn * tstep;
    G2_LOAD(cA, cB, 0); VM_WAIT(); G2_WRITE(0);
    __syncthreads();
    int buf = 0, ui = 0;
    for (;;) {
        const bool has_next = S.next(ui + 1, nxt);
        const char* nA = has_next ? (const char*)g.A + (size_t)nxt.pm * tstep : cA; const char* nB = has_next ? (const char*)g.Bt + (size_t)nxt.pn * tstep : cB;
        for (int kt = 0; kt < nt; ++kt) {
            const bool last = (kt == nt - 1);
            const bool pre = !last || has_next;
            if (pre) { if (last) G2_LOAD(nA, nB, 0); else G2_LOAD(cA, cB, kt + 1); }
            const LAS unsigned char* tb = lds + buf * BUF_BYTES;
#pragma unroll
            for (int ks = 0; ks < 2; ++ks) {
                const unsigned cx = ks ? cx1 : cx0;
                pg8::bf16x8 bf[2][2];
#pragma unroll
                for (int bj = 0; bj < 2; ++bj)
#pragma unroll
                    for (int n = 0; n < 2; ++n) bf[bj][n] = *(const LAS pg8::bf16x8*)(tb + bbase + (128 * bj + 16 * n) * 128 + cx);
#pragma unroll
                for (int ai = 0; ai < 2; ++ai) {
                    pg8::bf16x8 af[4];
#pragma unroll
                    for (int m = 0; m < 4; ++m) af[m] = *(const LAS pg8::bf16x8*)(tb + abase + (128 * ai + 16 * m) * 128 + cx);
#pragma unroll
                    for (int bj = 0; bj < 2; ++bj)
#pragma unroll
                        for (int m = 0; m < 4; ++m)
#pragma unroll
                            for (int n = 0; n < 2; ++n) acc[ai][bj][m][n] = __builtin_amdgcn_mfma_f32_16x16x32_bf16(bf[bj][n], af[m], acc[ai][bj][m][n], 0, 0, 0);
                }
            }
#ifdef G2_SINGLE_BUF
            __syncthreads();
            if (pre) { VM_WAIT(); G2_WRITE(0); }
            __syncthreads();
#else
            if (pre) { VM_WAIT(); G2_WRITE(buf ^ 1); }
            __syncthreads();
            buf ^= 1;
#endif
        }
        E(acc, cur, wr, wc, fr, fq);
        if (!has_next) break;
        G2_ZERO();
        cur = nxt; cA = nA; cB = nB; ++ui;
    }
    __syncthreads();
#undef G2_LOAD
#undef G2_WRITE
#undef G2_ZERO
}
}
__device__ __forceinline__ void p3_meta_kv(Frame& F) {
    const int gw = F.vcu * NWAVES + F.wave, NGW = F.G * NWAVES, lane = F.lane;
    const float* CM = WSP(float, WS_CM); const float* KRM = WSP(float, WS_KRM); const float* KSM = WSP(float, WS_KSM);
    bf16* KH = WSP(bf16, WS_KH); bf16* VH = WSP(bf16, WS_VH);
    for (int t = gw; t < 256; t += NGW) {
        const int i = (t >> 3) & 15, h = t & 7; const float* c = CM + i * KVL;
        if (t < 128) {
            float a = 0.f;
#pragma unroll 8
            for (int r = 0; r < KVL; ++r) a += c[r] * F.w_uk[(size_t)r * 512 + h * 64 + lane];
            const float ss = wave_sum(a * a);
            const float rstd = frsqrt((ss + KSM[i]) * (1.f / QKH) + EPS);
            const bf16 kv = (bf16)f2bf(a * rstd * F.g_kn_nope[lane]);
            const bf16 kr = (bf16)f2bf(KRM[i * 32 + (lane & 31)] * rstd);
            for (int b = 0; b < NBATCH; ++b) { bf16* kp = KH + (size_t)(b * TT + i) * 768 + h * QKH; kp[lane] = kv; if (lane < 32) kp[64 + lane] = kr; }
        } else {
            float a0 = 0.f, a1 = 0.f;
#pragma unroll 8
            for (int r = 0; r < KVL; ++r) { const float cr = c[r]; a0 += cr * F.w_uv[(size_t)r * 1024 + h * 128 + lane]; a1 += cr * F.w_uv[(size_t)r * 1024 + h * 128 + 64 + lane]; }
            const bf16 v0 = (bf16)f2bf(a0), v1 = (bf16)f2bf(a1);
            for (int b = 0; b < NBATCH; ++b) { bf16* vp = VH + (size_t)(b * TT + i) * 1024 + h * VHD; vp[lane] = v0; vp[64 + lane] = v1; }
        }
    }
}
__device__ __forceinline__ void p1_naive(Frame& F) {
    const bf16* XN = WSP(bf16, WS_XN); const bf16* Win_t = WSP(bf16, WS_WIN); float* PF = WSP(float, WS_PF); bf16* GATE = WSP(bf16, WS_GATE);
    const size_t gt = (size_t)F.vcu * NWAVES * 64 + F.tid, NGT = (size_t)F.G * NWAVES * 64;
    for (size_t idx = gt; idx < (size_t)MC * (NIN / 8); idx += NGT) {
        const size_t m = idx / (NIN / 8); const int n0 = (int)(idx % (NIN / 8)) * 8;
        float acc[8];
#pragma unroll
        for (int j = 0; j < 8; ++j) acc[j] = 0.f;
        for (int k = 0; k < DM; k += 8) {
            const v4u x = *(const GAS v4u*)(XN + m * DM + k);
            const float xf[8] = {bflo(x.x), bfhi(x.x), bflo(x.y), bfhi(x.y), bflo(x.z), bfhi(x.z), bflo(x.w), bfhi(x.w)};
#pragma unroll
            for (int j = 0; j < 8; ++j) { const v4u w = *(const GAS v4u*)(Win_t + (size_t)(n0 + j) * DM + k);
                acc[j] += xf[0] * bflo(w.x) + xf[1] * bfhi(w.x) + xf[2] * bflo(w.y) + xf[3] * bfhi(w.y) + xf[4] * bflo(w.z) + xf[5] * bfhi(w.z) + xf[6] * bflo(w.w) + xf[7] * bfhi(w.w); }
        }
        if (n0 < PFW) {
#pragma unroll
            for (int j = 0; j < 8; ++j) PF[m * PFW + n0 + j] = acc[j];
        } else {
#pragma unroll
            for (int j = 0; j < 8; ++j) GATE[m * 2048 + (n0 - PFW) + j] = (bf16)f2bf(sigmoidf_fast(acc[j]));
        }
    }
}
__device__ __forceinline__ void p5_unit(Frame& F, int h, int tb) {
    constexpr int PITCH = 528;
    const int tid = F.tid, lane = F.lane, wid = F.wave, fr = lane & 15, fq = lane >> 4;
    LAS unsigned char* At = F.lds; LAS unsigned char* Bt = F.lds + 128 * PITCH;
    const float* SAC = WSP(float, WS_SAC); const float* SAL = WSP(float, WS_SAL); const bf16* Wuv_t = WSP(bf16, WS_WKV) + (size_t)512 * KVL;
    for (int e = tid; e < 128 * 64; e += NWAVES * 64) { const int row = e >> 6, c4 = e & 63, tok = tb * 128 + row, db = tok >> 3, r = h * 8 + (tok & 7);
        const f32x4 a = *((const GAS f32x4*)(SAC + ((size_t)(2 * db) * 64 + r) * 256) + c4), b = *((const GAS f32x4*)(SAC + ((size_t)(2 * db + 1) * 64 + r) * 256) + c4);
        const float il = 1.0f / (SAL[(2 * db) * 64 + r] + SAL[(2 * db + 1) * 64 + r]);
        v2u w; w.x = pk2((a.x + b.x) * il, (a.y + b.y) * il); w.y = pk2((a.z + b.z) * il, (a.w + b.w) * il);
        *(LAS v2u*)(At + row * PITCH + c4 * 8) = w; }
    for (int e = tid; e < 128 * 32; e += NWAVES * 64) { const int row = e >> 5, ch = e & 31;
        *(LAS v4u*)(Bt + row * PITCH + ch * 16) = *(const GAS v4u*)(Wuv_t + (size_t)(h * 128 + row) * KVL + ch * 8); }
    __syncthreads();
    f32x4 acc[2][4];
#pragma unroll
    for (int rt = 0; rt < 2; ++rt)
#pragma unroll
        for (int ct = 0; ct < 4; ++ct) acc[rt][ct] = (f32x4){0.f, 0.f, 0.f, 0.f};
    const int rbase = (wid >> 1) * 32, cbase = (wid & 1) * 64;
#pragma unroll
    for (int ks = 0; ks < 8; ++ks) {
        bf16x8 af[2], bfm[4];
#pragma unroll
        for (int rt = 0; rt < 2; ++rt) af[rt] = *(const LAS bf16x8*)(At + (rbase + rt * 16 + fr) * PITCH + (32 * ks + 8 * fq) * 2);
#pragma unroll
        for (int ct = 0; ct < 4; ++ct) bfm[ct] = *(const LAS bf16x8*)(Bt + (cbase + ct * 16 + fr) * PITCH + (32 * ks + 8 * fq) * 2);
#pragma unroll
        for (int rt = 0; rt < 2; ++rt)
#pragma unroll
            for (int ct = 0; ct < 4; ++ct) acc[rt][ct] = __builtin_amdgcn_mfma_f32_16x16x32_bf16(af[rt], bfm[ct], acc[rt][ct], 0, 0, 0);
    }
    const bf16* PG = WSP(bf16, WS_PG); const bf16* GATE = WSP(bf16, WS_GATE); bf16* AM = WSP(bf16, WS_AM);
#pragma unroll
    for (int rt = 0; rt < 2; ++rt)
#pragma unroll
        for (int e = 0; e < 4; ++e) { const size_t m = (size_t)(MP + tb * 128 + rbase + rt * 16 + 4 * fq + e);
#pragma unroll
            for (int ct = 0; ct < 4; ++ct) { const int col = h * VHD + cbase + ct * 16 + fr;
                const float g = bflo((unsigned)GATE[m * 2048 + DM + col]), pg = bflo((unsigned)PG[m * DM + col]);
                AM[m * DM + col] = (bf16)f2bf(pg + g * acc[rt][ct][e]); } }
    __syncthreads();
}
__device__ __forceinline__ void p7_hn(Frame& F) {
    const int gw = F.vcu * NWAVES + F.wave, NGW = F.G * NWAVES, lane = F.lane;
    const float* H = WSP(float, WS_H); bf16* HN = WSP(bf16, WS_HN);
    f32x4 g4[4];
#pragma unroll
    for (int j = 0; j < 4; ++j) g4[j] = *((const GAS f32x4*)F.g_mlp + lane + 64 * j);
    for (int m = gw; m < MC; m += NGW) {
        const GAS f32x4* xr = (const GAS f32x4*)(H + (size_t)m * DM) + lane;
        f32x4 v[4]; float s = 0.f;
#pragma unroll
        for (int j = 0; j < 4; ++j) { v[j] = xr[64 * j]; s += (v[j].x * v[j].x + v[j].y * v[j].y) + (v[j].z * v[j].z + v[j].w * v[j].w); }
        const float rstd = frsqrt(wave_sum(s) * (1.f / DM) + EPS);
        GAS v2u* o8 = (GAS v2u*)(HN + (size_t)m * DM) + lane;
#pragma unroll
        for (int j = 0; j < 4; ++j) { v2u o; o.x = pk2(v[j].x * rstd * g4[j].x, v[j].y * rstd * g4[j].y); o.y = pk2(v[j].z * rstd * g4[j].z, v[j].w * rstd * g4[j].w); o8[64 * j] = o; }
    }
}

struct Args { const void* in[24]; float* out; unsigned char* ws; int ph_lo, ph_hi; };
#ifdef USE_PG8
#define GEMM_PHASE(EPI) pg8::gemm_phase<EPI, pg8::StaticOrder, PG8_ALIGN, PG8_SP2>
#else
#define GEMM_PHASE(EPI) g2::gemm_phase<EPI, pg8::StaticOrder>
#endif
__device__ __forceinline__ int opaque(int v) { asm volatile("" : "+s"(v)); return v; }
__global__ void __launch_bounds__(NWAVES * 64, 2) mk_fwd(Args args) {
    extern __shared__ __attribute__((aligned(16))) unsigned char lds[];
    Frame F;
    F.lds = (LAS unsigned char*)lds;
    F.MISC = (volatile LAS unsigned*)(F.lds + MISC_OFF);
    F.tid = threadIdx.x; F.lane = F.tid & 63; F.wave = __builtin_amdgcn_readfirstlane(F.tid >> 6);
    F.G = gridDim.x; { const int bx = blockIdx.x; F.vcu = (F.G % 8 == 0) ? (bx % 8) * (F.G / 8) + bx / 8 : bx; }
    F.ws = args.ws; F.out = args.out; F.ctl = (gu32*)(args.ws + WS_CTL);
#define INP(k) ((const float*)args.in[opaque(k)])
    for (int u = F.tid; u < (LDS_BYTES - LDSCTL_OFF) / 4; u += NWAVES * 64) ((LAS unsigned*)(F.lds + LDSCTL_OFF))[u] = 0u;
    __syncthreads();
#ifdef ENTRY_FENCE
    if (F.tid == 0) { __builtin_amdgcn_fence(__ATOMIC_ACQ_REL, "agent"); asm volatile("s_waitcnt vmcnt(0)" ::: "memory"); }
    __syncthreads();
#endif
    XcdBarrier bar = xcd_barrier_post((unsigned*)(F.ctl + CW_BAR), F.MISC + 8);
    const int lo = args.ph_lo, hi = args.ph_hi;
#ifndef PHMASK
#define PHMASK 0x3ff
#endif
#define IN(k) ((((PHMASK) >> (k)) & 1) && lo <= (k) && (k) < hi)
#define SEAM(k) do { if (IN(k) && IN((k) + 1)) xcd_barrier(bar); } while (0)
    const int bx = (int)blockIdx.x;

    if (IN(0)) { F.x_prompt = INP(0); F.x_sample = INP(1); F.meta_tokens = INP(6); F.g_attn = INP(7); F.w_in = INP(8); F.w_uq = INP(10); F.w_uk = INP(14); F.w_uv = INP(17); F.w_pool_map = INP(18);
        F.w_o = INP(20); F.w_ff1 = INP(22); F.w_ff2 = INP(23); p0_prologue(F); }
    SEAM(0);
    if (IN(1)) {
#ifdef TOUCH_P1
        { const size_t gt = (size_t)F.vcu * NWAVES * 64 + F.tid, NGT = (size_t)F.G * NWAVES * 64; unsigned acc_ = 0;
          const GAS v4u* a_ = (const GAS v4u*)WSP(bf16, WS_XN); const GAS v4u* b_ = (const GAS v4u*)WSP(bf16, WS_WIN);
          for (size_t i = gt; i < (size_t)MC * DM / 8; i += NGT) { const v4u v = a_[i]; acc_ += v.x ^ v.y ^ v.z ^ v.w; }
          for (size_t i = gt; i < (size_t)NIN * DM / 8; i += NGT) { const v4u v = b_[i]; acc_ += v.x ^ v.y ^ v.z ^ v.w; }
          if (acc_ == 0x12345678u) F.ctl[8] = acc_; VM_WAIT(); __syncthreads(); }
#endif
#ifdef ZERO_LDS_P1
        for (int u = F.tid; u < 131072 / 16; u += NWAVES * 64) ((LAS v4u*)F.lds)[u] = (v4u){0u, 0u, 0u, 0u};
        __syncthreads();
#endif
#ifdef DELAY_P1
        { const unsigned long long t0 = __builtin_amdgcn_s_memrealtime(); while (__builtin_amdgcn_s_memrealtime() - t0 < 3000000ull) __builtin_amdgcn_s_sleep(8); }
#endif
#ifdef NAIVE_P1
        p1_naive(F);
#else
#ifdef P1_SHAPE_TEST
        pg8::Gemm g{WSP(bf16, WS_XN), WSP(bf16, WS_WIN), MP, 3072, DM}; pg8::StaticOrder S; S.init(MP, 3072, F.G, bx);
#else
        pg8::Gemm g{WSP(bf16, WS_XN), WSP(bf16, WS_WIN), MCX, NIN, DM}; pg8::StaticOrder S; S.init(MCX, NIN, F.G, bx);
#endif
#ifdef SCALAR_EPI
        EpiInProjScalar E{WSP(float, WS_PF), WSP(bf16, WS_GATE)};
        GEMM_PHASE(EpiInProjScalar)(F.lds + RING_OFF, g, S, E);
#else
        EpiInProj E{WSP(float, WS_PF), WSP(bf16, WS_GATE)};
        GEMM_PHASE(EpiInProj)(F.lds + RING_OFF, g, S, E);
#endif
#ifdef TWICE_P1
        __syncthreads();
        GEMM_PHASE(EpiInProj)(F.lds + RING_OFF, g, S, E);
#endif
#ifdef TWICE_DUMMY
        __syncthreads();
        { EpiInProj E2{WSP(float, WS_Z), WSP(bf16, WS_H)}; GEMM_PHASE(EpiInProj)(F.lds + RING_OFF, g, S, E2); }
#endif
#endif
    }
    SEAM(1);
    if (IN(2)) { F.g_kv_lat = INP(11); F.g_q_lat = INP(9); F.g_kn_rope = INP(16); F.state_pool = INP(4); p2_rows(F); p2_pool(F); }
    SEAM(2);
    if (IN(3)) {
        F.w_uk = INP(14); F.w_uv = INP(17); F.g_kn_nope = INP(15); F.pool_scale = INP(19);
#ifndef NO_P3M
        p3_meta_kv(F);
#endif
#ifndef NO_P3Q
        { pg8::Gemm g{WSP(bf16, WS_QL), WSP(bf16, WS_WUQ), MC, 768, opaque(QLORA)}; pg8::StaticOrder S; S.init(MC, 768, F.G, bx);
          EpiPlainBf16 E{WSP(bf16, WS_QR), 768};
          GEMM_PHASE(EpiPlainBf16)(F.lds + RING_OFF, g, S, E); }
        __syncthreads();
#endif
#ifndef NO_P3K
        { pg8::Gemm g{WSP(bf16, WS_CB), WSP(bf16, WS_WKV), MP, 1536, opaque(KVL)}; pg8::StaticOrder S; S.init(MP, 1536, F.G, bx);
          EpiKV E{WSP(bf16, WS_KH), WSP(bf16, WS_VH), WSP(bf16, WS_KRG), WSP(float, WS_KSS), F.g_kn_nope};
          GEMM_PHASE(EpiKV)(F.lds + RING_OFF, g, S, E); }
        __syncthreads();
#endif
#ifndef NO_P3P
        { pg8::Gemm g{WSP(bf16, WS_DP), WSP(bf16, WS_WPL), MC, DM, opaque(PW)}; pg8::StaticOrder S; S.init(MC, DM, F.G, (F.G == 256) ? ((bx + 116) & 255) : bx);
          EpiPool E{WSP(bf16, WS_PG), WSP(bf16, WS_GATE), F.pool_scale};
          GEMM_PHASE(EpiPool)(F.lds + RING_OFF, g, S, E); }
#endif
    }
    SEAM(3);
    if (IN(4)) {
        F.g_qn_nope = INP(12); F.g_qn_rope = INP(13); F.g_kn_nope = INP(15); F.g_kn_rope = INP(16);
        const float gq = fmaxf(wave_max(fabsf(F.g_qn_nope[F.lane])), wave_max(fabsf(F.g_qn_rope[F.lane & 15])));
        const float gk = fmaxf(wave_max(fabsf(F.g_kn_nope[F.lane])), wave_max(fabsf(F.g_kn_rope[F.lane & 15])));
        const float b2 = (float)QKH * SCALE_L2E * gq * gk;
#ifndef NO_PA
        {
            pa::Ctx C{WSP(bf16, WS_QR), WSP(bf16, WS_KH), WSP(bf16, WS_VH), WSP(bf16, WS_PG), WSP(bf16, WS_GATE), WSP(bf16, WS_AM), WSP(float, WS_ROPE), F.g_qn_nope, F.g_qn_rope, b2};
            for (int pr0 = F.vcu * 2; pr0 < 512; pr0 += 2 * F.G) {
#pragma unroll 1
                for (int k = 0; k < 4; ++k) {
                    const int pr = pr0 + (k >> 1); const int bh = pr >> 2, p = pr & 3, j = (k & 1) ? 7 - p : p;
                    pa::unit(C, bh >> 3, bh & 7, j, (char*)lds);
                }
            }
        }
#endif
#ifndef NO_SA
        {
            sa::Ctx C{INP(2), INP(3), (const int*)INP(5), F.out + O_CS, F.out + O_KRS, WSP(bf16, WS_QR), WSP(bf16, WS_WUK), WSP(float, WS_ROPE), F.g_qn_nope, F.g_qn_rope, F.g_kn_nope, F.g_kn_rope,
                      WSP(float, WS_SAC), WSP(float, WS_SAL), b2};
            for (int it = F.vcu; it < 256; it += F.G) sa::item(C, it >> 1, it & 1, F.lds);
        }
#endif
    }
    SEAM(4);
    if (IN(5)) { for (int u = F.vcu; u < 64; u += F.G) p5_unit(F, u >> 3, u & 7); }
    SEAM(5);
    if (IN(6)) {
        pg8::Gemm g{WSP(bf16, WS_AM), WSP(bf16, WS_WO), MC, DM, opaque(DM)}; pg8::StaticOrder S; S.init(MC, DM, F.G, bx);
        EpiResF32 E{WSP(float, WS_H), INP(0), INP(1), MP / 256};
        GEMM_PHASE(EpiResF32)(F.lds + RING_OFF, g, S, E);
    }
    SEAM(6);
    if (IN(7)) { F.g_mlp = INP(21); p7_hn(F); }
    SEAM(7);
    if (IN(8)) {
        pg8::Gemm g{WSP(bf16, WS_HN), WSP(bf16, WS_W1), MC, DFF, opaque(DM)}; pg8::StaticOrder S; S.init(MC, DFF, F.G, bx);
        EpiRelu2 E{WSP(bf16, WS_Z)};
        GEMM_PHASE(EpiRelu2)(F.lds + RING_OFF, g, S, E);
    }
    SEAM(8);
    if (IN(9)) {
        pg8::Gemm g{WSP(bf16, WS_Z), WSP(bf16, WS_W2), MC, DM, opaque(DFF)}; pg8::StaticOrder S; S.init(MC, DM, F.G, bx);
        EpiResF32 E{F.out + O_YP, WSP(float, WS_H), WSP(float, WS_H), 1 << 20};
        GEMM_PHASE(EpiResF32)(F.lds + RING_OFF, g, S, E);
    }
#ifdef ENTRY_FENCE
    asm volatile("s_waitcnt vmcnt(0)" ::: "memory"); __syncthreads();
    if (F.tid == 0) { __builtin_amdgcn_fence(__ATOMIC_RELEASE, "agent"); asm volatile("s_waitcnt vmcnt(0)" ::: "memory"); }
    __syncthreads();
#endif
#ifdef TAG_SMALL
    if (IN(9)) {
        xcd_barrier(bar);
        const size_t gt = (size_t)F.vcu * NWAVES * 64 + F.tid, NGT = (size_t)F.G * NWAVES * 64;
        for (size_t i = O_CP + gt; i < O_END; i += NGT) F.out[i] *= (float)(TAG_SMALL);
    }
#endif
#ifdef CHECK_C
    if (IN(9)) {
        xcd_barrier(bar);
        if (blockIdx.x == 0) {
            const float* xp = INP(0); const float* mt = INP(6); const float* ga = INP(7); const float* win = INP(8); const float* gk = INP(11);
            LAS float* res = (LAS float*)F.lds;
            if (F.wave < 4) {
                const int b = (F.wave == 0) ? 2 : (F.wave == 1 ? 1 : (F.wave == 2 ? 15 : 0));
                const int t = (F.wave == 0) ? 3 : (F.wave == 1 ? 116 : (F.wave == 2 ? 2063 : 16));
                const float* xr = t < 16 ? mt + (size_t)t * DM : xp + ((size_t)b * SEQ + (t - 16)) * DM;
                float ss = 0.f; for (int k = F.lane; k < DM; k += 64) ss += xr[k] * xr[k];
                const float rs = frsqrt(wave_sum(ss) / DM + EPS);
                float c[4] = {0.f, 0.f, 0.f, 0.f};
                for (int k = 0; k < DM; ++k) { const float xn = xr[k] * rs * ga[k];
                    for (int j = 0; j < 4; ++j) c[j] += xn * win[(size_t)k * DIN + 896 + F.lane * 4 + j]; }
                float s2 = c[0] * c[0] + c[1] * c[1] + c[2] * c[2] + c[3] * c[3];
                const float r2 = frsqrt(wave_sum(s2) / KVL + EPS);
                float err = 0.f, refn = 0.f;
                for (int j = 0; j < 4; ++j) { const float ref = c[j] * r2 * gk[F.lane * 4 + j]; const float got = F.out[O_CP + ((size_t)b * TT + t) * KVL + F.lane * 4 + j]; err += (got - ref) * (got - ref); refn += ref * ref; }
                err = wave_sum(err); refn = wave_sum(refn);
                if (F.lane == 0) res[F.wave] = (err > 0.0004f * refn) ? 1.f : 0.f;
            }
            __syncthreads();
            if (F.tid == 0) F.out[O_YP] = 1000.f * (1.f + res[0] + 2.f * res[1] + 4.f * res[2] + 8.f * res[3]);
        }
    }
#endif
#ifdef CHECK_PFM
    if (IN(9)) {
        xcd_barrier(bar);
        if (blockIdx.x == 0) {
            const float* mt = INP(6); const float* ga = INP(7); const float* win = INP(8);
            LAS float* res = (LAS float*)F.lds;
            if (F.wave < 4) {
                const int n = (F.wave == 0) ? 5 : (F.wave == 1 ? 300 : (F.wave == 2 ? 1160 : 200));
                const int col = n < 256 ? 896 + n : (n < 768 ? n - 256 : n);
                const float* xr = mt + (size_t)3 * DM;
                float ss = 0.f; for (int k = F.lane; k < DM; k += 64) ss += xr[k] * xr[k];
                const float rs = frsqrt(wave_sum(ss) / DM + EPS);
                float a = 0.f; for (int k = F.lane; k < DM; k += 64) a += xr[k] * rs * ga[k] * win[(size_t)k * DIN + col];
                a = wave_sum(a);
#if CHECK_PFM == 2
                { const bf16* XNM_ = WSP(bf16, WS_XNM); const bf16* W_ = WSP(bf16, WS_WIN); float a2 = 0.f;
                  for (int k = F.lane; k < DM; k += 64) a2 += bflo((unsigned)XNM_[3 * DM + k]) * bflo((unsigned)W_[(size_t)n * DM + k]);
                  a = wave_sum(a2); }
#elif CHECK_PFM == 3
                { const bf16* XNM_ = WSP(bf16, WS_XNM); float a2 = 0.f;
                  for (int k = F.lane; k < DM; k += 64) a2 += fabsf(bflo((unsigned)XNM_[3 * DM + k]) - xr[k] * rs * ga[k]);
                  a = wave_sum(a2); }
#endif
                const float got = (CHECK_PFM == 3) ? 0.f : WSP(float, WS_PFM)[3 * PFW + n];
                if (F.lane == 0) res[F.wave] = (fabsf(got - a) > 0.03f * fabsf(a) + 0.02f) ? 1.f : 0.f;
            }
            __syncthreads();
            if (F.tid == 0) F.out[O_YP] = 1000.f * (1.f + res[0] + 2.f * res[1] + 4.f * res[2] + 8.f * res[3]);
        }
    }
#endif
#ifdef CHECK_S
    if (IN(9)) {
        xcd_barrier(bar);
        if (blockIdx.x == 0) {
            const float* xp = INP(0); const float* xs = INP(1); const float* sp = INP(4); const float* mt = INP(6); const float* ga = INP(7); const float* win = INP(8); const float* gk = INP(11);
            LAS float* res = (LAS float*)F.lds;
            if (F.wave < 4) {
                const int w = F.wave + 4 * (CHECK_S - 1);
                const int kind = (w == 2 || w == 3 || w == 6 || w == 5) ? 1 : 0;
                const int b = (w == 0) ? 2 : (w == 1 ? 1 : (w == 2 ? 5 : (w == 3 ? 5 : (w == 4 ? 3 : (w == 5 ? 9 : (w == 6 ? 9 : 0))))));
                const int t = (w == 0) ? 3 : (w == 1 ? 116 : (w == 2 ? 3 : (w == 3 ? 3 : (w == 4 ? 2056 : (w == 5 ? 0 : (w == 6 ? 3 : 0))))));
                const float* xr = kind ? xs + ((size_t)b * DSEQ + t) * DM : (t < 16 ? mt + (size_t)t * DM : xp + ((size_t)b * SEQ + (t - 16)) * DM);
                const int pos = kind ? PAST + t : t;
                float ss = 0.f; for (int k = F.lane; k < DM; k += 64) ss += xr[k] * xr[k];
                const float rs = frsqrt(wave_sum(ss) / DM + EPS);
                float err = 0.f, refn = 0.f;
                if (w <= 2) {
                    float a1 = 0.f, a2 = 0.f; const int i = F.lane & 15;
                    for (int k = 0; k < DM; ++k) { const float xn = xr[k] * rs * ga[k]; a1 += xn * win[(size_t)k * DIN + 1152 + i]; a2 += xn * win[(size_t)k * DIN + 1168 + i]; }
                    const double ang = (double)pos * ROPE_INV[i]; const float cs = (float)cos(ang), sn = (float)sin(ang);
                    const float o1 = a1 * cs - a2 * sn, o2 = a2 * cs + a1 * sn;
                    const float* gp = kind ? F.out + O_KRS + ((size_t)b * DSEQ + t) * QKR : F.out + O_KRP + ((size_t)b * TT + t) * QKR;
                    if (F.lane < 16) { err = (gp[i] - o1) * (gp[i] - o1) + (gp[16 + i] - o2) * (gp[16 + i] - o2); refn = o1 * o1 + o2 * o2; }
                } else if (w == 3 || w == 5) {
                    float c[4] = {0.f, 0.f, 0.f, 0.f};
                    for (int k = 0; k < DM; ++k) { const float xn = xr[k] * rs * ga[k]; for (int j = 0; j < 4; ++j) c[j] += xn * win[(size_t)k * DIN + 896 + F.lane * 4 + j]; }
                    const float r2 = frsqrt(wave_sum(c[0] * c[0] + c[1] * c[1] + c[2] * c[2] + c[3] * c[3]) / KVL + EPS);
                    for (int j = 0; j < 4; ++j) { const float ref = c[j] * r2 * gk[F.lane * 4 + j]; const float got = F.out[O_CS + ((size_t)b * DSEQ + t) * KVL + F.lane * 4 + j]; err += (got - ref) * (got - ref); refn += ref * ref; }
                } else if (w == 4 || w == 6) {
                    float u[8] = {0.f, 0.f, 0.f, 0.f, 0.f, 0.f, 0.f, 0.f};
                    for (int k = 0; k < DM; ++k) { const float xn = xr[k] * rs * ga[k]; for (int j = 0; j < 8; ++j) u[j] += xn * win[(size_t)k * DIN + F.lane * 8 + j]; }
                    const float* gp = (w == 4) ? F.out + O_PSP + ((size_t)b * 15 + (t - 2049)) * PW : F.out + O_PSS + ((size_t)b * 15 + 7 + t) * PW;
                    for (int j = 0; j < 8; ++j) { const float got = gp[F.lane * 8 + j]; err += (got - u[j]) * (got - u[j]); refn += u[j] * u[j]; }
                } else if (w == 55) {
                    for (int j = 0; j < 8; ++j) { const float ref = sp[((size_t)b * 15 + 8 + 2) * PW + F.lane * 8 + j]; const float got = F.out[O_PSS + ((size_t)b * 15 + 2) * PW + F.lane * 8 + j]; err += (got - ref) * (got - ref); refn += ref * ref; }
                } else if (w == 7) {
                    const bf16* W_ = WSP(bf16, WS_WIN);
                    for (int j = 0; j < 8; ++j) { const int n = F.lane * 8 + j;
                        for (int k = 0; k < DM; ++k) { const float ref = win[(size_t)k * DIN + n], got = bflo((unsigned)W_[(size_t)(256 + n) * DM + k]); err += (got - ref) * (got - ref); refn += ref * ref; } }
                } else { err = 0.f; refn = 1.f; }
                err = wave_sum(err); refn = wave_sum(refn);
#ifdef CHECK_MAG
                if (F.lane == 0) res[F.wave] = floorf(200.f * sqrtf(err / refn) + 0.5f);
            }
            __syncthreads();
            if (F.tid == 0) F.out[O_YP] = 1000.f * (1.f + res[CHECK_MAG]);
#else
                if (F.lane == 0) res[F.wave] = (err > 0.0004f * refn) ? 1.f : 0.f;
            }
            __syncthreads();
            if (F.tid == 0) F.out[O_YP] = 1000.f * (1.f + res[0] + 2.f * res[1] + 4.f * res[2] + 8.f * res[3]);
#endif
        }
    }
#endif
#ifdef ZERO_META_C
    if (IN(9)) {
        xcd_barrier(bar);
        const size_t gt = (size_t)F.vcu * NWAVES * 64 + F.tid, NGT = (size_t)F.G * NWAVES * 64;
        for (size_t i = gt; i < (size_t)NBATCH * NMETA * KVL; i += NGT) { const size_t b = i / (NMETA * KVL), r = i % (NMETA * KVL); F.out[O_CP + b * TT * KVL + r] = 0.f; }
    }
#endif
#ifdef TAG_Y
    if (IN(9)) {
        xcd_barrier(bar);
        const size_t gt = (size_t)F.vcu * NWAVES * 64 + F.tid, NGT = (size_t)F.G * NWAVES * 64;
        for (size_t i = TAG_Y_LO + gt; i < TAG_Y_HI; i += NGT) F.out[i] *= 1.3f;
    }
#endif
#if defined(DUMP) && DUMP == 99
    if (lo <= 10 && 10 < hi) {
        unsigned e1 = 0, e2 = 0, e3 = 0;
        LAS unsigned* L = (LAS unsigned*)F.lds;
        for (int r = 0; r < 200; ++r) {
            const int slot = (F.tid * 33 + r * 4099) & 32767;
            L[F.tid + 512 * (r & 63)] = (unsigned)(F.tid * 2654435761u + r);
            __syncthreads();
            const int o = (F.tid + 257) & 511;
            if (L[o + 512 * (r & 63)] != (unsigned)(o * 2654435761u + r)) ++e1;
            __syncthreads();
            (void)slot;
        }
        {
            const int fr = F.lane & 15, fq = F.lane >> 4;
            pg8::bf16x8 a, b;
            for (int j = 0; j < 8; ++j) { const int k = 8 * fq + j; a[j] = (short)f2bf((float)((fr + k) % 5 - 2)); b[j] = (short)f2bf((float)((k * 3 + fr) % 7 - 3)); }
            pg8::f32x4 d = (pg8::f32x4){0.f, 0.f, 0.f, 0.f};
            for (int rep = 0; rep < 64; ++rep) d = __builtin_amdgcn_mfma_f32_16x16x32_bf16(a, b, d, 0, 0, 0);
            for (int e = 0; e < 4; ++e) { const int i = 4 * fq + e, jj = fr; float s = 0.f; for (int k = 0; k < 32; ++k) s += (float)((i + k) % 5 - 2) * (float)((k * 3 + jj) % 7 - 3);
                if (d[e] != 64.f * s) ++e2; }
        }
        if (blockDim.x != 512 || gridDim.x != 256 || blockDim.y != 1 || gridDim.y != 1) e3 = 1;
        unsigned e4 = 0, e5 = 0, e6 = 0;
        { const float v = (float)(F.lane + 1); if (wave_sum(v) != 2080.f) e4 = 1;
          const int row = F.lane >> 4; const float want16 = (float)(16 * (16 * row) + 136);
          if (sum_row16(v) != want16) e5 = 1;
          if (wave_max(v) != 64.f) e6 = 1; }
        const float code = (e1 ? 1000.f : 0.f) + (e2 ? 2000.f : 0.f) + (e3 ? 4000.f : 0.f) + (e4 ? 8000.f : 0.f) + (e5 ? 16000.f : 0.f) + (e6 ? 32000.f : 0.f) + 500.f;
#ifdef PROBE_VAL
        { const float v = (float)(F.lane + 1); float r_ = 0.f;
          if (PROBE_VAL == 1) r_ = wave_sum(v); else if (PROBE_VAL == 2) r_ = sum_x16(v); else if (PROBE_VAL == 3) r_ = sum_x32(v); else if (PROBE_VAL == 4) r_ = sum_x16(sum_row16(v)); else if (PROBE_VAL == 5) r_ = sum_x32(sum_row16(v));
          const int pl = PROBE_LANE;
          const float got = __shfl(r_, pl);
          for (int i = F.tid; i < 4096; i += 512) F.out[O_YP + (size_t)blockIdx.x * 4096 + i] = 10.f * got; }
#else
        for (int i = F.tid; i < 4096; i += 512) F.out[O_YP + (size_t)blockIdx.x * 4096 + i] = code;
#endif
    }
#elif defined(DUMP)
    if (lo <= 10 && 10 < hi) {
        const size_t gt = (size_t)F.vcu * NWAVES * 64 + F.tid, NGT = (size_t)F.G * NWAVES * 64;
        for (size_t i = gt; i < (size_t)MP * DM; i += NGT) {
            float v = 0.f;
#if DUMP == 1
            v = WSP(float, WS_PF)[i % ((size_t)MC * PFW)] + bflo((unsigned)WSP(bf16, WS_GATE)[i]) + bflo((unsigned)WSP(bf16, WS_GATE)[i + (size_t)MP * DM]);
#elif DUMP == 99
            v = 0.f;
#elif DUMP == 7
            v = bflo((unsigned)WSP(bf16, WS_XN)[i]) + bflo((unsigned)WSP(bf16, WS_WIN)[i % ((size_t)NIN * DM)]) + bflo((unsigned)WSP(bf16, WS_W1)[i % ((size_t)DFF * DM)]) + bflo((unsigned)WSP(bf16, WS_W2)[i % ((size_t)DFF * DM)])
              + bflo((unsigned)WSP(bf16, WS_WO)[i % ((size_t)DM * DM)]) + bflo((unsigned)WSP(bf16, WS_WKV)[i % ((size_t)1536 * 256)]) + bflo((unsigned)WSP(bf16, WS_WUK)[i % ((size_t)512 * 256)])
              + bflo((unsigned)WSP(bf16, WS_WPL)[i % ((size_t)1024 * 512)]) + bflo((unsigned)WSP(bf16, WS_WUQ)[i % ((size_t)768 * 384)]) + WSP(float, WS_ROPE)[i % (size_t)(2072 * 32)] + bflo((unsigned)WSP(bf16, WS_XNM)[i % (size_t)(16 * 1024)]);
#elif DUMP == 2
            v = bflo((unsigned)WSP(bf16, WS_CB)[i % ((size_t)MC * 256)]) + bflo((unsigned)WSP(bf16, WS_QL)[i % ((size_t)MC * 384)]) + bflo((unsigned)WSP(bf16, WS_DP)[i % ((size_t)MC * 512)])
              + bflo((unsigned)WSP(bf16, WS_KRG)[i % ((size_t)RB * 32)]) + WSP(float, WS_KSS)[i % (size_t)RB];
#elif DUMP == 3
            v = bflo((unsigned)WSP(bf16, WS_QR)[i % ((size_t)MC * 768)]) + bflo((unsigned)WSP(bf16, WS_KH)[i % ((size_t)RB * 768)]) + bflo((unsigned)WSP(bf16, WS_VH)[i % ((size_t)RB * 1024)]) + bflo((unsigned)WSP(bf16, WS_PG)[i]);
#elif DUMP == 4
            v = bflo((unsigned)WSP(bf16, WS_AM)[i]) + WSP(float, WS_SAC)[i % ((size_t)256 * 64 * 256)] + WSP(float, WS_SAL)[i % (size_t)(256 * 64)];
#elif DUMP == 5
            v = bflo((unsigned)WSP(bf16, WS_AM)[i + (size_t)MS * DM]);
#elif DUMP == 6
            v = WSP(float, WS_H)[i + (size_t)MS * DM];
#endif
            F.out[O_YP + i] = v;
        }
    }
#endif
#undef IN
#undef SEAM
}

#ifndef MK_N_LAUNCHES
#define MK_N_LAUNCHES 1
#endif
extern "C" void kernel_launch(void* const* d_in, const int* in_sizes, int n_in, void* d_out, int out_size, void* d_ws, size_t ws_size, hipStream_t stream) {
    static int grid = 0;
    if (grid == 0) {
        if (n_in != 24 || out_size != (int)O_END || ws_size < WS_END) { fprintf(stderr, "kernel_launch: unexpected shapes (n_in %d out %d ws %zu need %zu); nothing launched\n", n_in, out_size, ws_size, (size_t)WS_END); grid = -1; return; }
        int dev = 0, cus = 0, per_cu = 0;
        if (hipGetDevice(&dev) != hipSuccess || hipDeviceGetAttribute(&cus, hipDeviceAttributeMultiprocessorCount, dev) != hipSuccess) { grid = -1; return; }
        if (hipFuncSetAttribute((const void*)mk_fwd, hipFuncAttributeMaxDynamicSharedMemorySize, LDS_BYTES) != hipSuccess) { fprintf(stderr, "kernel_launch: hipFuncSetAttribute failed\n"); grid = -1; return; }
        if (hipOccupancyMaxActiveBlocksPerMultiprocessor(&per_cu, (const void*)mk_fwd, NWAVES * 64, LDS_BYTES) != hipSuccess || per_cu < 1) { fprintf(stderr, "kernel_launch: occupancy query says %d blocks per CU\n", per_cu); }
        (void)hipGetLastError();
        grid = cus;
    }
    if (grid < 0) return;
    if (hipMemsetAsync((char*)d_ws + WS_CTL, 0, CTL_BYTES, stream) != hipSuccess) return;
    Args a{};
    for (int i = 0; i < 24; ++i) a.in[i] = d_in[i];
    a.out = (float*)d_out; a.ws = (unsigned char*)d_ws;
#if MK_N_LAUNCHES == 1
#ifdef DUMP
    a.ph_lo = 0; a.ph_hi = 11;
#else
    a.ph_lo = 0; a.ph_hi = 10;
#endif
    hipLaunchKernelGGL(mk_fwd, dim3(grid), dim3(NWAVES * 64), LDS_BYTES, stream, a);
#else
#ifdef DUMP
    constexpr int NPH = 11;
#else
    constexpr int NPH = 10;
#endif
    for (int p = 0; p < NPH; ++p) { a.ph_lo = p; a.ph_hi = p + 1; hipLaunchKernelGGL(mk_fwd, dim3(grid), dim3(NWAVES * 64), LDS_BYTES, stream, a); }
#endif
}
```

```cpp
#include <hip/hip_runtime.h>
#include <cstdio>
#include <cstdint>
#define USE_PG8 1
namespace pg8 {
#define PG8_LAS __attribute__((address_space(3)))
typedef unsigned short bf16_t;
typedef short bf16x8 __attribute__((ext_vector_type(8)));
typedef float f32x4 __attribute__((ext_vector_type(4)));
typedef unsigned u32x4 __attribute__((ext_vector_type(4)));
constexpr int BM = 256, BK = 64, HALF = 128, HTB = HALF * BK * 2  , STAGE_BYTES = 8 * HTB, NXCD = 8, WGM = 8;

__host__ __device__ __forceinline__ int lds_byte(int r, int c) { const int st = (r >> 4) * 2 + (c >> 5), rr = r & 15, cc = c & 31, ob = rr * 64 + cc * 2; return st * 1024 + (ob ^ (((ob >> 9) & 1) << 5)); }
__host__ __device__ __forceinline__ void stage_rc(int b, int& R, int& C) { const int st = b / 1024, sb = b % 1024, swz = sb ^ (((sb >> 9) & 1) << 5); R = (st >> 1) * 16 + swz / 64; C = (st & 1) * 32 + (swz % 64) / 2; }
__host__ __device__ __forceinline__ int perm32(int rho) { const int n = rho >> 4, i = rho & 15; return 8 * (i >> 2) + 4 * n + (i & 3); }

struct Unit { int pm, pn; };
struct Gemm { const bf16_t* A; const bf16_t* Bt; int M, N, K; };

struct StaticOrder {
    int nM, nN, nwg, G, c;
    __host__ __device__ void init(int M, int N, int G_, int c_) { nM = M / BM; nN = N / BM; nwg = nM * nN; G = G_; c = c_; }
    __host__ __device__ bool next(int i, Unit& u) const {
        const long L = (long)i * G + c; if (L >= nwg) return false;
        int wgid = (int)L; { const int q = nwg / NXCD, r = nwg % NXCD, xcd = wgid % NXCD, off = wgid / NXCD; wgid = (xcd < r ? xcd * (q + 1) : r * (q + 1) + (xcd - r) * q) + off; }
        const int nig = WGM * nN, gid = wgid / nig, fm = gid * WGM, gsz = (nM - fm) < WGM ? (nM - fm) : WGM;
        u.pm = fm + ((wgid % nig) % gsz); u.pn = (wgid % nig) / gsz; return true;
    }
    __device__ __forceinline__ void a_ready(const Unit&) const {}
    __device__ __forceinline__ void done(const Unit&) const {}
};

template <class Epi, class Sched, bool ALIGN_EPI = false, bool SP2 = false>
__device__ __forceinline__ void gemm_phase(PG8_LAS unsigned char* lds, const Gemm g, const Sched& S, const Epi& E) {
    const int tid = threadIdx.x, wid = __builtin_amdgcn_readfirstlane(tid >> 6), lane = tid & 63, wr = wid >> 2, wc = wid & 3, fr = lane & 15, fq = lane >> 4;
    const int K = g.K, nt = K / BK;
    unsigned voffA[2], voffB[2];
#pragma unroll
    for (int i = 0; i < 2; ++i) { int R, C; stage_rc(tid * 16 + i * 8192, R, C); const int Rb = Epi::PERM ? ((R & ~31) + perm32(R & 31)) : R;
        voffA[i] = (unsigned)(R * K + C) * 2u; voffB[i] = (unsigned)(Rb * K + C) * 2u; }
    const size_t kstep = (size_t)(BK * 2);
    const size_t hstep = (size_t)HALF * K * 2;
    const size_t tstep = 2 * hstep;
    const unsigned ldsw = (unsigned)wid * 1024u;
    const int aoff = lds_byte(wr * 64 + fr, fq * 8), boff = lds_byte(wc * 32 + fr, fq * 8);
#define PG8_SA(b, h) (((b) * 2 + (h)) * HTB)
#define PG8_SB(b, h) ((4 + (b) * 2 + (h)) * HTB)
#define PG8_STAGE(bufoff, gbase, voff) do { _Pragma("unroll") for (int _i = 0; _i < 2; ++_i) \
        __builtin_amdgcn_global_load_lds((const unsigned*)((const char*)(gbase) + (voff)[_i]), (PG8_LAS unsigned*)(lds + (bufoff) + ldsw + _i * 8192), 16, 0, 0); } while (0)
#define PG8_LDA(dst, b, h) do { _Pragma("unroll") for (int m = 0; m < 4; ++m) _Pragma("unroll") for (int k = 0; k < 2; ++k) dst[m][k] = *(const PG8_LAS bf16x8*)(lds + PG8_SA(b, h) + aoff + m * 2048 + k * 1024); } while (0)
#define PG8_LDB(dst, b, h) do { _Pragma("unroll") for (int n = 0; n < 2; ++n) _Pragma("unroll") for (int k = 0; k < 2; ++k) dst[n][k] = *(const PG8_LAS bf16x8*)(lds + PG8_SB(b, h) + boff + n * 2048 + k * 1024); } while (0)
#define PG8_MMA(ai, bj, At, Bt) do { __builtin_amdgcn_s_setprio(1); _Pragma("unroll") for (int m = 0; m < 4; ++m) _Pragma("unroll") for (int n = 0; n < 2; ++n) _Pragma("unroll") for (int k = 0; k < 2; ++k) \
        acc[ai][bj][m][n] = __builtin_amdgcn_mfma_f32_16x16x32_bf16(Bt[n][k], At[m][k], acc[ai][bj][m][n], 0, 0, 0); __builtin_amdgcn_s_setprio(0); } while (0)
#ifdef SAFE_WAITS
#define PG8_WAIT_V(n) asm volatile("s_waitcnt vmcnt(0)" ::: "memory")
#else
#define PG8_WAIT_V(n) asm volatile("s_waitcnt vmcnt(" #n ")" ::: "memory")
#endif
#define PG8_WAIT_L(n) asm volatile("s_waitcnt lgkmcnt(" #n ")" ::: "memory")
#define PG8_BAR __builtin_amdgcn_s_barrier()
#define PG8_SCHED __builtin_amdgcn_sched_barrier(0)
    Unit cur, nxt; int ui = 0;
    if (!S.next(0, cur)) return;
    f32x4 acc[2][2][4][2];
#pragma unroll
    for (int a = 0; a < 2; ++a)
#pragma unroll
        for (int b = 0; b < 2; ++b)
#pragma unroll
            for (int m = 0; m < 4; ++m)
#pragma unroll
                for (int n = 0; n < 2; ++n) acc[a][b][m][n] = (f32x4){0.f, 0.f, 0.f, 0.f};
    bf16x8 At[4][2], B0[2][2], B1[2][2];
    const char* cA = (const char*)g.A + (size_t)cur.pm * tstep; const char* cB = (const char*)g.Bt + (size_t)cur.pn * tstep;
    S.a_ready(cur);
    if constexpr (SP2) {
        PG8_STAGE(PG8_SB(0, 0), cB, voffB); PG8_STAGE(PG8_SB(0, 1), cB + hstep, voffB); PG8_STAGE(PG8_SA(0, 0), cA, voffA); PG8_STAGE(PG8_SA(0, 1), cA + hstep, voffA);
        if (wr == 1) PG8_BAR;
        PG8_WAIT_V(2); PG8_BAR;
        PG8_STAGE(PG8_SB(1, 0), cB + kstep, voffB); PG8_STAGE(PG8_SA(1, 0), cA + kstep, voffA); PG8_STAGE(PG8_SB(1, 1), cB + hstep + kstep, voffB);
        PG8_WAIT_V(6); PG8_BAR;
    } else {
        PG8_STAGE(PG8_SB(0, 0), cB, voffB); PG8_STAGE(PG8_SA(0, 0), cA, voffA); PG8_STAGE(PG8_SB(0, 1), cB + hstep, voffB); PG8_STAGE(PG8_SA(0, 1), cA + hstep, voffA);
        if (wr == 1) PG8_BAR;
        PG8_WAIT_V(4); PG8_BAR;
        PG8_STAGE(PG8_SB(1, 0), cB + kstep, voffB); PG8_STAGE(PG8_SA(1, 0), cA + kstep, voffA); PG8_STAGE(PG8_SB(1, 1), cB + hstep + kstep, voffB);
        PG8_WAIT_V(6); PG8_BAR;
    }
    for (;;) {
        const bool has_next = S.next(ui + 1, nxt);
        const char* nA = has_next ? (const char*)g.A + (size_t)nxt.pm * tstep : cA; const char* nB = has_next ? (const char*)g.Bt + (size_t)nxt.pn * tstep : cB;
        for (int t = 0; t < nt; t += 2) {
            const bool last = (t == nt - 2);
            const char* a1 = cA + (size_t)(t + 1) * kstep;
            const char* a2 = last ? nA : cA + (size_t)(t + 2) * kstep; const char* b2 = last ? nB : cB + (size_t)(t + 2) * kstep;
            const char* a3 = a2 + kstep; const char* b3 = b2 + kstep;
            if (last && has_next) S.a_ready(nxt);
            if constexpr (SP2) {
            PG8_LDB(B0, 0, 0); PG8_LDB(B1, 0, 1); PG8_SCHED; PG8_LDA(At, 0, 0); PG8_STAGE(PG8_SA(1, 1), a1 + hstep, voffA);
            PG8_WAIT_V(8); PG8_WAIT_L(0); PG8_BAR; PG8_MMA(0, 0, At, B0); PG8_MMA(0, 1, At, B1); PG8_BAR; PG8_SCHED;
            PG8_LDA(At, 0, 1); PG8_STAGE(PG8_SB(0, 0), b2, voffB); PG8_STAGE(PG8_SB(0, 1), b2 + hstep, voffB); PG8_STAGE(PG8_SA(0, 0), a2, voffA);
            PG8_WAIT_V(8); PG8_WAIT_L(0); PG8_BAR; PG8_MMA(1, 0, At, B0); PG8_MMA(1, 1, At, B1); PG8_BAR; PG8_SCHED;
            PG8_LDB(B0, 1, 0); PG8_LDB(B1, 1, 1); PG8_SCHED; PG8_LDA(At, 1, 0); PG8_STAGE(PG8_SA(0, 1), a2 + hstep, voffA);
            PG8_WAIT_V(8); PG8_WAIT_L(0); PG8_BAR; PG8_MMA(0, 0, At, B0); PG8_MMA(0, 1, At, B1); PG8_BAR; PG8_SCHED;
            PG8_LDA(At, 1, 1); PG8_STAGE(PG8_SB(1, 0), b3, voffB); PG8_STAGE(PG8_SB(1, 1), b3 + hstep, voffB); PG8_STAGE(PG8_SA(1, 0), a3, voffA);
            PG8_WAIT_V(8); PG8_WAIT_L(0); PG8_BAR; PG8_MMA(1, 0, At, B0); PG8_MMA(1, 1, At, B1); PG8_BAR; PG8_SCHED;
            } else {
            PG8_LDB(B0, 0, 0); PG8_SCHED; PG8_LDA(At, 0, 0); PG8_STAGE(PG8_SA(1, 1), a1 + hstep, voffA);
            PG8_WAIT_L(8); PG8_BAR; PG8_WAIT_L(0); PG8_MMA(0, 0, At, B0); PG8_BAR; PG8_SCHED;
            PG8_LDB(B1, 0, 1); PG8_STAGE(PG8_SB(0, 0), b2, voffB);
            PG8_BAR; PG8_WAIT_L(0); PG8_MMA(0, 1, At, B1); PG8_BAR;
            PG8_LDA(At, 0, 1); PG8_STAGE(PG8_SA(0, 0), a2, voffA);
            PG8_BAR; PG8_WAIT_L(0); PG8_MMA(1, 0, At, B0); PG8_BAR; PG8_SCHED;
            PG8_STAGE(PG8_SB(0, 1), b2 + hstep, voffB);
            PG8_WAIT_V(6); PG8_BAR; PG8_MMA(1, 1, At, B1); PG8_BAR;
            PG8_LDB(B0, 1, 0); PG8_SCHED; PG8_LDA(At, 1, 0); PG8_STAGE(PG8_SA(0, 1), a2 + hstep, voffA);
            PG8_WAIT_L(8); PG8_BAR; PG8_WAIT_L(0); PG8_MMA(0, 0, At, B0); PG8_BAR; PG8_SCHED;
            PG8_LDB(B1, 1, 1); PG8_STAGE(PG8_SB(1, 0), b3, voffB);
            PG8_BAR; PG8_WAIT_L(0); PG8_MMA(0, 1, At, B1); PG8_BAR;
            PG8_LDA(At, 1, 1); PG8_STAGE(PG8_SA(1, 0), a3, voffA);
            PG8_BAR; PG8_WAIT_L(0); PG8_MMA(1, 0, At, B0); PG8_BAR; PG8_SCHED;
            PG8_STAGE(PG8_SB(1, 1), b3 + hstep, voffB);
            PG8_WAIT_V(6); PG8_BAR; PG8_MMA(1, 1, At, B1); PG8_BAR;
            }
        }
        if constexpr (ALIGN_EPI) { if (wr == 0) PG8_BAR; }
        if constexpr (!Epi::AFTER_DRAIN) { E(acc, cur, wr, wc, fr, fq); S.done(cur); }
        if (!has_next) break;
#pragma unroll
        for (int a = 0; a < 2; ++a)
#pragma unroll
            for (int b = 0; b < 2; ++b)
#pragma unroll
                for (int m = 0; m < 4; ++m)
#pragma unroll
                    for (int n = 0; n < 2; ++n) acc[a][b][m][n] = (f32x4){0.f, 0.f, 0.f, 0.f};
        cur = nxt; cA = nA; cB = nB; ++ui;
        if constexpr (ALIGN_EPI) { if (wr == 1) PG8_BAR; }
    }
    PG8_WAIT_V(0);
    if constexpr (!ALIGN_EPI) { if (wr == 0) PG8_BAR; }
    PG8_BAR;
    if constexpr (Epi::AFTER_DRAIN) { E.fused(acc, cur, wr, wc, fr, fq, lds, wid, lane); S.done(cur); }
#undef PG8_SA
#undef PG8_SB
#undef PG8_STAGE
#undef PG8_LDA
#undef PG8_LDB
#undef PG8_MMA
#undef PG8_WAIT_V
#undef PG8_WAIT_L
#undef PG8_BAR
#undef PG8_SCHED
}
}
#ifndef PG8_SP2
#define PG8_SP2 true
#endif
#ifndef PG8_ALIGN
#define PG8_ALIGN true
#endif
constexpr int NWAVES = 8;
constexpr int DM = 1024, NBATCH = 16, SEQ = 2048, NMETA = 16, TT = SEQ + NMETA, DBATCH = 128, DSEQ = 8, PAST = 8192, PAGE = 128, NPAGES = 64;
constexpr int NHEAD = 8, QKN = 64, QKR = 32, QKH = 96, VHD = 128, QLORA = 384, KVL = 256, PW = 512, DFF = 4096, DIN = 3232;
constexpr int MP = NBATCH * SEQ, MS = DBATCH * DSEQ, MC = MP + MS, MCX = MC + 256;
constexpr int NIN = 3328, PFW = 1280;
constexpr int RB = NBATCH * TT;
constexpr float EPS = 1e-6f;
constexpr float SCALE_L2E = 0.10206207261596575f * 1.4426950408889634f;
constexpr size_t O_YP = 0, O_YS = O_YP + (size_t)MP * DM, O_CP = O_YS + (size_t)MS * DM, O_KRP = O_CP + (size_t)RB * KVL, O_PSP = O_KRP + (size_t)RB * QKR,
                 O_CS = O_PSP + (size_t)NBATCH * 15 * PW, O_KRS = O_CS + (size_t)MS * KVL, O_PSS = O_KRS + (size_t)MS * QKR, O_END = O_PSS + (size_t)DBATCH * 15 * PW;
static_assert(O_END == 45514752, "d_out size");
constexpr size_t al256(size_t x) { return (x + 255) & ~(size_t)255; }
constexpr size_t WS_CTL = 0, CTL_BYTES = 1u << 20;
constexpr size_t WS_WIN = CTL_BYTES;
constexpr size_t WS_WUQ = WS_WIN + al256((size_t)NIN * DM * 2);
constexpr size_t WS_WKV = WS_WUQ + al256((size_t)768 * 384 * 2);
constexpr size_t WS_WUK = WS_WKV + al256((size_t)1536 * 256 * 2);
constexpr size_t WS_WPL = WS_WUK + al256((size_t)512 * 256 * 2);
constexpr size_t WS_WO = WS_WPL + al256((size_t)1024 * 512 * 2);
constexpr size_t WS_W1 = WS_WO + al256((size_t)DM * DM * 2);
constexpr size_t WS_W2 = WS_W1 + al256((size_t)DFF * DM * 2);
constexpr size_t WS_ROPE = WS_W2 + al256((size_t)DFF * DM * 2);
constexpr size_t WS_XNM = WS_ROPE + al256((size_t)2072 * 32 * 4);
constexpr size_t WS_PFM = WS_XNM + al256(16 * 1024 * 2);
constexpr size_t WS_CM = WS_PFM + al256(16 * 1280 * 4);
constexpr size_t WS_KRM = WS_CM + al256(16 * 256 * 4);
constexpr size_t WS_KSM = WS_KRM + al256(16 * 32 * 4);
constexpr size_t WS_XN = WS_KSM + 256;
constexpr size_t WS_PF = WS_XN + al256((size_t)MCX * DM * 2);
constexpr size_t WS_GATE = WS_PF + al256((size_t)MCX * PFW * 4);
constexpr size_t WS_CB = WS_GATE + al256((size_t)MCX * 2048 * 2);
constexpr size_t WS_KRG = WS_CB + al256((size_t)MC * 256 * 2);
constexpr size_t WS_KSS = WS_KRG + al256((size_t)(RB + 64) * 32 * 2);
constexpr size_t WS_QL = WS_KSS + al256((size_t)(RB + 64) * 4);
constexpr size_t WS_DP = WS_QL + al256((size_t)MC * 384 * 2);
constexpr size_t WS_QR = WS_DP + al256((size_t)MC * 512 * 2);
constexpr size_t WS_KH = WS_QR + al256((size_t)MC * 768 * 2);
constexpr size_t WS_VH = WS_KH + al256((size_t)(RB + 64) * 768 * 2);
constexpr size_t WS_PG = WS_VH + al256((size_t)(RB + 64) * 1024 * 2);
constexpr size_t WS_AM = WS_PG + al256((size_t)MC * DM * 2);
constexpr size_t WS_SAC = WS_AM + al256((size_t)MC * DM * 2);
constexpr size_t WS_SAL = WS_SAC + al256((size_t)256 * 64 * 256 * 4);
constexpr size_t WS_H = WS_SAL + al256((size_t)256 * 64 * 4);
constexpr size_t WS_HN = WS_H + al256((size_t)MC * DM * 4);
constexpr size_t WS_Z = WS_HN + al256((size_t)MC * DM * 2);
constexpr size_t WS_WOS = WS_Z + al256((size_t)MC * DFF * 2);
constexpr size_t WS_W2S = WS_WOS + al256((size_t)DM * DM * 2);
constexpr size_t WS_AMS = WS_W2S + al256((size_t)DFF * DM * 2);
constexpr size_t WS_HS = WS_AMS + al256((size_t)MS * DM * 2);
constexpr size_t WS_ZS = WS_HS + al256((size_t)4 * MS * DM * 4);
constexpr size_t WS_YS = WS_ZS + al256((size_t)MS * DFF * 2);
constexpr size_t WS_PB = WS_YS + al256((size_t)8 * MS * DM * 4);
constexpr size_t WS_HB = WS_PB + al256((size_t)MCX * PFW * 2);
constexpr size_t WS_END = WS_HB + al256((size_t)MP * DM * 2);
constexpr int CW_TMO = 0, CW_CODE = 1, CW_BAR = 4096;
#ifdef SMALL_LDS
constexpr int RING_OFF = 0, RING_BYTES = 147456;
#else
constexpr int RING_OFF = 0, RING_BYTES = 161792;
#endif
constexpr int LDSCTL_OFF = RING_BYTES, MISC_OFF = LDSCTL_OFF + 320;
constexpr int LDS_BYTES = RING_BYTES + 512;
static_assert(LDS_BYTES <= 163840, "LDS");

#define GAS __attribute__((address_space(1)))
#define LAS __attribute__((address_space(3)))
typedef unsigned short bf16;
typedef unsigned v4u __attribute__((ext_vector_type(4)));
typedef unsigned v2u __attribute__((ext_vector_type(2)));
typedef float f32x4 __attribute__((ext_vector_type(4)));
typedef float f32x2 __attribute__((ext_vector_type(2)));
typedef float f32x16 __attribute__((ext_vector_type(16)));
typedef short bf16x8 __attribute__((ext_vector_type(8)));
typedef short s16x4 __attribute__((ext_vector_type(4)));
typedef GAS unsigned gu32;
#define RLX_AGENT __ATOMIC_RELAXED, __HIP_MEMORY_SCOPE_AGENT
#define LDS_WAIT() asm volatile("s_waitcnt lgkmcnt(0)" ::: "memory")
#define VM_WAIT() asm volatile("s_waitcnt vmcnt(0)" ::: "memory")
#define SBAR() __builtin_amdgcn_sched_barrier(0)
__device__ __forceinline__ unsigned f2bf(float f) { unsigned u = __builtin_bit_cast(unsigned, f); return (u + 0x7fffu + ((u >> 16) & 1u)) >> 16; }
typedef float f32x2_t __attribute__((ext_vector_type(2))); typedef __bf16 bf16x2_t __attribute__((ext_vector_type(2)));
__device__ __forceinline__ unsigned pk2(float lo, float hi) { const f32x2_t v = {lo, hi}; const bf16x2_t b = __builtin_convertvector(v, bf16x2_t); return __builtin_bit_cast(unsigned, b); }
__device__ __forceinline__ float bflo(unsigned u) { return __builtin_bit_cast(float, u << 16); }
__device__ __forceinline__ float bfhi(unsigned u) { return __builtin_bit_cast(float, u & 0xffff0000u); }
template <int CTRL> __device__ __forceinline__ float dppf(float v) { return __builtin_bit_cast(float, __builtin_amdgcn_update_dpp(0, __builtin_bit_cast(int, v), CTRL, 0xf, 0xf, true)); }
__device__ __forceinline__ float sum_x16(float v) { const unsigned u = __float_as_uint(v); auto r = __builtin_amdgcn_permlane16_swap(u, u, false, false); return __uint_as_float(r[0]) + __uint_as_float(r[1]); }
__device__ __forceinline__ float sum_x32(float v) { const unsigned u = __float_as_uint(v); auto r = __builtin_amdgcn_permlane32_swap(u, u, false, false); return __uint_as_float(r[0]) + __uint_as_float(r[1]); }
__device__ __forceinline__ float max_x16(float v) { const unsigned u = __float_as_uint(v); auto r = __builtin_amdgcn_permlane16_swap(u, u, false, false); return fmaxf(__uint_as_float(r[0]), __uint_as_float(r[1])); }
__device__ __forceinline__ float max_x32(float v) { const unsigned u = __float_as_uint(v); auto r = __builtin_amdgcn_permlane32_swap(u, u, false, false); return fmaxf(__uint_as_float(r[0]), __uint_as_float(r[1])); }
__device__ __forceinline__ float sum_quad(float v) { v += dppf<0xB1>(v); v += dppf<0x4E>(v); return v; }
__device__ __forceinline__ float sum_oct(float v) { v = sum_quad(v); v += dppf<0x141>(v); return v; }
__device__ __forceinline__ float sum_row16(float v) { v = sum_oct(v); v += dppf<0x140>(v); return v; }
__device__ __forceinline__ float wave_sum(float v) { return sum_x32(sum_x16(sum_row16(v))); }
__device__ __forceinline__ float wave_max(float v) { v = fmaxf(v, dppf<0xB1>(v)); v = fmaxf(v, dppf<0x4E>(v)); v = fmaxf(v, dppf<0x141>(v)); v = fmaxf(v, dppf<0x140>(v)); return max_x32(max_x16(v)); }
__device__ __forceinline__ float frsqrt(float x) { return 1.0f / sqrtf(x); }
__constant__ double ROPE_INV[16] = { 1.0, 0.5623413251903491, 0.31622776601683794, 0.1778279410038923, 0.1, 0.05623413251903491, 0.03162277660168379, 0.01778279410038923,
    0.01, 0.005623413251903491, 0.0031622776601683794, 0.001778279410038923, 0.001, 0.0005623413251903491, 0.00031622776601683794, 0.0001778279410038923 };
#define XB_TMO      128
#define XB_XCNT(j)  (256  + 64 * (j))
#define XB_XSUB(j)  (1280 + 64 * (j))
#define XB_XGEN(j)  (2304 + 64 * (j))
#define XB_TOP      3328
#define XB_TOPGEN   3392
#define XCD_BAR_WORDS 3456
#define XB_SPIN_CAP (1u << 18)

__device__ __forceinline__ unsigned xb_ld(unsigned* p)              { return __hip_atomic_load(p, __ATOMIC_RELAXED, __HIP_MEMORY_SCOPE_AGENT); }
__device__ __forceinline__ unsigned xb_add(unsigned* p, unsigned v) { return __hip_atomic_fetch_add(p, v, __ATOMIC_RELAXED, __HIP_MEMORY_SCOPE_AGENT); }
__device__ __forceinline__ unsigned xb_xcc_id() { return (unsigned)__builtin_amdgcn_s_getreg((3 << 11) | 20) & 0xFu; }
#define XB_SPIN(cond, bar) do { unsigned _sp = 0; while (cond) { __builtin_amdgcn_s_sleep(1); \
    if ((++_sp & 255u) == 0u) { if (xb_ld(&(bar)[XB_TMO])) break; if (_sp > XB_SPIN_CAP) { atomicAdd(&(bar)[XB_TMO], 1u); break; } } } } while (0)

struct XcdBarrier {
    unsigned* bar; unsigned x;
    volatile LAS unsigned* st;
};

__device__ __forceinline__ XcdBarrier xcd_barrier_post(unsigned* bar, volatile LAS unsigned* st) {
    XcdBarrier b; b.bar = bar; b.x = xb_xcc_id(); b.st = st;
    if (threadIdx.x == 0) (void)xb_add(&bar[XB_XCNT(b.x)], 1u);
    return b;
}
__device__ __forceinline__ void xcd_barrier_complete(unsigned* bar, unsigned x, unsigned& nloc, unsigned& nx) {
    const unsigned G = gridDim.x * gridDim.y * gridDim.z;
    unsigned sum, cnt, mine, sp = 0u;
    for (;;) {
        sum = 0u; cnt = 0u; mine = 0u;
#pragma unroll
        for (unsigned j = 0; j < 16; ++j) { const unsigned c = xb_ld(&bar[XB_XCNT(j)]); sum += c; cnt += (c > 0u) ? 1u : 0u; mine = (j == x) ? c : mine; }
        if (sum == G) break;
        __builtin_amdgcn_s_sleep(1);
        if ((++sp & 255u) == 0u) { if (xb_ld(&bar[XB_TMO])) break; if (sp > XB_SPIN_CAP) { atomicAdd(&bar[XB_TMO], 1u); break; } }
    }
    nloc = mine > 0u ? mine : 1u; nx = cnt > 0u ? cnt : 1u;
}

__device__ __forceinline__ void xcd_barrier(const XcdBarrier& b) {
    asm volatile("s_waitcnt vmcnt(0)" ::: "memory");
    __syncthreads();
    if (threadIdx.x == 0) {
        unsigned* bar = b.bar;
        __builtin_amdgcn_s_waitcnt(0);
        unsigned nloc = b.st[0], nx = b.st[1];
        if (nloc == 0u) { xcd_barrier_complete(bar, b.x, nloc, nx); b.st[0] = nloc; b.st[1] = nx; }
        const unsigned old = xb_add(&bar[XB_XSUB(b.x)], 1u);
        const unsigned gen = old / nloc;
        if (old + 1u == (gen + 1u) * nloc) {
            __builtin_amdgcn_fence(__ATOMIC_RELEASE, "agent");
            asm volatile("s_waitcnt vmcnt(0)" ::: "memory");
            const unsigned og = xb_add(&bar[XB_TOP], 1u);
            const unsigned tg = og / nx;
            if (og + 1u == (tg + 1u) * nx) xb_add(&bar[XB_TOPGEN], 1u);
            else XB_SPIN(xb_ld(&bar[XB_TOPGEN]) == tg, bar);
            __builtin_amdgcn_fence(__ATOMIC_ACQUIRE, "agent");
            xb_add(&bar[XB_XGEN(b.x)], 1u);
            asm volatile("s_waitcnt vmcnt(0)" ::: "memory");
        } else {
            XB_SPIN(xb_ld(&bar[XB_XGEN(b.x)]) == gen, bar);
            __builtin_amdgcn_fence(__ATOMIC_ACQUIRE, "agent");
            asm volatile("s_waitcnt vmcnt(0)" ::: "memory");
        }
    }
    __syncthreads();
}
struct Frame {
    LAS unsigned char* lds;
    volatile LAS unsigned* MISC;
    gu32* ctl;
    int tid, lane, wave, vcu, G;
    const float *x_prompt, *x_sample, *cache_c, *cache_kr, *state_pool; const int* page_table;
    const float *meta_tokens, *g_attn, *w_in, *g_q_lat, *w_uq, *g_kv_lat, *g_qn_nope, *g_qn_rope, *w_uk, *g_kn_nope, *g_kn_rope, *w_uv, *w_pool_map, *pool_scale, *w_o, *g_mlp, *w_ff1, *w_ff2;
    float* out; unsigned char* ws;
};
#define WSP(T, off) ((T*)(F.ws + (off)))

__device__ __forceinline__ void p0_tr_block(const float* W, int ldw, bf16* dst, bf16* dst2, int pitch, int pitch2, bool zero, LAS float* scr, int lane) {
    const int c = lane & 7;
    if (zero) {
#pragma unroll
        for (int j = 0; j < 4; ++j) { const int n = (lane >> 3) + 8 * j; *(GAS v4u*)(dst + (size_t)n * pitch + 8 * c) = (v4u){0u, 0u, 0u, 0u}; }
        return;
    }
    {
        const int r8 = lane >> 3, c4 = lane & 7; const float* wp = W + (size_t)r8 * ldw + 4 * c4;
        f32x4 v[8];
#pragma unroll
        for (int i = 0; i < 8; ++i) v[i] = *(const GAS f32x4*)(wp + (size_t)(8 * i) * ldw);
#pragma unroll
        for (int i = 0; i < 8; ++i) { LAS float* s = scr + (8 * i + r8) * 33 + 4 * c4; s[0] = v[i].x; s[1] = v[i].y; s[2] = v[i].z; s[3] = v[i].w; }
    }
    LDS_WAIT(); asm volatile("" ::: "memory");
#pragma unroll
    for (int j = 0; j < 4; ++j) { const int n = (lane >> 3) + 8 * j; const LAS float* s = scr + (8 * c) * 33 + n;
        v4u o; o.x = pk2(s[0 * 33], s[1 * 33]); o.y = pk2(s[2 * 33], s[3 * 33]); o.z = pk2(s[4 * 33], s[5 * 33]); o.w = pk2(s[6 * 33], s[7 * 33]);
        *(GAS v4u*)(dst + (size_t)n * pitch + 8 * c) = o;
        if (dst2) *(GAS v4u*)(dst2 + (size_t)n * pitch2 + 8 * c) = o; }
    LDS_WAIT(); asm volatile("" ::: "memory");
}
__device__ __forceinline__ int in_row(int n0) { return n0 < 512 ? 256 + n0 : (n0 < 896 ? 768 + (n0 - 512) : (n0 < 1152 ? n0 - 896 : (n0 < 1184 ? n0 : 1280 + (n0 - 1184)))); }

__device__ __forceinline__ void p0_weights(Frame& F, int it0, int it1, int gw, int NGW) {
    LAS float* scr = (LAS float*)(F.lds + RING_OFF + F.wave * 16384);
    const int lane = F.lane;
    bf16* Win_t = WSP(bf16, WS_WIN); bf16* Wuq_t = WSP(bf16, WS_WUQ); bf16* Wkv_t = WSP(bf16, WS_WKV); bf16* Wuk_t = WSP(bf16, WS_WUK); bf16* Wpl_t = WSP(bf16, WS_WPL);
    bf16* Wo_t = WSP(bf16, WS_WO); bf16* W1_t = WSP(bf16, WS_W1); bf16* W2_t = WSP(bf16, WS_W2);
    constexpr int I_1 = 16 * 128, I_2 = 64 * 32, I_O = 16 * 32, I_IN = 16 * 101, I_PL = 2 * 32, I_UQ = 6 * 24, I_UV = 4 * 32, I_UK = 4 * 16, I_INZ = 16 * 3;
    for (int it = it0 + gw; it < it1; it += NGW) {
        int r = it; const float* W; int ldw, pitch, pitch2 = 0; bf16* dst; bf16* dst2 = nullptr; bool zero = false;
        if (r < I_1) { const int kb = r / 128, nb = r % 128; W = F.w_ff1 + (size_t)(64 * kb) * DFF + 32 * nb; ldw = DFF; pitch = DM; dst = W1_t + (size_t)(32 * nb) * DM + 64 * kb; }
        else if ((r -= I_1) < I_2) { const int kb = r / 32, nb = r % 32; W = F.w_ff2 + (size_t)(64 * kb) * DM + 32 * nb; ldw = DM; pitch = DFF; dst = W2_t + (size_t)(32 * nb) * DFF + 64 * kb;
            dst2 = WSP(bf16, WS_W2S) + ((size_t)(kb >> 3) * DM + 32 * nb) * 512 + 64 * (kb & 7); pitch2 = 512; }
        else if ((r -= I_2) < I_O) { const int kb = r / 32, nb = r % 32; W = F.w_o + (size_t)(64 * kb) * DM + 32 * nb; ldw = DM; pitch = DM; dst = Wo_t + (size_t)(32 * nb) * DM + 64 * kb;
            dst2 = WSP(bf16, WS_WOS) + ((size_t)(kb >> 2) * DM + 32 * nb) * 256 + 64 * (kb & 3); pitch2 = 256; }
        else if ((r -= I_O) < I_IN) { const int kb = r / 101, nb = r % 101; W = F.w_in + (size_t)(64 * kb) * DIN + 32 * nb; ldw = DIN; pitch = DM; dst = Win_t + (size_t)in_row(32 * nb) * DM + 64 * kb; }
        else if ((r -= I_IN) < I_PL) { const int kb = r / 32, nb = r % 32, g = nb / 8;
            pitch = 128; dst = Wpl_t + (size_t)(32 * nb) * 128 + 64 * kb; ldw = 256;
            W = F.w_pool_map + (size_t)g * 128 * 256 + (size_t)(64 * kb) * 256 + (32 * nb - 256 * g); }
        else if ((r -= I_PL) < I_UQ) { const int kb = r / 24, nb = r % 24; W = F.w_uq + (size_t)(64 * kb) * 768 + 32 * nb; ldw = 768; pitch = QLORA; dst = Wuq_t + (size_t)(32 * nb) * QLORA + 64 * kb; }
        else if ((r -= I_UQ) < I_UV) { const int kb = r / 32, nb = r % 32; W = F.w_uv + (size_t)(64 * kb) * 1024 + 32 * nb; ldw = 1024; pitch = KVL; dst = Wkv_t + (size_t)(512 + 32 * nb) * KVL + 64 * kb; }
        else if ((r -= I_UV) < I_UK) { const int kb = r / 16, nb = r % 16, h = nb >> 1, d0 = (nb & 1) * 32; W = F.w_uk + (size_t)(64 * kb) * 512 + 32 * nb; ldw = 512; pitch = KVL;
            dst = Wkv_t + (size_t)(256 * (h >> 2) + 128 * (d0 >> 5) + 32 * (h & 3)) * KVL + 64 * kb; dst2 = Wuk_t + (size_t)(32 * nb) * KVL + 64 * kb; pitch2 = KVL; }
        else { r -= I_UK; const int kb = r / 3, nb = r % 3; W = F.w_in; ldw = DIN; pitch = DM; dst = Win_t + (size_t)(1184 + 32 * nb) * DM + 64 * kb; zero = true; }
        p0_tr_block(W, ldw, dst, dst2, pitch, pitch2, zero, scr, lane);
    }
}
constexpr int P0_LATE_ITEMS = 16 * 128 + 64 * 32 + 16 * 32, P0_ALL_ITEMS = P0_LATE_ITEMS + 16 * 101 + 2 * 32 + 6 * 24 + 4 * 32 + 4 * 16 + 16 * 3;
__device__ __forceinline__ void p0_prologue(Frame& F) {
    const int gw = F.vcu * NWAVES + F.wave, NGW = F.G * NWAVES, lane = F.lane;
    p0_weights(F, P0_LATE_ITEMS, P0_ALL_ITEMS, gw, NGW);
    bf16* XN = WSP(bf16, WS_XN);
    f32x4 g4[4];
#pragma unroll
    for (int j = 0; j < 4; ++j) g4[j] = *((const GAS f32x4*)F.g_attn + lane + 64 * j);
    for (int m = gw; m < MC + NMETA; m += NGW) {
        const float* xrow = m < MP ? F.x_prompt + (size_t)m * DM : (m < MC ? F.x_sample + (size_t)(m - MP) * DM : F.meta_tokens + (size_t)(m - MC) * DM);
        bf16* orow = XN + (size_t)m * DM;
        const GAS f32x4* xr = (const GAS f32x4*)xrow + lane;
        f32x4 v[4]; float s = 0.f;
#pragma unroll
        for (int j = 0; j < 4; ++j) { v[j] = xr[64 * j]; s += (v[j].x * v[j].x + v[j].y * v[j].y) + (v[j].z * v[j].z + v[j].w * v[j].w); }
        const float rstd = frsqrt(wave_sum(s) * (1.f / DM) + EPS);
        GAS v2u* o8 = (GAS v2u*)orow + lane;
#pragma unroll
        for (int j = 0; j < 4; ++j) { v2u o; o.x = pk2(v[j].x * rstd * g4[j].x, v[j].y * rstd * g4[j].y); o.y = pk2(v[j].z * rstd * g4[j].z, v[j].w * rstd * g4[j].w); o8[64 * j] = o; }
    }
    { GAS v4u* zp = (GAS v4u*)(XN + (size_t)(MC + NMETA) * DM);
      for (int e = (F.vcu * NWAVES * 64) + F.tid; e < (MCX - MC - NMETA) * DM / 8; e += F.G * NWAVES * 64) zp[e] = (v4u){0u, 0u, 0u, 0u}; }
    float* ROPE = WSP(float, WS_ROPE);
    for (int e = (F.vcu * NWAVES * 64) + F.tid; e < 2072 * 16; e += F.G * NWAVES * 64) {
        const int p = e >> 4, i = e & 15; const int pos = p < TT ? p : PAST + (p - TT);
        const double ang = (double)pos * ROPE_INV[i];
        const double k = __builtin_rint(ang * 0.15915494309189535);
        const double r = __builtin_fma(-k, 6.283185307179586, ang) - k * 2.4492935982947064e-16;
        const float rf = (float)r;
        ROPE[p * 32 + i] = cosf(rf); ROPE[p * 32 + 16 + i] = sinf(rf);
    }
    { GAS v4u* kp = (GAS v4u*)(WSP(bf16, WS_KH) + (size_t)RB * 768); GAS v4u* vp = (GAS v4u*)(WSP(bf16, WS_VH) + (size_t)RB * 1024);
      for (int e = (F.vcu * NWAVES * 64) + F.tid; e < 64 * 768 / 8 + 64 * 1024 / 8; e += F.G * NWAVES * 64) { if (e < 64 * 768 / 8) kp[e] = (v4u){0u, 0u, 0u, 0u}; else vp[e - 64 * 768 / 8] = (v4u){0u, 0u, 0u, 0u}; } }
}

__device__ __forceinline__ void p1_meta(Frame& F) {
    const int gw = F.vcu * NWAVES + F.wave, NGW = F.G * NWAVES, lane = F.lane;
    const bf16* Win_t = WSP(bf16, WS_WIN); const bf16* XNM = WSP(bf16, WS_XNM); float* PFM = WSP(float, WS_PFM);
    for (int t = gw; t < 800; t += NGW) {
        const int n = t < 768 ? t : 1152 + (t - 768);
        const GAS v4u* wp = (const GAS v4u*)(Win_t + (size_t)n * DM + lane * 16);
        const v4u w0 = wp[0], w1 = wp[1];
        float wf[16];
        wf[0] = bflo(w0.x); wf[1] = bfhi(w0.x); wf[2] = bflo(w0.y); wf[3] = bfhi(w0.y); wf[4] = bflo(w0.z); wf[5] = bfhi(w0.z); wf[6] = bflo(w0.w); wf[7] = bfhi(w0.w);
        wf[8] = bflo(w1.x); wf[9] = bfhi(w1.x); wf[10] = bflo(w1.y); wf[11] = bfhi(w1.y); wf[12] = bflo(w1.z); wf[13] = bfhi(w1.z); wf[14] = bflo(w1.w); wf[15] = bfhi(w1.w);
        float mine = 0.f;
#pragma unroll 4
        for (int i = 0; i < 16; ++i) {
            const GAS v4u* xp = (const GAS v4u*)(XNM + (size_t)i * DM + lane * 16);
            const v4u x0 = xp[0], x1 = xp[1];
            float a = bflo(x0.x) * wf[0] + bfhi(x0.x) * wf[1] + bflo(x0.y) * wf[2] + bfhi(x0.y) * wf[3] + bflo(x0.z) * wf[4] + bfhi(x0.z) * wf[5] + bflo(x0.w) * wf[6] + bfhi(x0.w) * wf[7]
                    + bflo(x1.x) * wf[8] + bfhi(x1.x) * wf[9] + bflo(x1.y) * wf[10] + bfhi(x1.y) * wf[11] + bflo(x1.z) * wf[12] + bfhi(x1.z) * wf[13] + bflo(x1.w) * wf[14] + bfhi(x1.w) * wf[15];
            a = wave_sum(a);
            mine = (lane == i) ? a : mine;
        }
        if (lane < 16) PFM[lane * PFW + n] = mine;
    }
}

__device__ __forceinline__ void p2_rows(Frame& F) {
    const int gw = F.vcu * NWAVES + F.wave, NGW = F.G * NWAVES, lane = F.lane;
    const bf16* PB = WSP(bf16, WS_PB); const float* ROPE = WSP(float, WS_ROPE);
    bf16* CB = WSP(bf16, WS_CB); bf16* KRG = WSP(bf16, WS_KRG); float* KSS = WSP(float, WS_KSS); bf16* QL = WSP(bf16, WS_QL);
    float* CM = WSP(float, WS_CM); float* KRM = WSP(float, WS_KRM); float* KSM = WSP(float, WS_KSM);
    const f32x4 gkv = *((const GAS f32x4*)F.g_kv_lat + lane);
    const f32x4 gqa = *((const GAS f32x4*)F.g_q_lat + lane);
    const f32x2 gqb = *((const GAS f32x2*)(F.g_q_lat + 256) + lane);
    const float gkr = F.g_kn_rope[lane & 15];
    struct RowIn { v2u c; unsigned short k1, k2; float cs, sn; v2u qa; unsigned qb; };
    auto row_load = [&](int m, RowIn& r) {
        const bool meta = m >= MC, samp = !meta && m >= MP;
        const bf16* pf = PB + (size_t)m * PFW;
        const int pos = meta ? m - MC : (samp ? PAST + ((m - MP) & 7) : (m & (SEQ - 1)) + NMETA);
        const int ridx = pos < TT ? pos : TT + (pos - PAST);
        r.c = *((const GAS v2u*)pf + lane);
        r.k1 = 0; r.k2 = 0; r.cs = 1.f; r.sn = 0.f;
        if (lane < 16) { r.k1 = pf[1152 + lane]; r.k2 = pf[1152 + 16 + lane]; r.cs = ROPE[ridx * 32 + lane]; r.sn = ROPE[ridx * 32 + 16 + lane]; }
        r.qa = (v2u){0u, 0u}; r.qb = 0u;
        if (!meta) { r.qa = *((const GAS v2u*)(pf + 768) + lane); r.qb = *((const GAS unsigned*)(pf + 1024) + lane); }
    };
    auto row_do = [&](int m, const RowIn& r) {
        const bool meta = m >= MC, samp = !meta && m >= MP;
        const f32x4 c4 = (f32x4){bflo(r.c.x), bfhi(r.c.x), bflo(r.c.y), bfhi(r.c.y)};
        const float x1 = bflo((unsigned)r.k1), x2 = bflo((unsigned)r.k2), cs = r.cs, sn = r.sn;
        const f32x4 qa = (f32x4){bflo(r.qa.x), bfhi(r.qa.x), bflo(r.qa.y), bfhi(r.qa.y)}; const f32x2 qb = (f32x2){bflo(r.qb), bfhi(r.qb)};
        float sc = (c4.x * c4.x + c4.y * c4.y) + (c4.z * c4.z + c4.w * c4.w), sk = x1 * x1 + x2 * x2, sq = (qa.x * qa.x + qa.y * qa.y) + (qa.z * qa.z + qa.w * qa.w) + (qb.x * qb.x + qb.y * qb.y);
        sc = wave_sum(sc); sk = wave_sum(sk); sq = wave_sum(sq);
        const float rc = frsqrt(sc * (1.f / KVL) + EPS), rq = frsqrt(sq * (1.f / QLORA) + EPS);
        const f32x4 cn = (f32x4){c4.x * rc * gkv.x, c4.y * rc * gkv.y, c4.z * rc * gkv.z, c4.w * rc * gkv.w};
        const float o1 = x1 * cs - x2 * sn, o2 = x2 * cs + x1 * sn;
        if (meta) {
            const int i = m - MC;
            *((GAS f32x4*)(CM + (size_t)i * KVL) + lane) = cn;
            if (lane < 16) { KRM[i * 32 + lane] = o1 * gkr; KRM[i * 32 + 16 + lane] = o2 * gkr; }
            if (lane == 0) KSM[i] = sk;
#pragma unroll 4
            for (int b = 0; b < NBATCH; ++b) { const size_t R = (size_t)b * TT + i;
                *((GAS f32x4*)(F.out + O_CP + R * KVL) + lane) = cn;
                if (lane < 16) { F.out[O_KRP + R * QKR + lane] = o1; F.out[O_KRP + R * QKR + 16 + lane] = o2;
                    KRG[R * 32 + lane] = (bf16)f2bf(o1 * gkr); KRG[R * 32 + 16 + lane] = (bf16)f2bf(o2 * gkr); }
                if (lane == 0) KSS[R] = sk; }
        } else {
            v2u cb; cb.x = pk2(cn.x, cn.y); cb.y = pk2(cn.z, cn.w);
            *((GAS v2u*)(CB + (size_t)m * KVL) + lane) = cb;
            if (!samp) { const size_t R = (size_t)m + NMETA * ((m >> 11) + 1);
                *((GAS f32x4*)(F.out + O_CP + R * KVL) + lane) = cn;
                if (lane < 16) { F.out[O_KRP + R * QKR + lane] = o1; F.out[O_KRP + R * QKR + 16 + lane] = o2;
                    KRG[R * 32 + lane] = (bf16)f2bf(o1 * gkr); KRG[R * 32 + 16 + lane] = (bf16)f2bf(o2 * gkr); }
                if (lane == 0) KSS[R] = sk;
            } else { const size_t R = (size_t)(m - MP);
                *((GAS f32x4*)(F.out + O_CS + R * KVL) + lane) = cn;
                if (lane < 16) { F.out[O_KRS + R * QKR + lane] = o1; F.out[O_KRS + R * QKR + 16 + lane] = o2; } }
            v2u qo; qo.x = pk2(qa.x * rq * gqa.x, qa.y * rq * gqa.y); qo.y = pk2(qa.z * rq * gqa.z, qa.w * rq * gqa.w);
            *((GAS v2u*)(QL + (size_t)m * QLORA) + lane) = qo;
            *((GAS unsigned*)(QL + (size_t)m * QLORA + 256) + lane) = pk2(qb.x * rq * gqb.x, qb.y * rq * gqb.y);
        }
    };
    {
        RowIn ra, rb; int m = gw;
        if (m < MC + NMETA) row_load(m, ra);
        for (; m < MC + NMETA; m += 2 * NGW) {
            const int m2 = m + NGW, m3 = m + 2 * NGW;
            if (m2 < MC + NMETA) row_load(m2, rb);
            row_do(m, ra);
            if (m3 < MC + NMETA) row_load(m3, ra);
            if (m2 < MC + NMETA) row_do(m2, rb);
        }
    }
}
__device__ __forceinline__ void ldu8(const bf16* p, f32x4& a, f32x4& b) { const v4u v = *(const GAS v4u*)p;
    a = (f32x4){bflo(v.x), bfhi(v.x), bflo(v.y), bfhi(v.y)}; b = (f32x4){bflo(v.z), bfhi(v.z), bflo(v.w), bfhi(v.w)}; }
__device__ __forceinline__ void p2_pool(Frame& F) {
    const int gw = F.vcu * NWAVES + F.wave, NGW = F.G * NWAVES, lane = F.lane;
    const bf16* PB = WSP(bf16, WS_PB); bf16* DP = WSP(bf16, WS_DP);
    const int w = 2 << (lane >> 4); const float iw = 1.0f / (float)w; const int col = 256 + 8 * lane;
    for (int t = gw; t < MP / 16; t += NGW) {
        const int b = t >> 7, t0 = (t & 127) * 16;
        const bf16* base = PB + (size_t)b * SEQ * PFW + col;
#define UROW(tp) (((tp) >= 0) ? base + (size_t)(tp) * PFW : PB + (size_t)(MC + (tp) + NMETA) * PFW + col)
        f32x4 ra = (f32x4){0.f, 0.f, 0.f, 0.f}, rb = ra;
#pragma unroll
        for (int j = 1; j < 16; ++j) { f32x4 a, bq; ldu8(UROW(t0 - j), a, bq); if (j < w) { ra += a; rb += bq; } }
#pragma unroll 8
        for (int r = 0; r < 16; ++r) {
            f32x4 ca, cb, oa, ob; ldu8(UROW(t0 + r), ca, cb); ldu8(UROW(t0 + r - w + 1), oa, ob);
            ra += ca; rb += cb;
            const f32x4 da = ra * iw - ca, db = rb * iw - cb;
            v4u o; o.x = pk2(da.x, da.y); o.y = pk2(da.z, da.w); o.z = pk2(db.x, db.y); o.w = pk2(db.z, db.w);
            *((GAS v4u*)(DP + ((size_t)(lane >> 4) * MC + (b * SEQ + t0 + r)) * 128) + (lane & 15)) = o;
            ra -= oa; rb -= ob;
        }
#undef UROW
    }
    for (int db = gw; db < DBATCH; db += NGW) {
        const float* sp = F.state_pool + (size_t)db * 15 * PW + 8 * lane; const bf16* base = PB + (size_t)(MP + db * DSEQ) * PFW + col;
#define ULOAD(s, A, B) do { if ((s) >= 0) ldu8(base + (size_t)(s) * PFW, A, B); else { const float* p_ = sp + (size_t)(15 + (s)) * PW; A = *(const GAS f32x4*)p_; B = *(const GAS f32x4*)(p_ + 4); } } while (0)
        f32x4 ra = (f32x4){0.f, 0.f, 0.f, 0.f}, rb = ra;
#pragma unroll 5
        for (int j = 1; j < 16; ++j) { f32x4 a, bq; ULOAD(-j, a, bq); if (j < w) { ra += a; rb += bq; } }
#pragma unroll
        for (int r = 0; r < DSEQ; ++r) {
            f32x4 ca, cb, oa, ob; ULOAD(r, ca, cb); ULOAD(r - w + 1, oa, ob);
            ra += ca; rb += cb;
            const f32x4 da = ra * iw - ca, dbv = rb * iw - cb;
            v4u o; o.x = pk2(da.x, da.y); o.y = pk2(da.z, da.w); o.z = pk2(dbv.x, dbv.y); o.w = pk2(dbv.z, dbv.w);
            *((GAS v4u*)(DP + ((size_t)(lane >> 4) * MC + (MP + db * DSEQ + r)) * 128) + (lane & 15)) = o;
            ra -= oa; rb -= ob;
        }
#undef ULOAD
    }
    const int gt = F.vcu * NWAVES * 64 + F.tid, NGT = F.G * NWAVES * 64;
    for (int e = gt; e < NBATCH * 15 * (PW / 4); e += NGT) { const int c4 = e & 127, j = (e >> 7) % 15, b = e / (128 * 15);
        const v2u v = *((const GAS v2u*)(PB + (size_t)(b * SEQ + SEQ - 15 + j) * PFW + 256) + c4);
        *((GAS f32x4*)(F.out + O_PSP) + e) = (f32x4){bflo(v.x), bfhi(v.x), bflo(v.y), bfhi(v.y)}; }
    for (int e = gt; e < DBATCH * 15 * (PW / 4); e += NGT) { const int c4 = e & 127, j = (e >> 7) % 15, db = e / (128 * 15);
        f32x4 v;
        if (j < 7) v = *((const GAS f32x4*)(F.state_pool + (size_t)(db * 15 + 8 + j) * PW) + c4);
        else { const v2u q = *((const GAS v2u*)(PB + (size_t)(MP + db * DSEQ + j - 7) * PFW + 256) + c4); v = (f32x4){bflo(q.x), bfhi(q.x), bflo(q.y), bfhi(q.y)}; }
        *((GAS f32x4*)(F.out + O_PSS) + e) = v; }
}
using pg8::Unit;
__device__ __forceinline__ float sigmoidf_fast(float x) { return __builtin_amdgcn_rcpf(1.0f + __builtin_amdgcn_exp2f(-1.4426950408889634f * x)); }

struct EpiInProj {
    static constexpr bool PERM = true, AFTER_DRAIN = false;
    float* PF; bf16* GATE; bf16* PB;
    __device__ __forceinline__ void operator()(const f32x4 (&acc)[2][2][4][2], const Unit& u, int wr, int wc, int fr, int fq) const {
        const int row0 = u.pm * 256 + wr * 64 + fr, cw = wc * 32 + 8 * fq;
        if (u.pn < 5) {
#pragma unroll
            for (int ai = 0; ai < 2; ++ai)
#pragma unroll
                for (int m = 0; m < 4; ++m) { bf16* rowp = PB + (size_t)(row0 + ai * 128 + m * 16) * PFW + u.pn * 256 + cw;
#pragma unroll
                    for (int bj = 0; bj < 2; ++bj) { const f32x4 v0 = acc[ai][bj][m][0], v1 = acc[ai][bj][m][1]; v4u w;
                        w.x = pk2(v0[0], v0[1]); w.y = pk2(v0[2], v0[3]); w.z = pk2(v1[0], v1[1]); w.w = pk2(v1[2], v1[3]);
                        *(GAS v4u*)(rowp + bj * 128) = w; } }
        } else {
#pragma unroll
            for (int ai = 0; ai < 2; ++ai)
#pragma unroll
                for (int m = 0; m < 4; ++m) { bf16* rowp = GATE + (size_t)(row0 + ai * 128 + m * 16) * 2048 + (u.pn - 5) * 256 + cw;
#pragma unroll
                    for (int bj = 0; bj < 2; ++bj) { const f32x4 v0 = acc[ai][bj][m][0], v1 = acc[ai][bj][m][1]; v4u w;
                        w.x = pk2(sigmoidf_fast(v0[0]), sigmoidf_fast(v0[1])); w.y = pk2(sigmoidf_fast(v0[2]), sigmoidf_fast(v0[3]));
                        w.z = pk2(sigmoidf_fast(v1[0]), sigmoidf_fast(v1[1])); w.w = pk2(sigmoidf_fast(v1[2]), sigmoidf_fast(v1[3]));
                        *(GAS v4u*)(rowp + bj * 128) = w; } }
        }
    }
};
struct EpiInProjScalar {
    static constexpr bool PERM = true, AFTER_DRAIN = false;
    float* PF; bf16* GATE;
    __device__ __forceinline__ void operator()(const f32x4 (&acc)[2][2][4][2], const Unit& u, int wr, int wc, int fr, int fq) const {
        const int row0 = u.pm * 256 + wr * 64 + fr, cw = wc * 32 + 8 * fq;
#pragma unroll
        for (int ai = 0; ai < 2; ++ai)
#pragma unroll
            for (int m = 0; m < 4; ++m)
#pragma unroll
                for (int bj = 0; bj < 2; ++bj)
#pragma unroll
                    for (int n = 0; n < 2; ++n)
#pragma unroll
                        for (int e = 0; e < 4; ++e) { const size_t r = (size_t)(row0 + ai * 128 + m * 16); const int c = u.pn * 256 + bj * 128 + cw + 4 * n + e; const float v = acc[ai][bj][m][n][e];
                            if (c < PFW) PF[r * PFW + c] = v; else GATE[r * 2048 + (c - PFW)] = (bf16)f2bf(sigmoidf_fast(v)); }
    }
};
struct EpiPlainBf16 {
    static constexpr bool PERM = true, AFTER_DRAIN = false;
    bf16* O; int ldc;
    __device__ __forceinline__ void operator()(const f32x4 (&acc)[2][2][4][2], const Unit& u, int wr, int wc, int fr, int fq) const {
        const int row0 = u.pm * 256 + wr * 64 + fr, col0 = u.pn * 256 + wc * 32 + 8 * fq;
#pragma unroll
        for (int ai = 0; ai < 2; ++ai)
#pragma unroll
            for (int m = 0; m < 4; ++m) { bf16* rowp = O + (size_t)(row0 + ai * 128 + m * 16) * ldc + col0;
#pragma unroll
                for (int bj = 0; bj < 2; ++bj) { const f32x4 v0 = acc[ai][bj][m][0], v1 = acc[ai][bj][m][1]; v4u w;
                    w.x = pk2(v0[0], v0[1]); w.y = pk2(v0[2], v0[3]); w.z = pk2(v1[0], v1[1]); w.w = pk2(v1[2], v1[3]); *(GAS v4u*)(rowp + bj * 128) = w; } }
    }
};
struct EpiKV {
    static constexpr bool PERM = true, AFTER_DRAIN = false;
    bf16* KH; bf16* VH; const bf16* KRG; const float* KSS; const float* gkn;
    __device__ __forceinline__ void operator()(const f32x4 (&acc)[2][2][4][2], const Unit& u, int wr, int wc, int fr, int fq) const {
        const int row0 = u.pm * 256 + wr * 64 + fr, roff = NMETA * ((u.pm >> 3) + 1);
        if (u.pn < 2) {
            const int head = u.pn * 4 + wc;
            f32x4 g[2][2];
#pragma unroll
            for (int bj = 0; bj < 2; ++bj)
#pragma unroll
                for (int n = 0; n < 2; ++n) g[bj][n] = *(const GAS f32x4*)(gkn + 32 * bj + 8 * fq + 4 * n);
            float kss[2][4]; v4u krv[2][4];
#pragma unroll
            for (int ai = 0; ai < 2; ++ai)
#pragma unroll
                for (int m = 0; m < 4; ++m) { const size_t R = (size_t)(row0 + ai * 128 + m * 16 + roff); const float* ps_ = KSS + R; const bf16* pk_ = KRG + R * 32 + 8 * fq;
                    asm volatile("global_load_dword %0, %1, off" : "=v"(kss[ai][m]) : "v"(ps_)); asm volatile("global_load_dwordx4 %0, %1, off" : "=v"(krv[ai][m]) : "v"(pk_)); }
            asm volatile("s_waitcnt vmcnt(0)" : "+v"(kss[0][0]), "+v"(kss[0][1]), "+v"(kss[0][2]), "+v"(kss[0][3]), "+v"(kss[1][0]), "+v"(kss[1][1]), "+v"(kss[1][2]), "+v"(kss[1][3]),
                                                "+v"(krv[0][0]), "+v"(krv[0][1]), "+v"(krv[0][2]), "+v"(krv[0][3]), "+v"(krv[1][0]), "+v"(krv[1][1]), "+v"(krv[1][2]), "+v"(krv[1][3]));
#pragma unroll
            for (int ai = 0; ai < 2; ++ai)
#pragma unroll
                for (int m = 0; m < 4; ++m) { const size_t R = (size_t)(row0 + ai * 128 + m * 16 + roff);
                    float ss = 0.f;
#pragma unroll
                    for (int bj = 0; bj < 2; ++bj)
#pragma unroll
                        for (int n = 0; n < 2; ++n) { const f32x4 v = acc[ai][bj][m][n]; ss += (v[0] * v[0] + v[1] * v[1]) + (v[2] * v[2] + v[3] * v[3]); }
                    ss = sum_x32(sum_x16(ss));
                    const float rstd = frsqrt((ss + kss[ai][m]) * (1.f / QKH) + EPS);
                    bf16* kp = KH + R * 768 + head * QKH;
#pragma unroll
                    for (int bj = 0; bj < 2; ++bj) { const f32x4 v0 = acc[ai][bj][m][0] * g[bj][0] * rstd, v1 = acc[ai][bj][m][1] * g[bj][1] * rstd; v4u w;
                        w.x = pk2(v0[0], v0[1]); w.y = pk2(v0[2], v0[3]); w.z = pk2(v1[0], v1[1]); w.w = pk2(v1[2], v1[3]); *(GAS v4u*)(kp + 32 * bj + 8 * fq) = w; }
                    const v4u kr = krv[ai][m]; v4u w;
                    w.x = pk2(bflo(kr.x) * rstd, bfhi(kr.x) * rstd); w.y = pk2(bflo(kr.y) * rstd, bfhi(kr.y) * rstd); w.z = pk2(bflo(kr.z) * rstd, bfhi(kr.z) * rstd); w.w = pk2(bflo(kr.w) * rstd, bfhi(kr.w) * rstd);
                    *(GAS v4u*)(kp + 64 + 8 * fq) = w; }
        } else {
            const int col0 = (u.pn - 2) * 256 + wc * 32 + 8 * fq;
#pragma unroll
            for (int ai = 0; ai < 2; ++ai)
#pragma unroll
                for (int m = 0; m < 4; ++m) { bf16* rowp = VH + (size_t)(row0 + ai * 128 + m * 16 + roff) * 1024 + col0;
#pragma unroll
                    for (int bj = 0; bj < 2; ++bj) { const f32x4 v0 = acc[ai][bj][m][0], v1 = acc[ai][bj][m][1]; v4u w;
                        w.x = pk2(v0[0], v0[1]); w.y = pk2(v0[2], v0[3]); w.z = pk2(v1[0], v1[1]); w.w = pk2(v1[2], v1[3]); *(GAS v4u*)(rowp + bj * 128) = w; } }
        }
    }
};
struct PoolOrder {
    int G, c;
    __device__ __forceinline__ bool next(int i, Unit& u) const { const int L = i * G + c; if (L >= 4 * (MC / 256)) return false; const int pn = L & 3, pm = L >> 2; u.pm = pn * (MC / 256) + pm; u.pn = pn; return true; }
    __device__ __forceinline__ void a_ready(const Unit&) const {}
    __device__ __forceinline__ void done(const Unit&) const {}
};
struct EpiPool {
    static constexpr bool PERM = true, AFTER_DRAIN = false;
    bf16* PG; const bf16* GATE; const float* pscale;
    __device__ __forceinline__ void operator()(const f32x4 (&acc)[2][2][4][2], const Unit& u, int wr, int wc, int fr, int fq) const {
        const int row0 = (u.pm - u.pn * (MC / 256)) * 256 + wr * 64 + fr, col0 = u.pn * 256 + wc * 32 + 8 * fq;
        f32x4 ps[2][2];
#pragma unroll
        for (int bj = 0; bj < 2; ++bj)
#pragma unroll
            for (int n = 0; n < 2; ++n) ps[bj][n] = *(const GAS f32x4*)(pscale + col0 + bj * 128 + 4 * n);
        v4u gt[2][4][2];
#pragma unroll
        for (int ai = 0; ai < 2; ++ai)
#pragma unroll
            for (int m = 0; m < 4; ++m) { const bf16* p = GATE + (size_t)(row0 + ai * 128 + m * 16) * 2048 + col0;
                asm volatile("global_load_dwordx4 %0, %1, off" : "=v"(gt[ai][m][0]) : "v"(p));
                asm volatile("global_load_dwordx4 %0, %1, off offset:256" : "=v"(gt[ai][m][1]) : "v"(p)); }
        asm volatile("s_waitcnt vmcnt(0)" : "+v"(gt[0][0][0]), "+v"(gt[0][0][1]), "+v"(gt[0][1][0]), "+v"(gt[0][1][1]), "+v"(gt[0][2][0]), "+v"(gt[0][2][1]), "+v"(gt[0][3][0]), "+v"(gt[0][3][1]),
                                            "+v"(gt[1][0][0]), "+v"(gt[1][0][1]), "+v"(gt[1][1][0]), "+v"(gt[1][1][1]), "+v"(gt[1][2][0]), "+v"(gt[1][2][1]), "+v"(gt[1][3][0]), "+v"(gt[1][3][1]));
#pragma unroll
        for (int ai = 0; ai < 2; ++ai)
#pragma unroll
            for (int m = 0; m < 4; ++m) { const size_t r = (size_t)(row0 + ai * 128 + m * 16);
#pragma unroll
                for (int bj = 0; bj < 2; ++bj) { const v4u g = gt[ai][m][bj];
                    const f32x4 v0 = acc[ai][bj][m][0] * ps[bj][0], v1 = acc[ai][bj][m][1] * ps[bj][1]; v4u w;
                    w.x = pk2(v0[0] * bflo(g.x), v0[1] * bfhi(g.x)); w.y = pk2(v0[2] * bflo(g.y), v0[3] * bfhi(g.y)); w.z = pk2(v1[0] * bflo(g.z), v1[1] * bfhi(g.z)); w.w = pk2(v1[2] * bflo(g.w), v1[3] * bfhi(g.w));
                    *(GAS v4u*)(PG + r * DM + col0 + bj * 128) = w; } }
    }
};
struct EpiResF32 {
    static constexpr bool PERM = true, AFTER_DRAIN = false;
    float* C; const float* R0; const float* R1; int split_pm;
    __device__ __forceinline__ void operator()(const f32x4 (&acc)[2][2][4][2], const Unit& u, int wr, int wc, int fr, int fq) const {
        const int row0 = u.pm * 256 + wr * 64 + fr, col0 = u.pn * 256 + wc * 32 + 8 * fq;
        const float* rb = u.pm < split_pm ? R0 : R1 - (size_t)split_pm * 256 * DM;
#pragma unroll
        for (int ai = 0; ai < 2; ++ai)
#pragma unroll
            for (int m = 0; m < 4; ++m) { const size_t o = (size_t)(row0 + ai * 128 + m * 16) * DM + col0;
#pragma unroll
                for (int bj = 0; bj < 2; ++bj) { const f32x4 r0 = *(const GAS f32x4*)(rb + o + bj * 128), r1 = *(const GAS f32x4*)(rb + o + bj * 128 + 4);
                    *(GAS f32x4*)(C + o + bj * 128) = acc[ai][bj][m][0] + r0; *(GAS f32x4*)(C + o + bj * 128 + 4) = acc[ai][bj][m][1] + r1; } }
    }
};
struct EpiResToBf16 {
    static constexpr bool PERM = true, AFTER_DRAIN = false;
    bf16* C; const float* R;
    __device__ __forceinline__ void operator()(const f32x4 (&acc)[2][2][4][2], const Unit& u, int wr, int wc, int fr, int fq) const {
        const int row0 = u.pm * 256 + wr * 64 + fr, col0 = u.pn * 256 + wc * 32 + 8 * fq;
#pragma unroll
        for (int ai = 0; ai < 2; ++ai) {
            f32x4 r[4][4];
#pragma unroll
            for (int m = 0; m < 4; ++m) { const float* p = R + (size_t)(row0 + ai * 128 + m * 16) * DM + col0;
                asm volatile("global_load_dwordx4 %0, %1, off" : "=v"(r[m][0]) : "v"(p));
                asm volatile("global_load_dwordx4 %0, %1, off offset:16" : "=v"(r[m][1]) : "v"(p));
                asm volatile("global_load_dwordx4 %0, %1, off offset:512" : "=v"(r[m][2]) : "v"(p));
                asm volatile("global_load_dwordx4 %0, %1, off offset:528" : "=v"(r[m][3]) : "v"(p)); }
            asm volatile("s_waitcnt vmcnt(0)" : "+v"(r[0][0]), "+v"(r[0][1]), "+v"(r[0][2]), "+v"(r[0][3]), "+v"(r[1][0]), "+v"(r[1][1]), "+v"(r[1][2]), "+v"(r[1][3]),
                                                "+v"(r[2][0]), "+v"(r[2][1]), "+v"(r[2][2]), "+v"(r[2][3]), "+v"(r[3][0]), "+v"(r[3][1]), "+v"(r[3][2]), "+v"(r[3][3]));
#pragma unroll
            for (int m = 0; m < 4; ++m) { const size_t o = (size_t)(row0 + ai * 128 + m * 16) * DM + col0;
#pragma unroll
                for (int bj = 0; bj < 2; ++bj) { const f32x4 a = acc[ai][bj][m][0] + r[m][2 * bj], b = acc[ai][bj][m][1] + r[m][2 * bj + 1]; v4u w;
                    w.x = pk2(a[0], a[1]); w.y = pk2(a[2], a[3]); w.z = pk2(b[0], b[1]); w.w = pk2(b[2], b[3]);
                    *(GAS v4u*)(C + o + bj * 128) = w; } }
        }
    }
};
struct EpiResFromBf16 {
    static constexpr bool PERM = true, AFTER_DRAIN = false;
    float* C; const bf16* R;
    __device__ __forceinline__ void operator()(const f32x4 (&acc)[2][2][4][2], const Unit& u, int wr, int wc, int fr, int fq) const {
        const int row0 = u.pm * 256 + wr * 64 + fr, col0 = u.pn * 256 + wc * 32 + 8 * fq;
        v4u r[2][4][2];
#pragma unroll
        for (int ai = 0; ai < 2; ++ai)
#pragma unroll
            for (int m = 0; m < 4; ++m) { const bf16* p = R + (size_t)(row0 + ai * 128 + m * 16) * DM + col0;
                asm volatile("global_load_dwordx4 %0, %1, off" : "=v"(r[ai][m][0]) : "v"(p));
                asm volatile("global_load_dwordx4 %0, %1, off offset:256" : "=v"(r[ai][m][1]) : "v"(p)); }
        asm volatile("s_waitcnt vmcnt(0)" : "+v"(r[0][0][0]), "+v"(r[0][0][1]), "+v"(r[0][1][0]), "+v"(r[0][1][1]), "+v"(r[0][2][0]), "+v"(r[0][2][1]), "+v"(r[0][3][0]), "+v"(r[0][3][1]),
                                            "+v"(r[1][0][0]), "+v"(r[1][0][1]), "+v"(r[1][1][0]), "+v"(r[1][1][1]), "+v"(r[1][2][0]), "+v"(r[1][2][1]), "+v"(r[1][3][0]), "+v"(r[1][3][1]));
#pragma unroll
        for (int ai = 0; ai < 2; ++ai)
#pragma unroll
            for (int m = 0; m < 4; ++m) { const size_t o = (size_t)(row0 + ai * 128 + m * 16) * DM + col0;
#pragma unroll
                for (int bj = 0; bj < 2; ++bj) { const v4u t = r[ai][m][bj];
                    *(GAS f32x4*)(C + o + bj * 128) = acc[ai][bj][m][0] + (f32x4){bflo(t.x), bfhi(t.x), bflo(t.y), bfhi(t.y)};
                    *(GAS f32x4*)(C + o + bj * 128 + 4) = acc[ai][bj][m][1] + (f32x4){bflo(t.z), bfhi(t.z), bflo(t.w), bfhi(t.w)}; } }
    }
};
struct SliceOrder {
    int NS, G, c;
    __device__ __forceinline__ bool next(int i, Unit& u) const { const int L = i * G + c; if (L >= NS * 16) return false; const int s = L >> 4; u.pm = 4 * s + ((L >> 2) & 3); u.pn = 4 * s + (L & 3); return true; }
    __device__ __forceinline__ void a_ready(const Unit&) const {}
    __device__ __forceinline__ void done(const Unit&) const {}
};
struct EpiSlab {
    static constexpr bool PERM = true, AFTER_DRAIN = false;
    float* S;
    __device__ __forceinline__ void operator()(const f32x4 (&acc)[2][2][4][2], const Unit& u, int wr, int wc, int fr, int fq) const {
        const int row0 = (u.pm & 3) * 256 + wr * 64 + fr, col0 = (u.pn & 3) * 256 + wc * 32 + 8 * fq; float* base = S + (size_t)(u.pm >> 2) * MS * DM;
#pragma unroll
        for (int ai = 0; ai < 2; ++ai)
#pragma unroll
            for (int m = 0; m < 4; ++m) { const size_t o = (size_t)(row0 + ai * 128 + m * 16) * DM + col0;
#pragma unroll
                for (int bj = 0; bj < 2; ++bj) { *(GAS f32x4*)(base + o + bj * 128) = acc[ai][bj][m][0]; *(GAS f32x4*)(base + o + bj * 128 + 4) = acc[ai][bj][m][1]; } }
    }
};
struct EpiRelu2 {
    static constexpr bool PERM = true, AFTER_DRAIN = false;
    bf16* Z; bf16* ZS;
    __device__ __forceinline__ void operator()(const f32x4 (&acc)[2][2][4][2], const Unit& u, int wr, int wc, int fr, int fq) const {
        const int row0 = u.pm * 256 + wr * 64 + fr, col0 = u.pn * 256 + wc * 32 + 8 * fq;
        const bool smp = u.pm >= MP / 256;
        bf16* zb = smp ? ZS + ((size_t)(col0 >> 9) * MS - MP) * 512 + (col0 & 511) : Z + col0; const int zp = smp ? 512 : DFF;
#pragma unroll
        for (int ai = 0; ai < 2; ++ai)
#pragma unroll
            for (int m = 0; m < 4; ++m) { bf16* rowp = zb + (size_t)(row0 + ai * 128 + m * 16) * zp;
#pragma unroll
                for (int bj = 0; bj < 2; ++bj) { f32x4 v0 = acc[ai][bj][m][0], v1 = acc[ai][bj][m][1];
#pragma unroll
                    for (int j = 0; j < 4; ++j) { const float a = fmaxf(v0[j], 0.f), b = fmaxf(v1[j], 0.f); v0[j] = a * a; v1[j] = b * b; }
                    v4u w; w.x = pk2(v0[0], v0[1]); w.y = pk2(v0[2], v0[3]); w.z = pk2(v1[0], v1[1]); w.w = pk2(v1[2], v1[3]); *(GAS v4u*)(rowp + bj * 128) = w; } }
    }
};
namespace pa {
constexpr int SHM = 16384;
#define PA_KSWZ(row, colB) ((row) * 256 + ((colB) ^ (((row) & 7) << 4)))
__device__ __forceinline__ int v_st(int k, int c) { const int kk = (k & ~0xC) | ((k & 4) << 1) | ((k & 8) >> 1); return ((kk >> 3) * 4 + (c >> 5)) * 512 + ((kk & 7) * 32 + (c & 31)) * 2; }
__device__ __forceinline__ int v_rd_base(int lane) { return ((lane & 3) << 3) | (((lane >> 2) & 3) << 6) | (((lane >> 4) & 1) << 5) | (((lane >> 5) & 1) << 8); }
constexpr int v_rd_off(int d0, int ks, int half) { return d0 * 512 + ks * 4096 + half * 2048; }
__device__ __forceinline__ int crow(int r, int hi) { return (r & 3) + 8 * (r >> 2) + 4 * hi; }

template <int KB>
__device__ __forceinline__ void qkt(f32x16& p0, f32x16& p1, const char* K_lds, int r32, int hi, const bf16x8* qr) {
    p0 = f32x16{}; p1 = f32x16{};
    const char* kb[4];
#pragma unroll
    for (int dd = 0; dd < 4; ++dd) kb[dd] = K_lds + KB * SHM + PA_KSWZ(r32, (dd * 16 + hi * 8) * 2);
#pragma unroll
    for (int d0 = 0; d0 < 6; ++d0) { const char* a = kb[d0 & 3] + (d0 >> 2) * 128;
        const bf16x8 b0 = *reinterpret_cast<const bf16x8*>(a);
        const bf16x8 b1 = *reinterpret_cast<const bf16x8*>(a + 32 * 256);
        p0 = __builtin_amdgcn_mfma_f32_32x32x16_bf16(b0, qr[d0], p0, 0, 0, 0);
        p1 = __builtin_amdgcn_mfma_f32_32x32x16_bf16(b1, qr[d0], p1, 0, 0, 0); }
}
template <int VB>
__device__ __forceinline__ void pv_tile(f32x16* o, int vb0, bf16x8 pa0, bf16x8 pa1, bf16x8 pa2, bf16x8 pa3) {
#define TRRD(dst, off) asm volatile("ds_read_b64_tr_b16 %0, %1 offset:%2" : "=&v"(dst) : "v"(vb0), "i"(off) : "memory")
#define PV_D0(d0) do { s16x4 l0, l1, l2, l3, h0, h1, h2, h3; constexpr int b_ = VB * SHM + v_rd_off(d0, 0, 0); \
        TRRD(l0, b_); TRRD(h0, b_ + 2048); TRRD(l1, b_ + 4096); TRRD(h1, b_ + 6144); TRRD(l2, b_ + 8192); TRRD(h2, b_ + 10240); TRRD(l3, b_ + 12288); TRRD(h3, b_ + 14336); \
        asm volatile("s_waitcnt lgkmcnt(0)" ::: "memory"); SBAR(); \
        o[d0] = __builtin_amdgcn_mfma_f32_32x32x16_bf16(pa0, (bf16x8){l0[0], l0[1], l0[2], l0[3], h0[0], h0[1], h0[2], h0[3]}, o[d0], 0, 0, 0); \
        o[d0] = __builtin_amdgcn_mfma_f32_32x32x16_bf16(pa1, (bf16x8){l1[0], l1[1], l1[2], l1[3], h1[0], h1[1], h1[2], h1[3]}, o[d0], 0, 0, 0); \
        o[d0] = __builtin_amdgcn_mfma_f32_32x32x16_bf16(pa2, (bf16x8){l2[0], l2[1], l2[2], l2[3], h2[0], h2[1], h2[2], h2[3]}, o[d0], 0, 0, 0); \
        o[d0] = __builtin_amdgcn_mfma_f32_32x32x16_bf16(pa3, (bf16x8){l3[0], l3[1], l3[2], l3[3], h3[0], h3[1], h3[2], h3[3]}, o[d0], 0, 0, 0); } while (0)
    PV_D0(0); PV_D0(1); PV_D0(2); PV_D0(3);
#undef PV_D0
#undef TRRD
}
__device__ __forceinline__ void mask_tile(f32x16& p0, f32x16& p1, int dq) {
    const float NEG = -__builtin_inff();
#pragma unroll
    for (int r = 0; r < 16; ++r) { const int c = (r & 3) + 8 * (r >> 2);
        if (dq - c < 0) p0[r] = NEG;
        if (dq - c - 32 < 0) p1[r] = NEG; }
}
__device__ __forceinline__ void exp_half(f32x16& p, float b2) {
#pragma unroll
    for (int r = 0; r < 16; ++r) p[r] = __builtin_amdgcn_exp2f(p[r] - b2);
}
__device__ __forceinline__ void finish(f32x16& p0, f32x16& p1, float b2, float& l_reg, bf16x8& pa0, bf16x8& pa1, bf16x8& pa2, bf16x8& pa3) {
    exp_half(p1, b2);
    float ps = 0.f;
#pragma unroll
    for (int r = 0; r < 16; ++r) ps += p0[r];
#pragma unroll
    for (int r = 0; r < 16; ++r) ps += p1[r];
    ps = sum_x32(ps);
    l_reg += ps;
#define PK4(P, B_, OUT) do { unsigned a0 = pk2(P[B_ + 0], P[B_ + 1]), a1 = pk2(P[B_ + 2], P[B_ + 3]); unsigned b0 = pk2(P[B_ + 4], P[B_ + 5]), b1 = pk2(P[B_ + 6], P[B_ + 7]); \
        auto r0 = __builtin_amdgcn_permlane32_swap(a0, b0, false, false); auto r1 = __builtin_amdgcn_permlane32_swap(a1, b1, false, false); \
        v4u w = {r0[0], r1[0], r0[1], r1[1]}; OUT = *reinterpret_cast<bf16x8*>(&w); } while (0)
    PK4(p0, 0, pa0); PK4(p0, 8, pa1); PK4(p1, 0, pa2); PK4(p1, 8, pa3);
#undef PK4
}
struct Ctx { const bf16* QR; const bf16* KH; const bf16* VH; const bf16* PG; const bf16* GATE; bf16* AM; const float* ROPE; const float* gqn; const float* gqr; float b2; };

__device__ __forceinline__ void unit(const Ctx& C, int b, int h, int j, char* lds, LAS unsigned char* F_lds) {
    int tid = threadIdx.x; asm volatile("" : "+v"(tid));
    const int wid = __builtin_amdgcn_readfirstlane(tid >> 6), lane = tid & 63, r32 = lane & 31, hi = lane >> 5;
    const int P0 = NMETA + 256 * j, NT = 4 * j + 5;
    const int m0 = b * SEQ + 256 * j;
    char* V_lds = lds; char* K_lds = lds + 3 * SHM; float* li_l = (float*)(lds + 5 * SHM) + wid * 64;
    const bf16* Kh = C.KH + (size_t)b * TT * 768 + h * QKH; const bf16* Vh = C.VH + (size_t)b * TT * 1024 + h * VHD;
    bf16x8 qr[6];
    { const int mrow = m0 + wid * 32 + r32, pos = P0 + wid * 32 + r32;
      const bf16* qp = C.QR + (size_t)mrow * 768 + h * QKH + hi * 8;
      float f[6][8]; float ss = 0.f;
#pragma unroll
      for (int d0 = 0; d0 < 6; ++d0) { const v4u q = *(const GAS v4u*)(qp + d0 * 16);
          f[d0][0] = bflo(q.x); f[d0][1] = bfhi(q.x); f[d0][2] = bflo(q.y); f[d0][3] = bfhi(q.y); f[d0][4] = bflo(q.z); f[d0][5] = bfhi(q.z); f[d0][6] = bflo(q.w); f[d0][7] = bfhi(q.w);
#pragma unroll
          for (int e = 0; e < 8; ++e) ss += f[d0][e] * f[d0][e]; }
      ss = sum_x32(ss);
      const float rs = frsqrt(ss * (1.f / QKH) + EPS) * SCALE_L2E;
      const float* rp = C.ROPE + (size_t)pos * 32 + hi * 8;
#pragma unroll
      for (int e = 0; e < 8; ++e) { const float cs = rp[e], sn = rp[16 + e], x1 = f[4][e], x2 = f[5][e], g = C.gqr[hi * 8 + e] * rs;
          f[4][e] = (x1 * cs - x2 * sn) * g; f[5][e] = (x2 * cs + x1 * sn) * g; }
#pragma unroll
      for (int d0 = 0; d0 < 4; ++d0)
#pragma unroll
          for (int e = 0; e < 8; ++e) f[d0][e] *= C.gqn[d0 * 16 + hi * 8 + e] * rs;
#pragma unroll
      for (int d0 = 0; d0 < 6; ++d0) { v4u w; w.x = pk2(f[d0][0], f[d0][1]); w.y = pk2(f[d0][2], f[d0][3]); w.z = pk2(f[d0][4], f[d0][5]); w.w = pk2(f[d0][6], f[d0][7]); qr[d0] = *reinterpret_cast<bf16x8*>(&w); }
    }
    const int sr = tid >> 4, sc = (tid & 15) * 8, vst0 = v_st(sr, sc), vst1 = v_st(32 + sr, sc), kws = PA_KSWZ(sr, sc * 2);
    const int vb0 = (int)(uintptr_t)V_lds + v_rd_base(lane);
    const int qpos = P0 + wid * 32 + r32 - 4 * hi, qlo = P0 + wid * 32;
    const float b2 = C.b2;
    bf16x8 st_v0, st_v1, st_k0, st_k1;
    const unsigned kvo = (unsigned)(sr * 768 + sc) * 2u, vvo = (unsigned)(sr * 1024 + sc) * 2u;
#define SLOAD(k0) do { const char* kt_ = (const char*)Kh + (size_t)(k0) * 1536; const char* vt_ = (const char*)Vh + (size_t)(k0) * 2048; \
        st_v0 = *(const GAS bf16x8*)(vt_ + vvo); st_v1 = *(const GAS bf16x8*)(vt_ + 65536 + vvo); st_k0 = *(const GAS bf16x8*)(kt_ + kvo); st_k1 = *(const GAS bf16x8*)(kt_ + 49152 + kvo); } while (0)
#define SWRITE(kbf, voff) do { *(bf16x8*)(V_lds + (voff) + vst0) = st_v0; *(bf16x8*)(V_lds + (voff) + vst1) = st_v1; *(bf16x8*)(K_lds + (kbf) * SHM + kws) = st_k0; *(bf16x8*)(K_lds + (kbf) * SHM + kws + 32 * 256) = st_k1; } while (0)
#define MASKT(PX0, PX1, t) do { const int kb_ = (t) * 64; if (kb_ + 63 > qlo) mask_tile(PX0, PX1, qpos - kb_); } while (0)
    float l_reg = 0.f; f32x16 o[4] = {};
    f32x16 pA0, pA1, pB0, pB1; bf16x8 pa0, pa1, pa2, pa3;
    SLOAD(0); VM_WAIT(); SWRITE(0, 0); SBAR();
    SLOAD(64);
    __syncthreads();
    SBAR(); qkt<0>(pA0, pA1, K_lds, r32, hi, qr);
    MASKT(pA0, pA1, 0); exp_half(pA0, b2);
    VM_WAIT(); SWRITE(1, SHM);
    __syncthreads();
    int vr = 0;
#define HALF_STEP(PX0, PX1, PY0, PY1, t, KB, SB) do { \
        if ((t) + 1 < NT) { SLOAD(((t) + 1) * 64); }   \
        SBAR(); qkt<KB>(PX0, PX1, K_lds, r32, hi, qr); \
        finish(PY0, PY1, b2, l_reg, pa0, pa1, pa2, pa3); \
        pv_tile<0>(o, vb0 + vr, pa0, pa1, pa2, pa3); MASKT(PX0, PX1, (t)); exp_half(PX0, b2); \
        { const int vw = (vr >= SHM) ? vr - SHM : vr + 2 * SHM;                  \
          if ((t) + 1 < NT) { VM_WAIT(); SWRITE(SB, vw); } } \
        vr = (vr == 2 * SHM) ? 0 : vr + SHM; \
        __syncthreads(); } while (0)
    for (int t = 1; t + 1 < NT; t += 2) {
        HALF_STEP(pB0, pB1, pA0, pA1, t, 1, 0);
        HALF_STEP(pA0, pA1, pB0, pB1, t + 1, 0, 1);
    }
    finish(pA0, pA1, b2, l_reg, pa0, pa1, pa2, pa3); SBAR();
    pv_tile<0>(o, vb0 + vr, pa0, pa1, pa2, pa3);
    if (hi == 0) li_l[r32] = l_reg;
    asm volatile("s_waitcnt lgkmcnt(0)" ::: "memory");
    float rli[16];
#pragma unroll
    for (int r = 0; r < 16; ++r) rli[r] = __builtin_amdgcn_rcpf(li_l[crow(r, hi)]);
    __syncthreads();
    {
        LAS float* ot = (LAS float*)F_lds + wid * (32 * 132);
#pragma unroll
        for (int r = 0; r < 16; ++r)
#pragma unroll
            for (int d0 = 0; d0 < 4; ++d0) ot[crow(r, hi) * 132 + d0 * 32 + r32] = o[d0][r] * rli[r];
        asm volatile("s_waitcnt lgkmcnt(0)" ::: "memory");
        const int row = lane & 31, hf = lane >> 5; const size_t mrow = (size_t)(m0 + wid * 32 + row); const int col0 = h * VHD + hf * 64;
        const GAS v4u* gp = (const GAS v4u*)(C.GATE + mrow * 2048 + DM + col0); const GAS v4u* pp = (const GAS v4u*)(C.PG + mrow * DM + col0); GAS v4u* ap = (GAS v4u*)(C.AM + mrow * DM + col0);
        const LAS f32x4* orow = (const LAS f32x4*)(ot + row * 132 + hf * 64);
#pragma unroll
        for (int c = 0; c < 8; ++c) { const v4u g = gp[c], q = pp[c]; const f32x4 a = orow[2 * c], b = orow[2 * c + 1]; v4u w;
            w.x = pk2(bflo(q.x) + bflo(g.x) * a.x, bfhi(q.x) + bfhi(g.x) * a.y); w.y = pk2(bflo(q.y) + bflo(g.y) * a.z, bfhi(q.y) + bfhi(g.y) * a.w);
            w.z = pk2(bflo(q.z) + bflo(g.z) * b.x, bfhi(q.z) + bfhi(g.z) * b.y); w.w = pk2(bflo(q.w) + bflo(g.w) * b.z, bfhi(q.w) + bfhi(g.w) * b.w);
            ap[c] = w; }
    }
    __syncthreads();
#undef HALF_STEP
#undef MASKT
#undef SWRITE
#undef SLOAD
}
}
namespace sa {
constexpr int TK = 32, CT_HALF = 8192, CT_BYTES = 16384, KRT_PITCH = 80, KRT_BYTES = TK * KRT_PITCH, PL_PITCH = 96, PL_BYTES = 72 * PL_PITCH  , LZ_BYTES = 32768 + 4096;
constexpr int OFF_CT = 0, OFF_LZ = 3 * CT_BYTES, OFF_KRT = OFF_LZ + 2 * LZ_BYTES, OFF_KSS = OFF_KRT + 3 * KRT_BYTES, OFF_PL = OFF_KSS + 3 * 128, OFF_PT = OFF_PL + 2 * PL_BYTES,
              OFF_QF = OFF_PT + 256, OFF_END = OFF_QF + 8 * 1536;
#ifndef SMALL_LDS
static_assert(OFF_END <= RING_BYTES, "sample attention LDS");
#endif
__device__ __forceinline__ unsigned off_b(unsigned row, unsigned ch) { return 256u * row + 16u * (ch ^ (((row & 3) << 2) | ((0u - (row >> 2)) & 3))); }
typedef float f32x4_t __attribute__((ext_vector_type(4)));
struct Ctx { const float* cache_c; const float* cache_kr; const int* page_table; const float* new_c; const float* new_kr; const bf16* QR; const bf16* Wuk_t; const float* ROPE;
             const float *gqn, *gqr, *gkn, *gkr; float* SAC; float* SAL; float b2; };

typedef short v4i16_t __attribute__((ext_vector_type(4)));
__device__ __forceinline__ s16x4 tr_read(unsigned addr) { return __builtin_bit_cast(s16x4, __builtin_amdgcn_ds_read_tr16_b64_v4i16((__attribute__((address_space(3))) v4i16_t*)(uintptr_t)addr)); }

__device__ __forceinline__ void item(const Ctx& C, int db, int hf, LAS unsigned char* lds) {
    int tid = threadIdx.x; asm volatile("" : "+v"(tid));
    const int wid = __builtin_amdgcn_readfirstlane(tid >> 6), lane = tid & 63, fr = lane & 15, fq = lane >> 4;
    const int h = wid;
    volatile LAS int* pt = (volatile LAS int*)(lds + OFF_PT);
    { const int* ptg = C.page_table + db * NPAGES + hf * 32; asm volatile("" : "+s"(ptg)); if (tid < 32) pt[tid] = ptg[tid]; }
    {
        bf16x8 Aq0, Aq1, Aqr;
        const int s = fr & 7; const int mrow = MP + db * DSEQ + s;
        const bf16* qrb = C.QR; asm volatile("" : "+s"(qrb));
        const bf16* qp = qrb + (size_t)mrow * 768 + h * QKH;
        float qn[2][8], qro[8], ss = 0.f;
#pragma unroll
        for (int ii = 0; ii < 2; ++ii)
#pragma unroll
            for (int j = 0; j < 8; ++j) { const int d = 16 * (2 * ii + (j >> 2)) + 4 * fq + (j & 3); const float v = bflo((unsigned)qp[d]); qn[ii][j] = v; ss += v * v; }
        const float* rp = C.ROPE + (size_t)(TT + s) * 32;
#pragma unroll
        for (int j = 0; j < 8; ++j) { const int i = 8 * fq + j, i2 = i & 15; const float own = bflo((unsigned)qp[64 + i]), oth = bflo((unsigned)qp[64 + (i ^ 16)]);
            ss += own * own;
            const float cs = rp[i2], sn = rp[16 + i2];
            qro[j] = (i < 16) ? own * cs - oth * sn : own * cs + oth * sn; }
        ss = sum_x32(sum_x16(ss));
        const float rs = (fr < 8) ? frsqrt(ss * (1.f / QKH) + EPS) * SCALE_L2E : 0.f;
#pragma unroll
        for (int ii = 0; ii < 2; ++ii)
#pragma unroll
            for (int j = 0; j < 8; ++j) { const int d = 16 * (2 * ii + (j >> 2)) + 4 * fq + (j & 3); qn[ii][j] *= rs * C.gqn[d] * C.gkn[d]; }
#pragma unroll
        for (int j = 0; j < 8; ++j) { const int i2 = (8 * fq + j) & 15; qro[j] *= rs * C.gqr[i2] * C.gkr[i2]; }
        v4u w; w.x = pk2(qn[0][0], qn[0][1]); w.y = pk2(qn[0][2], qn[0][3]); w.z = pk2(qn[0][4], qn[0][5]); w.w = pk2(qn[0][6], qn[0][7]); Aq0 = *reinterpret_cast<bf16x8*>(&w);
        w.x = pk2(qn[1][0], qn[1][1]); w.y = pk2(qn[1][2], qn[1][3]); w.z = pk2(qn[1][4], qn[1][5]); w.w = pk2(qn[1][6], qn[1][7]); Aq1 = *reinterpret_cast<bf16x8*>(&w);
        w.x = pk2(qro[0], qro[1]); w.y = pk2(qro[2], qro[3]); w.z = pk2(qro[4], qro[5]); w.w = pk2(qro[6], qro[7]); Aqr = *reinterpret_cast<bf16x8*>(&w);
        if (fr < 8) { LAS bf16x8* qf = (LAS bf16x8*)(lds + OFF_QF + wid * 1536) + fq * 8 + fr; qf[0] = Aq0; qf[32] = Aq1; qf[64] = Aqr; }
    }
    __syncthreads();
    bf16x8 Wf[4][8];
    { const bf16* wp = C.Wuk_t + (size_t)(h * 64 + fr) * KVL + 8 * fq;
#pragma unroll
      for (int i = 0; i < 4; ++i)
#pragma unroll
          for (int ks = 0; ks < 8; ++ks) Wf[i][ks] = *(const GAS bf16x8*)(wp + (size_t)(16 * i) * KVL + 32 * ks);
#pragma unroll
      for (int i = 0; i < 4; ++i)
#pragma unroll
          for (int ks = 0; ks < 8; ++ks) asm volatile("" : "+v"(Wf[i][ks])); }
    const int NT = hf ? 129 : 128;
    const unsigned xr = ((fr & 3) << 2) | ((0u - (unsigned)(fr >> 2)) & 3);
#define SA_DMA(uu) do { const int u_ = (uu); LAS unsigned char* lz_ = lds + OFF_LZ + (u_ & 1) * LZ_BYTES; \
        if (u_ < 128) { const size_t phys = (size_t)__builtin_amdgcn_readfirstlane(pt[u_ >> 2]);     const float* cp = C.cache_c + (phys * PAGE + (u_ & 3) * TK) * KVL + lane * 4; \
            _Pragma("unroll") for (int i = 0; i < 4; ++i) __builtin_amdgcn_global_load_lds((const unsigned*)(cp + (size_t)(i * 8 + wid) * KVL), (LAS unsigned*)(lz_ + (i * 8 + wid) * 1024), 16, 0, 2); \
            if (wid < 4) { const float* kp = C.cache_kr + (phys * PAGE + (u_ & 3) * TK) * QKR + (wid * 64 + lane) * 4; __builtin_amdgcn_global_load_lds((const unsigned*)kp, (LAS unsigned*)(lz_ + 32768 + wid * 1024), 16, 0, 2); } } \
        else { int ln_ = lane; asm volatile("" : "+v"(ln_));   \
            const float* sp_ = C.new_c + (size_t)(db * DSEQ + wid) * KVL + ln_ * 4; \
            _Pragma("unroll") for (int i = 0; i < 4; ++i) __builtin_amdgcn_global_load_lds((const unsigned*)sp_, (LAS unsigned*)(lz_ + (i * 8 + wid) * 1024), 16, 0, 0); \
            if (wid < 4) __builtin_amdgcn_global_load_lds((const unsigned*)(C.new_kr + (size_t)db * DSEQ * QKR + ln_ * 4), (LAS unsigned*)(lz_ + 32768 + wid * 1024), 16, 0, 0); } } while (0)
#define SA_CONVERT(uu, bb) do { const int u_ = (uu); const unsigned lz_ = (unsigned)(uintptr_t)(lds + OFF_LZ) + (u_ & 1) * LZ_BYTES + wid * 1024 + lane * 16; \
        LAS unsigned char* ct_ = lds + OFF_CT + (bb) * CT_BYTES + (lane >> 5) * CT_HALF; const unsigned co_ = ((lane & 31) >> 1), cb_ = 8 * (lane & 1); \
        f32x4 v0_, v1_, v2_, v3_, k_;   \
        asm volatile("ds_read_b128 %0, %1" : "=v"(v0_) : "v"(lz_)); asm volatile("ds_read_b128 %0, %1 offset:8192" : "=v"(v1_) : "v"(lz_)); \
        asm volatile("ds_read_b128 %0, %1 offset:16384" : "=v"(v2_) : "v"(lz_)); asm volatile("ds_read_b128 %0, %1 offset:24576" : "=v"(v3_) : "v"(lz_)); \
        if (wid < 4) asm volatile("ds_read_b128 %0, %1 offset:32768" : "=v"(k_) : "v"(lz_)); \
        asm volatile("s_waitcnt lgkmcnt(0)" : "+v"(v0_), "+v"(v1_), "+v"(v2_), "+v"(v3_)); \
        if (u_ >= 128) { v1_ = v1_ * 0.f; v2_ = v2_ * 0.f; v3_ = v3_ * 0.f; } \
        { v2u w_; w_.x = pk2(v0_.x, v0_.y); w_.y = pk2(v0_.z, v0_.w); *(LAS v2u*)(ct_ + off_b(wid, co_) + cb_) = w_; } \
        { v2u w_; w_.x = pk2(v1_.x, v1_.y); w_.y = pk2(v1_.z, v1_.w); *(LAS v2u*)(ct_ + off_b(8 + wid, co_) + cb_) = w_; } \
        { v2u w_; w_.x = pk2(v2_.x, v2_.y); w_.y = pk2(v2_.z, v2_.w); *(LAS v2u*)(ct_ + off_b(16 + wid, co_) + cb_) = w_; } \
        { v2u w_; w_.x = pk2(v3_.x, v3_.y); w_.y = pk2(v3_.z, v3_.w); *(LAS v2u*)(ct_ + off_b(24 + wid, co_) + cb_) = w_; } \
        if (wid < 4) { asm volatile("" : "+v"(k_)); if (u_ >= 128 && wid > 0) k_ = k_ * 0.f; \
          v2u w_; w_.x = pk2(k_.x, k_.y); w_.y = pk2(k_.z, k_.w); *(LAS v2u*)(lds + OFF_KRT + (bb) * KRT_BYTES + (wid * 8 + (lane >> 3)) * KRT_PITCH + (lane & 7) * 8) = w_; \
          float s_ = (k_.x * k_.x + k_.y * k_.y) + (k_.z * k_.z + k_.w * k_.w); s_ = sum_oct(s_); if ((lane & 7) == 0) *(LAS float*)(lds + OFF_KSS + (bb) * 128 + (wid * 8 + (lane >> 3)) * 4) = s_; } } while (0)
#define SA_BAR() do { asm volatile("s_waitcnt lgkmcnt(0)" ::: "memory"); __builtin_amdgcn_s_barrier(); asm volatile("" ::: "memory"); } while (0)
#define SA_WAIT_OLDER() do { if (wid < 4) asm volatile("s_waitcnt vmcnt(5)" ::: "memory"); else asm volatile("s_waitcnt vmcnt(4)" ::: "memory"); } while (0)
#define SA_CTX(bb, pb) do { int lc_ = lane; asm volatile("" : "+v"(lc_)); const int frc = lc_ & 15, fqc = lc_ >> 4; \
        const unsigned ctb = (unsigned)(uintptr_t)(lds + OFF_CT) + (bb) * CT_BYTES + hh * CT_HALF; \
        const LAS unsigned char* plb = lds + OFF_PL + (pb) * PL_BYTES + frc * PL_PITCH + fqc * 16; \
        s16x4 tv[2][2]; \
        { const unsigned row = 8 * fqc + (frc >> 2), pp = lc_ & 3; const unsigned a0_ = ctb + off_b(row, 2 * c0 + (pp >> 1)) + 8 * (pp & 1); \
            \
          const unsigned a1_ = a0_ ^ 0x20u, a2_ = a0_ ^ 0x30u, a3_ = a0_ ^ 0x10u; \
          asm volatile("ds_read_b64_tr_b16 %0, %1" : "=&v"(tv[0][0]) : "v"(a0_) : "memory"); asm volatile("ds_read_b64_tr_b16 %0, %1 offset:1024" : "=&v"(tv[0][1]) : "v"(a2_) : "memory"); \
          asm volatile("ds_read_b64_tr_b16 %0, %1" : "=&v"(tv[1][0]) : "v"(a1_) : "memory"); asm volatile("ds_read_b64_tr_b16 %0, %1 offset:1024" : "=&v"(tv[1][1]) : "v"(a3_) : "memory"); } \
        bf16x8 A[4]; _Pragma("unroll") for (int rt = 0; rt < 4; ++rt) A[rt] = *(const LAS bf16x8*)(plb + rt * 16 * PL_PITCH); \
        const bf16x8 Al = *(const LAS bf16x8*)(plb + srt * 16 * PL_PITCH); \
        asm volatile("s_waitcnt lgkmcnt(0)" ::: "memory"); __builtin_amdgcn_sched_barrier(0); \
        const bf16x8 B0 = (bf16x8){tv[0][0][0], tv[0][0][1], tv[0][0][2], tv[0][0][3], tv[0][1][0], tv[0][1][1], tv[0][1][2], tv[0][1][3]}; \
        const bf16x8 B1 = (bf16x8){tv[1][0][0], tv[1][0][1], tv[1][0][2], tv[1][0][3], tv[1][1][0], tv[1][1][1], tv[1][1][2], tv[1][1][3]}; \
        _Pragma("unroll") for (int rt = 0; rt < 4; ++rt) { ctx[rt][0] = __builtin_amdgcn_mfma_f32_16x16x32_bf16(A[rt], B0, ctx[rt][0], 0, 0, 0); \
                                                            ctx[rt][1] = __builtin_amdgcn_mfma_f32_16x16x32_bf16(A[rt], B1, ctx[rt][1], 0, 0, 0); } \
        { const v4u au = *reinterpret_cast<const v4u*>(&Al); \
          lacc += ((bflo(au.x) + bfhi(au.x)) + (bflo(au.y) + bfhi(au.y))) + ((bflo(au.z) + bfhi(au.z)) + (bflo(au.w) + bfhi(au.w))); } } while (0)
    f32x4 ctx[4][2];
#pragma unroll
    for (int rt = 0; rt < 4; ++rt) { ctx[rt][0] = (f32x4){0.f, 0.f, 0.f, 0.f}; ctx[rt][1] = (f32x4){0.f, 0.f, 0.f, 0.f}; }
    float lacc = 0.f;
    const float b2 = C.b2;
    const int hh = wid >> 2, c0 = 2 * (wid & 3), srt = wid >> 1;
    const int prow = (fq < 2) ? h * 8 + 4 * fq : 64 + 4 * (fq - 2);
    SA_DMA(0); SA_DMA(1); SA_WAIT_OLDER(); SA_CONVERT(0, 0); SA_DMA(2);
#ifdef SYNTH_MFMA
    {
        f32x4 Y[4]; for (int i = 0; i < 4; ++i) Y[i] = (f32x4){0.f, 0.f, 0.f, 0.f};
        bf16x8 Bs = Wf[0][0]; int nsy_ = 258; asm volatile("" : "+s"(nsy_));
        for (int r = 0; r < nsy_; ++r) {
#if SYNTH_MFMA == 2
            { const unsigned a_ = (unsigned)(uintptr_t)(lds + OFF_CT) + 256 * fr + 16 * (fq ^ xr); asm volatile("ds_read_b128 %0, %1\n\ts_waitcnt lgkmcnt(0)" : "=v"(Bs) : "v"(a_)); }
#endif
#pragma unroll
            for (int ks = 0; ks < 8; ++ks) {
#pragma unroll
                for (int i = 0; i < 4; ++i) Y[i] = __builtin_amdgcn_mfma_f32_16x16x32_bf16(Wf[i][ks], Bs, Y[i], 0, 0, 0); }
            asm volatile("" : "+v"(Bs));
        }
        float z_ = 0.f; asm volatile("" : "+v"(z_));
        lacc += (Y[0].x + Y[1].x + Y[2].x + Y[3].x) * z_;
    }
#endif
    SA_BAR();
#ifndef SA_NO_PRIO
    if (wid < 4) __builtin_amdgcn_s_setprio(2);
#endif
    int bc = 0;
    for (int u = 0; u < NT; ++u) {
        const int bn = (bc == 2) ? 0 : bc + 1, bp = (bc == 0) ? 2 : bc - 1;
        const int pb = u & 1;
        const int qlim = (u == 128) ? 0 : 1000;
        if (wid >= 4) { if (u > 0) SA_CTX(bp, pb ^ 1); }
        unsigned ba[4];
#pragma unroll
        for (int j = 0; j < 4; ++j) ba[j] = (unsigned)(uintptr_t)(lds + OFF_CT) + bc * CT_BYTES + 256 * fr + 16 * ((j * 4 + fq) ^ xr);
#define SA_RD(dst, j, off_) asm volatile("ds_read_b128 %0, %1 offset:%2" : "=v"(dst) : "v"(ba[j]), "i"(off_))
#define SA_WT(n, b) asm volatile("s_waitcnt lgkmcnt(" #n ")" : "+v"(b))
#define SA_MF(X, ks, b) do { _Pragma("unroll") for (int i = 0; i < 4; ++i) X[i] = __builtin_amdgcn_mfma_f32_16x16x32_bf16(Wf[i][ks], b, X[i], 0, 0, 0); } while (0)
#define SA_PRE(KO, B0, B1, B2) do { SA_RD(B0, 0, KO); SA_RD(B1, 1, KO); SA_RD(B2, 2, KO); } while (0)
#define SA_BURST(KO, X, B0, B1, B2) do { \
            SA_WT(2, B0); SA_MF(X, 0, B0); SA_RD(B0, 3, KO); \
            SA_WT(2, B1); SA_MF(X, 1, B1); SA_RD(B1, 0, KO + CT_HALF); \
            SA_WT(2, B2); SA_MF(X, 2, B2); SA_RD(B2, 1, KO + CT_HALF); \
            SA_WT(2, B0); SA_MF(X, 3, B0); SA_RD(B0, 2, KO + CT_HALF); \
            SA_WT(2, B1); SA_MF(X, 4, B1); SA_RD(B1, 3, KO + CT_HALF); \
            SA_WT(2, B2); SA_MF(X, 5, B2); \
            SA_WT(1, B0); SA_MF(X, 6, B0); \
            SA_WT(0, B1); SA_MF(X, 7, B1); } while (0)
#define SA_TAIL(kg, X) do { \
            float ss = 0.f; \
            _Pragma("unroll") for (int i = 0; i < 4; ++i) ss += (X[i].x * X[i].x + X[i].y * X[i].y) + (X[i].z * X[i].z + X[i].w * X[i].w); \
            ss = sum_x32(sum_x16(ss)); \
            const float krss = *(const LAS float*)(lds + OFF_KSS + bc * 128 + (kg * 16 + fr) * 4); \
            const float rstd = __builtin_amdgcn_rsqf((ss + krss) * (1.f / QKH) + EPS); \
            v4u w0, w1; w0.x = pk2(X[0].x, X[0].y); w0.y = pk2(X[0].z, X[0].w); w0.z = pk2(X[1].x, X[1].y); w0.w = pk2(X[1].z, X[1].w); \
            w1.x = pk2(X[2].x, X[2].y); w1.y = pk2(X[2].z, X[2].w); w1.z = pk2(X[3].x, X[3].y); w1.w = pk2(X[3].z, X[3].w); \
            const bf16x8 krf = *(const LAS bf16x8*)(lds + OFF_KRT + bc * KRT_BYTES + (kg * 16 + fr) * KRT_PITCH + fq * 16); \
            f32x4 S = (f32x4){0.f, 0.f, 0.f, 0.f}; \
            const LAS bf16x8* qf = (const LAS bf16x8*)(lds + OFF_QF + wid * 1536) + fq * 8 + (fr & 7); \
            const bf16x8 Aq0 = qf[0], Aq1 = qf[32], Aqr = qf[64];                \
            S = __builtin_amdgcn_mfma_f32_16x16x32_bf16(Aq0, *reinterpret_cast<bf16x8*>(&w0), S, 0, 0, 0); \
            S = __builtin_amdgcn_mfma_f32_16x16x32_bf16(Aq1, *reinterpret_cast<bf16x8*>(&w1), S, 0, 0, 0); \
            S = __builtin_amdgcn_mfma_f32_16x16x32_bf16(Aqr, krf, S, 0, 0, 0); \
            f32x4 p; \
            _Pragma("unroll") for (int e = 0; e < 4; ++e) p[e] = __builtin_amdgcn_exp2f(S[e] * rstd - b2); \
            { const int kk = kg * 16 + fr - 4 * fq;                               \
              _Pragma("unroll") for (int e = 0; e < 4; ++e) p[e] = (kk > e + qlim) ? 0.f : p[e]; } \
            { LAS bf16* pl = (LAS bf16*)(lds + OFF_PL + pb * PL_BYTES + prow * PL_PITCH) + kg * 16 + fr;     \
              _Pragma("unroll") for (int e = 0; e < 4; ++e) pl[e * (PL_PITCH / 2)] = (bf16)pk2(p[e], 0.f); } } while (0)
#ifdef SA_REP_SCORE
        int nrs_ = 2; asm volatile("" : "+s"(nrs_)); for (int rs_ = 0; rs_ < nrs_; ++rs_)
#endif
        {
            f32x4 Xa[4], Xb[4];
#pragma unroll
            for (int i = 0; i < 4; ++i) { Xa[i] = (f32x4){0.f, 0.f, 0.f, 0.f}; Xb[i] = (f32x4){0.f, 0.f, 0.f, 0.f}; }
            bf16x8 Ba0, Ba1, Ba2, Bb0, Bb1, Bb2;
            SA_PRE(0, Ba0, Ba1, Ba2);
            SA_BURST(0, Xa, Ba0, Ba1, Ba2);
            SA_PRE(4096, Bb0, Bb1, Bb2);
            SA_BURST(4096, Xb, Bb0, Bb1, Bb2);
            SA_TAIL(0, Xa);
            SA_TAIL(1, Xb);
#ifdef SA_REP_TAIL
            { int nt_ = 1; asm volatile("" : "+s"(nt_)); for (int r_ = 0; r_ < nt_; ++r_) { asm volatile("" : "+v"(Xb[0]), "+v"(Xb[1]), "+v"(Xb[2]), "+v"(Xb[3])); SA_TAIL(1, Xb); } }
#endif
        }
#undef SA_RD
#undef SA_WT
#undef SA_MF
#undef SA_PRE
#undef SA_BURST
#undef SA_TAIL
        if (wid < 4) { if (u > 0) SA_CTX(bp, pb ^ 1); }
        if (u + 1 < NT) {
            if (u + 2 < NT) SA_WAIT_OLDER(); else VM_WAIT();
            SA_CONVERT(u + 1, bn);
            if (u + 3 < NT) SA_DMA(u + 3);
        }
        SA_BAR();
        bc = bn;
    }
    { const int bl = (bc == 0) ? 2 : bc - 1; SA_CTX(bl, (NT - 1) & 1); }
#ifndef SA_NO_PRIO
    __builtin_amdgcn_s_setprio(0);
#endif
    const int it = db * 2 + hf;
    lacc = sum_x32(sum_x16(lacc));
    if (fq == 0 && (fr >> 3) == (wid & 1)) C.SAL[(size_t)it * 64 + h * 8 + (fr & 7)] = lacc;
    float* cp = C.SAC + (size_t)it * 64 * 256;
#pragma unroll
    for (int rt = 0; rt < 4; ++rt)
#pragma unroll
        for (int cb = 0; cb < 2; ++cb)
#pragma unroll
            for (int e = 0; e < 4; ++e) cp[(size_t)(rt * 16 + 4 * fq + e) * 256 + hh * 128 + 16 * (c0 + cb) + fr] = ctx[rt][cb][e];
    __syncthreads();
#undef SA_DMA
#undef SA_CONVERT
#undef SA_BAR
#undef SA_WAIT_OLDER
#undef SA_CTX
}
}
namespace g2 {
using pg8::Unit; using pg8::Gemm;
constexpr int TILE_BYTES = 32768, BUF_BYTES = 65536;
template <class Epi, class Sched>
__device__ __forceinline__ void gemm_phase(LAS unsigned char* lds, const Gemm g, const Sched& S, const Epi& E) {
    int tid = threadIdx.x; asm volatile("" : "+v"(tid));
    const int wid = __builtin_amdgcn_readfirstlane(tid >> 6), lane = tid & 63, wr = wid >> 2, wc = wid & 3, fr = lane & 15, fq = lane >> 4;
    const int K = g.K, nt = K / 64;
    Unit cur, nxt;
    if (!S.next(0, cur)) return;
    const int srow = tid >> 3, sch = tid & 7;
    const int rb0 = Epi::PERM ? ((srow & ~31) + pg8::perm32(srow & 31)) : srow;
    const unsigned goffA0 = (unsigned)(srow * K + sch * 8) * 2u, goffB0 = (unsigned)(rb0 * K + sch * 8) * 2u, loff0 = (unsigned)(srow * 128 + ((sch ^ (srow & 7)) << 4));
    const size_t rstep = (size_t)64 * K * 2;
    const size_t tstep = (size_t)256 * K * 2;
    const unsigned cx0 = (unsigned)(((0 + fq) ^ (fr & 7)) << 4), cx1 = (unsigned)(((4 + fq) ^ (fr & 7)) << 4);
    const unsigned abase = (unsigned)((64 * wr + fr) * 128), bbase = (unsigned)(TILE_BYTES + (32 * wc + fr) * 128);
    v4u sa[4], sb[4];
#define G2_LOAD(pa, pb, kt) do { const char* a_ = (pa) + (size_t)(kt) * 128; const char* b_ = (pb) + (size_t)(kt) * 128; \
        _Pragma("unroll") for (int i = 0; i < 4; ++i) { sa[i] = *(const GAS v4u*)(a_ + i * rstep + goffA0); sb[i] = *(const GAS v4u*)(b_ + i * rstep + goffB0); } } while (0)
#define G2_WRITE(buf) do { LAS unsigned char* d_ = lds + (buf) * BUF_BYTES; \
        _Pragma("unroll") for (int i = 0; i < 4; ++i) { *(LAS v4u*)(d_ + i * 8192 + loff0) = sa[i]; *(LAS v4u*)(d_ + TILE_BYTES + i * 8192 + loff0) = sb[i]; } } while (0)
    pg8::f32x4 acc[2][2][4][2];
#define G2_ZERO() do { _Pragma("unroll") for (int a = 0; a < 2; ++a) _Pragma("unroll") for (int b = 0; b < 2; ++b) _Pragma("unroll") for (int m = 0; m < 4; ++m) _Pragma("unroll") for (int n = 0; n < 2; ++n) acc[a][b][m][n] = (pg8::f32x4){0.f, 0.f, 0.f, 0.f}; } while (0)
    G2_ZERO();
    const char* cA = (const char*)g.A + (size_t)cur.pm * tstep; const char* cB = (const char*)g.Bt + (size_t)cur.pn * tstep;
    G2_LOAD(cA, cB, 0); VM_WAIT(); G2_WRITE(0);
    __syncthreads();
    int buf = 0, ui = 0;
    for (;;) {
        const bool has_next = S.next(ui + 1, nxt);
        const char* nA = has_next ? (const char*)g.A + (size_t)nxt.pm * tstep : cA; const char* nB = has_next ? (const char*)g.Bt + (size_t)nxt.pn * tstep : cB;
        for (int kt = 0; kt < nt; ++kt) {
            const bool last = (kt == nt - 1);
            const bool pre = !last || has_next;
            if (pre) { if (last) G2_LOAD(nA, nB, 0); else G2_LOAD(cA, cB, kt + 1); }
            const LAS unsigned char* tb = lds + buf * BUF_BYTES;
#pragma unroll
            for (int ks = 0; ks < 2; ++ks) {
                const unsigned cx = ks ? cx1 : cx0;
                pg8::bf16x8 bf[2][2];
#pragma unroll
                for (int bj = 0; bj < 2; ++bj)
#pragma unroll
                    for (int n = 0; n < 2; ++n) bf[bj][n] = *(const LAS pg8::bf16x8*)(tb + bbase + (128 * bj + 16 * n) * 128 + cx);
#pragma unroll
                for (int ai = 0; ai < 2; ++ai) {
                    pg8::bf16x8 af[4];
#pragma unroll
                    for (int m = 0; m < 4; ++m) af[m] = *(const LAS pg8::bf16x8*)(tb + abase + (128 * ai + 16 * m) * 128 + cx);
#pragma unroll
                    for (int bj = 0; bj < 2; ++bj)
#pragma unroll
                        for (int m = 0; m < 4; ++m)
#pragma unroll
                            for (int n = 0; n < 2; ++n) acc[ai][bj][m][n] = __builtin_amdgcn_mfma_f32_16x16x32_bf16(bf[bj][n], af[m], acc[ai][bj][m][n], 0, 0, 0);
                }
            }
#ifdef G2_SINGLE_BUF
            __syncthreads();
            if (pre) { VM_WAIT(); G2_WRITE(0); }
            __syncthreads();
#else
            if (pre) { VM_WAIT(); G2_WRITE(buf ^ 1); }
            __syncthreads();
            buf ^= 1;
#endif
        }
        E(acc, cur, wr, wc, fr, fq);
        if (!has_next) break;
        G2_ZERO();
        cur = nxt; cA = nA; cB = nB; ++ui;
    }
    __syncthreads();
#undef G2_LOAD
#undef G2_WRITE
#undef G2_ZERO
}
}
__device__ __forceinline__ void p3_meta_kv(Frame& F) {
    const int lane = F.lane, wv = F.wave;
    const float* CM = WSP(float, WS_CM); const float* KRM = WSP(float, WS_KRM); const float* KSM = WSP(float, WS_KSM);
    bf16* KH = WSP(bf16, WS_KH); bf16* VH = WSP(bf16, WS_VH);
    LAS float* part = (LAS float*)F.lds;
    for (int t = F.vcu; t < 256; t += F.G) {
        const int i = (t >> 3) & 15, h = t & 7; const float* c = CM + i * KVL + 32 * wv;
        float a0 = 0.f, a1 = 0.f;
        if (t < 128) {
#pragma unroll
            for (int r = 0; r < 32; ++r) a0 += c[r] * F.w_uk[(size_t)(32 * wv + r) * 512 + h * 64 + lane];
        } else {
#pragma unroll
            for (int r = 0; r < 32; ++r) { const float cr = c[r]; a0 += cr * F.w_uv[(size_t)(32 * wv + r) * 1024 + h * 128 + lane]; a1 += cr * F.w_uv[(size_t)(32 * wv + r) * 1024 + h * 128 + 64 + lane]; }
        }
        part[wv * 128 + lane] = a0; part[wv * 128 + 64 + lane] = a1;
        __syncthreads();
        if (wv == 0) {
            float s0 = 0.f, s1 = 0.f;
#pragma unroll
            for (int w = 0; w < 8; ++w) { s0 += part[w * 128 + lane]; s1 += part[w * 128 + 64 + lane]; }
            if (t < 128) {
                const float ss = wave_sum(s0 * s0);
                const float rstd = frsqrt((ss + KSM[i]) * (1.f / QKH) + EPS);
                const bf16 kv = (bf16)f2bf(s0 * rstd * F.g_kn_nope[lane]);
                const bf16 kr = (bf16)f2bf(KRM[i * 32 + (lane & 31)] * rstd);
                for (int b = 0; b < NBATCH; ++b) { bf16* kp = KH + (size_t)(b * TT + i) * 768 + h * QKH; kp[lane] = kv; if (lane < 32) kp[64 + lane] = kr; }
            } else {
                const bf16 v0 = (bf16)f2bf(s0), v1 = (bf16)f2bf(s1);
                for (int b = 0; b < NBATCH; ++b) { bf16* vp = VH + (size_t)(b * TT + i) * 1024 + h * VHD; vp[lane] = v0; vp[64 + lane] = v1; }
            }
        }
        __syncthreads();
    }
}
__device__ __forceinline__ void p1_naive(Frame& F) {
    const bf16* XN = WSP(bf16, WS_XN); const bf16* Win_t = WSP(bf16, WS_WIN); float* PF = WSP(float, WS_PF); bf16* GATE = WSP(bf16, WS_GATE);
    const size_t gt = (size_t)F.vcu * NWAVES * 64 + F.tid, NGT = (size_t)F.G * NWAVES * 64;
    for (size_t idx = gt; idx < (size_t)MC * (NIN / 8); idx += NGT) {
        const size_t m = idx / (NIN / 8); const int n0 = (int)(idx % (NIN / 8)) * 8;
        float acc[8];
#pragma unroll
        for (int j = 0; j < 8; ++j) acc[j] = 0.f;
        for (int k = 0; k < DM; k += 8) {
            const v4u x = *(const GAS v4u*)(XN + m * DM + k);
            const float xf[8] = {bflo(x.x), bfhi(x.x), bflo(x.y), bfhi(x.y), bflo(x.z), bfhi(x.z), bflo(x.w), bfhi(x.w)};
#pragma unroll
            for (int j = 0; j < 8; ++j) { const v4u w = *(const GAS v4u*)(Win_t + (size_t)(n0 + j) * DM + k);
                acc[j] += xf[0] * bflo(w.x) + xf[1] * bfhi(w.x) + xf[2] * bflo(w.y) + xf[3] * bfhi(w.y) + xf[4] * bflo(w.z) + xf[5] * bfhi(w.z) + xf[6] * bflo(w.w) + xf[7] * bfhi(w.w); }
        }
        if (n0 < PFW) {
#pragma unroll
            for (int j = 0; j < 8; ++j) PF[m * PFW + n0 + j] = acc[j];
        } else {
#pragma unroll
            for (int j = 0; j < 8; ++j) GATE[m * 2048 + (n0 - PFW) + j] = (bf16)f2bf(sigmoidf_fast(acc[j]));
        }
    }
}
__device__ __forceinline__ void p5_unit(Frame& F, int h, int tb) {
    constexpr int PITCH = 528;
    const int tid = F.tid, lane = F.lane, wid = F.wave, fr = lane & 15, fq = lane >> 4;
    LAS unsigned char* At = F.lds; LAS unsigned char* Bt = F.lds + 32 * PITCH;
    const float* SAC = WSP(float, WS_SAC); const float* SAL = WSP(float, WS_SAL); const bf16* Wuv_t = WSP(bf16, WS_WKV) + (size_t)512 * KVL;
    for (int e = tid; e < 32 * 64; e += NWAVES * 64) { const int row = e >> 6, c4 = e & 63, tok = tb * 32 + row, db = tok >> 3, r = h * 8 + (tok & 7);
        const f32x4 a = *((const GAS f32x4*)(SAC + ((size_t)(2 * db) * 64 + r) * 256) + c4), b = *((const GAS f32x4*)(SAC + ((size_t)(2 * db + 1) * 64 + r) * 256) + c4);
        const float il = 1.0f / (SAL[(2 * db) * 64 + r] + SAL[(2 * db + 1) * 64 + r]);
        v2u w; w.x = pk2((a.x + b.x) * il, (a.y + b.y) * il); w.y = pk2((a.z + b.z) * il, (a.w + b.w) * il);
        *(LAS v2u*)(At + row * PITCH + c4 * 8) = w; }
    for (int e = tid; e < 128 * 32; e += NWAVES * 64) { const int row = e >> 5, ch = e & 31;
        *(LAS v4u*)(Bt + row * PITCH + ch * 16) = *(const GAS v4u*)(Wuv_t + (size_t)(h * 128 + row) * KVL + ch * 8); }
    __syncthreads();
    f32x4 acc[2];
    acc[0] = (f32x4){0.f, 0.f, 0.f, 0.f}; acc[1] = (f32x4){0.f, 0.f, 0.f, 0.f};
    const int cbase = wid * 16;
#pragma unroll
    for (int ks = 0; ks < 8; ++ks) {
        const bf16x8 bfm = *(const LAS bf16x8*)(Bt + (cbase + fr) * PITCH + (32 * ks + 8 * fq) * 2);
#pragma unroll
        for (int rt = 0; rt < 2; ++rt) { const bf16x8 af = *(const LAS bf16x8*)(At + (rt * 16 + fr) * PITCH + (32 * ks + 8 * fq) * 2);
            acc[rt] = __builtin_amdgcn_mfma_f32_16x16x32_bf16(af, bfm, acc[rt], 0, 0, 0); }
    }
    const bf16* PG = WSP(bf16, WS_PG); const bf16* GATE = WSP(bf16, WS_GATE); bf16* AMS = WSP(bf16, WS_AMS);
    const int col = h * VHD + cbase + fr;
#pragma unroll
    for (int rt = 0; rt < 2; ++rt)
#pragma unroll
        for (int e = 0; e < 4; ++e) { const int tok = tb * 32 + rt * 16 + 4 * fq + e; const size_t m = (size_t)(MP + tok);
            const float g = bflo((unsigned)GATE[m * 2048 + DM + col]), pg = bflo((unsigned)PG[m * DM + col]);
            AMS[((size_t)(col >> 8) * MS + tok) * 256 + (col & 255)] = (bf16)f2bf(pg + g * acc[rt][e]); }
    __syncthreads();
}
__device__ __forceinline__ void p7_hn(Frame& F) {
    const int gw = F.vcu * NWAVES + F.wave, NGW = F.G * NWAVES, lane = F.lane;
    const float* H = WSP(float, WS_H); bf16* HN = WSP(bf16, WS_HN);
    f32x4 g4[4];
#pragma unroll
    for (int j = 0; j < 4; ++j) g4[j] = *((const GAS f32x4*)F.g_mlp + lane + 64 * j);
    for (int m = gw; m < MC; m += NGW) {
        const GAS f32x4* xr = (const GAS f32x4*)(H + (size_t)m * DM) + lane;
        f32x4 v[4]; float s = 0.f;
        if (m >= MP) {
            const GAS f32x4* xs = (const GAS f32x4*)(F.x_sample + (size_t)(m - MP) * DM) + lane; const float* HS = WSP(float, WS_HS);
#pragma unroll
            for (int j = 0; j < 4; ++j) { f32x4 a = xs[64 * j];
#pragma unroll
                for (int sl = 0; sl < 4; ++sl) a += *((const GAS f32x4*)(HS + ((size_t)sl * MS + (m - MP)) * DM) + lane + 64 * j);
                v[j] = a; *((GAS f32x4*)(H + (size_t)m * DM) + lane + 64 * j) = a; s += (a.x * a.x + a.y * a.y) + (a.z * a.z + a.w * a.w); }
        } else {
            const GAS v2u* hb = (const GAS v2u*)(WSP(bf16, WS_HB) + (size_t)m * DM) + lane;
#pragma unroll
            for (int j = 0; j < 4; ++j) { const v2u t = hb[64 * j]; v[j] = (f32x4){bflo(t.x), bfhi(t.x), bflo(t.y), bfhi(t.y)}; s += (v[j].x * v[j].x + v[j].y * v[j].y) + (v[j].z * v[j].z + v[j].w * v[j].w); }
        }
        const float rstd = frsqrt(wave_sum(s) * (1.f / DM) + EPS);
        GAS v2u* o8 = (GAS v2u*)(HN + (size_t)m * DM) + lane;
#pragma unroll
        for (int j = 0; j < 4; ++j) { v2u o; o.x = pk2(v[j].x * rstd * g4[j].x, v[j].y * rstd * g4[j].y); o.y = pk2(v[j].z * rstd * g4[j].z, v[j].w * rstd * g4[j].w); o8[64 * j] = o; }
    }
}

struct Args { const void* in[24]; float* out; unsigned char* ws; int ph_lo, ph_hi; };
#ifdef USE_PG8
#define GEMM_PHASE(EPI) pg8::gemm_phase<EPI, pg8::StaticOrder, PG8_ALIGN, PG8_SP2>
#define SLICE_PHASE(EPI) pg8::gemm_phase<EPI, SliceOrder, PG8_ALIGN, PG8_SP2>
#else
#define GEMM_PHASE(EPI) g2::gemm_phase<EPI, pg8::StaticOrder>
#define SLICE_PHASE(EPI) g2::gemm_phase<EPI, SliceOrder>
#endif
__device__ __forceinline__ int opaque(int v) { asm volatile("" : "+s"(v)); return v; }
__global__ void __launch_bounds__(NWAVES * 64, 2) mk_fwd(Args args) {
    extern __shared__ __attribute__((aligned(16))) unsigned char lds[];
    Frame F;
    F.lds = (LAS unsigned char*)lds;
    F.MISC = (volatile LAS unsigned*)(F.lds + MISC_OFF);
    F.tid = threadIdx.x; F.lane = F.tid & 63; F.wave = __builtin_amdgcn_readfirstlane(F.tid >> 6);
    F.G = gridDim.x; { const int bx = blockIdx.x; F.vcu = (F.G % 8 == 0) ? (bx % 8) * (F.G / 8) + bx / 8 : bx; }
    F.ws = args.ws; F.out = args.out; F.ctl = (gu32*)(args.ws + WS_CTL);
#define INP(k) ((const float*)args.in[opaque(k)])
    for (int u = F.tid; u < (LDS_BYTES - LDSCTL_OFF) / 4; u += NWAVES * 64) ((LAS unsigned*)(F.lds + LDSCTL_OFF))[u] = 0u;
    __syncthreads();
#ifdef ENTRY_FENCE
    if (F.tid == 0) { __builtin_amdgcn_fence(__ATOMIC_ACQ_REL, "agent"); asm volatile("s_waitcnt vmcnt(0)" ::: "memory"); }
    __syncthreads();
#endif
    XcdBarrier bar = xcd_barrier_post((unsigned*)(F.ctl + CW_BAR), F.MISC + 8);
    const int lo = args.ph_lo, hi = args.ph_hi;
#ifndef PHMASK
#define PHMASK 0x3ff
#endif
#define IN(k) ((((PHMASK) >> (k)) & 1) && lo <= (k) && (k) < hi)
#define SEAM(k) do { if (IN(k) && IN((k) + 1)) xcd_barrier(bar); } while (0)
#ifndef REPEAT_PHASE
#define REPEAT_PHASE -1
#endif
#define REP(k) for (int rep_ = 0; rep_ < ((REPEAT_PHASE == (k)) ? 2 : 1); ++rep_, ((REPEAT_PHASE == (k)) && rep_ == 1 ? (xcd_barrier(bar), 0) : 0))
    const int bx = (int)blockIdx.x;
#ifdef STAMP_IDX
    unsigned long long stamp_[16]; int nst_ = 0;
#define STAMP() do { stamp_[nst_ < 15 ? nst_ : 15] = __builtin_amdgcn_s_memrealtime(); ++nst_; } while (0)
    STAMP();
#else
#define STAMP() do { } while (0)
#endif

    if (IN(0)) REP(0) { F.x_prompt = INP(0); F.x_sample = INP(1); F.meta_tokens = INP(6); F.g_attn = INP(7); F.w_in = INP(8); F.w_uq = INP(10); F.w_uk = INP(14); F.w_uv = INP(17); F.w_pool_map = INP(18);
        F.w_o = INP(20); F.w_ff1 = INP(22); F.w_ff2 = INP(23); p0_prologue(F); }
    SEAM(0); STAMP();
    if (IN(1)) REP(1) {
#ifdef TOUCH_P1
        { const size_t gt = (size_t)F.vcu * NWAVES * 64 + F.tid, NGT = (size_t)F.G * NWAVES * 64; unsigned acc_ = 0;
          const GAS v4u* a_ = (const GAS v4u*)WSP(bf16, WS_XN); const GAS v4u* b_ = (const GAS v4u*)WSP(bf16, WS_WIN);
          for (size_t i = gt; i < (size_t)MC * DM / 8; i += NGT) { const v4u v = a_[i]; acc_ += v.x ^ v.y ^ v.z ^ v.w; }
          for (size_t i = gt; i < (size_t)NIN * DM / 8; i += NGT) { const v4u v = b_[i]; acc_ += v.x ^ v.y ^ v.z ^ v.w; }
          if (acc_ == 0x12345678u) F.ctl[8] = acc_; VM_WAIT(); __syncthreads(); }
#endif
#ifdef ZERO_LDS_P1
        for (int u = F.tid; u < 131072 / 16; u += NWAVES * 64) ((LAS v4u*)F.lds)[u] = (v4u){0u, 0u, 0u, 0u};
        __syncthreads();
#endif
#ifdef DELAY_P1
        { const unsigned long long t0 = __builtin_amdgcn_s_memrealtime(); while (__builtin_amdgcn_s_memrealtime() - t0 < 3000000ull) __builtin_amdgcn_s_sleep(8); }
#endif
#ifdef NAIVE_P1
        p1_naive(F);
#else
#ifdef P1_SHAPE_TEST
        pg8::Gemm g{WSP(bf16, WS_XN), WSP(bf16, WS_WIN), MP, 3072, DM}; pg8::StaticOrder S; S.init(MP, 3072, F.G, bx);
#else
        pg8::Gemm g{WSP(bf16, WS_XN), WSP(bf16, WS_WIN), MCX, NIN, DM}; pg8::StaticOrder S; S.init(MCX, NIN, F.G, bx);
#endif
#ifdef SCALAR_EPI
        EpiInProjScalar E{WSP(float, WS_PF), WSP(bf16, WS_GATE)};
        GEMM_PHASE(EpiInProjScalar)(F.lds + RING_OFF, g, S, E);
#else
        EpiInProj E{WSP(float, WS_PF), WSP(bf16, WS_GATE), WSP(bf16, WS_PB)};
        GEMM_PHASE(EpiInProj)(F.lds + RING_OFF, g, S, E);
#endif
#ifdef TWICE_P1
        __syncthreads();
        GEMM_PHASE(EpiInProj)(F.lds + RING_OFF, g, S, E);
#endif
#ifdef TWICE_DUMMY
        __syncthreads();
        { EpiInProj E2{WSP(float, WS_Z), WSP(bf16, WS_H), WSP(bf16, WS_HN)}; GEMM_PHASE(EpiInProj)(F.lds + RING_OFF, g, S, E2); }
#endif
#endif
    }
    SEAM(1); STAMP();
    if (IN(2)) REP(2) { F.g_kv_lat = INP(11); F.g_q_lat = INP(9); F.g_kn_rope = INP(16); F.state_pool = INP(4); p2_rows(F); p2_pool(F); }
    SEAM(2); STAMP();
    if (IN(3)) REP(3)
#ifdef REPEAT_P3
    for (int r3_ = 0, n3_ = opaque(2); r3_ < n3_; ++r3_, (r3_ < n3_ ? (xcd_barrier(bar), 0) : 0))
#endif
    {
        F.w_uk = INP(14); F.w_uv = INP(17); F.g_kn_nope = INP(15); F.pool_scale = INP(19);
#ifndef NO_P3M
#ifdef REPEAT_P3M
        for (int rm_ = 0, nm_ = opaque(2); rm_ < nm_; ++rm_)
#endif
        p3_meta_kv(F);
#endif
#ifdef REPEAT_P3Q
        for (int rq_ = 0, nq_ = opaque(2); rq_ < nq_; ++rq_)
#endif
#ifndef NO_P3Q
        { pg8::Gemm g{WSP(bf16, WS_QL), WSP(bf16, WS_WUQ), MC, 768, opaque(QLORA)}; pg8::StaticOrder S; S.init(MC, 768, F.G, bx);
          EpiPlainBf16 E{WSP(bf16, WS_QR), 768};
          GEMM_PHASE(EpiPlainBf16)(F.lds + RING_OFF, g, S, E); }
        __syncthreads();
#endif
#ifdef STAMP_P3
        STAMP();
#endif
#ifdef REPEAT_P3K
        for (int rk_ = 0, nk_ = opaque(2); rk_ < nk_; ++rk_)
#endif
#ifndef NO_P3K
        { pg8::Gemm g{WSP(bf16, WS_CB), WSP(bf16, WS_WKV), MP, 1536, opaque(KVL)}; pg8::StaticOrder S; S.init(MP, 1536, F.G, bx);
          EpiKV E{WSP(bf16, WS_KH), WSP(bf16, WS_VH), WSP(bf16, WS_KRG), WSP(float, WS_KSS), F.g_kn_nope};
          GEMM_PHASE(EpiKV)(F.lds + RING_OFF, g, S, E); }
        __syncthreads();
#endif
#ifdef STAMP_P3
        STAMP();
#endif
#ifdef REPEAT_P3P
        for (int rp_ = 0, np_ = opaque(2); rp_ < np_; ++rp_)
#endif
#ifndef NO_P3P
        { pg8::Gemm g{WSP(bf16, WS_DP), WSP(bf16, WS_WPL), 4 * MC, DM, opaque(128)}; PoolOrder S{F.G, (F.G == 256) ? ((F.vcu + 116) & 255) : F.vcu};
          EpiPool E{WSP(bf16, WS_PG), WSP(bf16, WS_GATE), F.pool_scale};
          pg8::gemm_phase<EpiPool, PoolOrder, PG8_ALIGN, PG8_SP2>(F.lds + RING_OFF, g, S, E); }
#endif
    }
    SEAM(3); STAMP();
    if (IN(4)) REP(4) {
        F.g_qn_nope = INP(12); F.g_qn_rope = INP(13); F.g_kn_nope = INP(15); F.g_kn_rope = INP(16);
        const float gq = fmaxf(wave_max(fabsf(F.g_qn_nope[F.lane])), wave_max(fabsf(F.g_qn_rope[F.lane & 15])));
        const float gk = fmaxf(wave_max(fabsf(F.g_kn_nope[F.lane])), wave_max(fabsf(F.g_kn_rope[F.lane & 15])));
        const float b2 = (float)QKH * SCALE_L2E * gq * gk;
#ifndef NO_PA
        {
            pa::Ctx C{WSP(bf16, WS_QR), WSP(bf16, WS_KH), WSP(bf16, WS_VH), WSP(bf16, WS_PG), WSP(bf16, WS_GATE), WSP(bf16, WS_AM), WSP(float, WS_ROPE), F.g_qn_nope, F.g_qn_rope, b2};
#ifdef REPEAT_PA
            for (int rpa_ = 0, npa_ = opaque(2); rpa_ < npa_; ++rpa_)
#endif
            for (int pr0 = F.vcu * 2; pr0 < 512; pr0 += 2 * F.G) {
#pragma unroll 1
                for (int k = 0; k < 4; ++k) {
                    const int pr = pr0 + (k >> 1); const int bh = pr >> 2, p = pr & 3, j = (k & 1) ? 7 - p : p;
                    pa::unit(C, bh >> 3, bh & 7, j, (char*)lds, F.lds);
                }
            }
        }
#endif
        STAMP();
#ifndef NO_SA
        {
            sa::Ctx C{INP(2), INP(3), (const int*)INP(5), F.out + O_CS, F.out + O_KRS, WSP(bf16, WS_QR), WSP(bf16, WS_WUK), WSP(float, WS_ROPE), F.g_qn_nope, F.g_qn_rope, F.g_kn_nope, F.g_kn_rope,
                      WSP(float, WS_SAC), WSP(float, WS_SAL), b2};
#ifdef REPEAT_SA
            for (int rsa_ = 0, nsa_ = opaque(2); rsa_ < nsa_; ++rsa_)
#endif
            for (int it = F.vcu; it < 256; it += F.G) sa::item(C, it >> 1, it & 1, F.lds);
        }
#endif
    }
    SEAM(4); STAMP();
    if (IN(5)) REP(5) {
        for (int u = F.vcu; u < 256; u += F.G) p5_unit(F, u >> 5, u & 31);
        F.w_o = INP(20); F.w_ff1 = INP(22); F.w_ff2 = INP(23); p0_weights(F, 0, P0_LATE_ITEMS, F.vcu * NWAVES + F.wave, F.G * NWAVES);
    }
    SEAM(5); STAMP();
    if (IN(6)) REP(6) {
        { pg8::Gemm g{WSP(bf16, WS_AM), WSP(bf16, WS_WO), MP, DM, opaque(DM)}; pg8::StaticOrder S; S.init(MP, DM, F.G, bx);
          EpiResToBf16 E{WSP(bf16, WS_HB), INP(0)};
          GEMM_PHASE(EpiResToBf16)(F.lds + RING_OFF, g, S, E); }
        __syncthreads();
        { pg8::Gemm g{WSP(bf16, WS_AMS), WSP(bf16, WS_WOS), 4 * MS, 4 * DM, opaque(256)}; SliceOrder S{4, F.G, F.vcu};
          EpiSlab E{WSP(float, WS_HS)};
          SLICE_PHASE(EpiSlab)(F.lds + RING_OFF, g, S, E); }
    }
    SEAM(6); STAMP();
    if (IN(7)) REP(7) { F.g_mlp = INP(21); F.x_sample = INP(1); p7_hn(F); }
    SEAM(7); STAMP();
    if (IN(8)) REP(8) {
        pg8::Gemm g{WSP(bf16, WS_HN), WSP(bf16, WS_W1), MC, DFF, opaque(DM)}; pg8::StaticOrder S; S.init(MC, DFF, F.G, bx);
        EpiRelu2 E{WSP(bf16, WS_Z), WSP(bf16, WS_ZS)};
#ifdef CLKP8
        const unsigned long long ck0_ = __builtin_amdgcn_s_memtime(), rt0_ = __builtin_amdgcn_s_memrealtime();
#endif
        GEMM_PHASE(EpiRelu2)(F.lds + RING_OFF, g, S, E);
#ifdef CLKP8
        { const unsigned long long ck1_ = __builtin_amdgcn_s_memtime(), rt1_ = __builtin_amdgcn_s_memrealtime();
          if (F.tid == 0) WSP(float, WS_CTL + 524288)[blockIdx.x] = (CLKP8 == 1) ? (float)(ck1_ - ck0_) / (float)(rt1_ - rt0_) * 3.f : (float)(rt1_ - rt0_) * 0.002f; }
#endif
    }
    SEAM(8); STAMP();
    if (IN(9)) REP(9) {
#ifdef REPEAT_P9M
        for (int r9_ = 0, n9_ = opaque(2); r9_ < n9_; ++r9_, __syncthreads())
#endif
        { pg8::Gemm g{WSP(bf16, WS_Z), WSP(bf16, WS_W2), MP, DM, opaque(DFF)}; pg8::StaticOrder S; S.init(MP, DM, F.G, bx);
          EpiResFromBf16 E{F.out + O_YP, WSP(bf16, WS_HB)};
          GEMM_PHASE(EpiResFromBf16)(F.lds + RING_OFF, g, S, E); }
        __syncthreads();
#ifdef REPEAT_P9T
        for (int r9_ = 0, n9_ = opaque(2); r9_ < n9_; ++r9_, __syncthreads())
#endif
        { pg8::Gemm g{WSP(bf16, WS_ZS), WSP(bf16, WS_W2S), 8 * MS, 8 * DM, opaque(512)}; SliceOrder S{8, F.G, F.vcu};
          EpiSlab E{WSP(float, WS_YS)};
          SLICE_PHASE(EpiSlab)(F.lds + RING_OFF, g, S, E); }
        xcd_barrier(bar);
        {
            const float* H = WSP(float, WS_H); const float* YS = WSP(float, WS_YS);
            for (size_t e = (size_t)F.vcu * NWAVES * 64 + F.tid; e < (size_t)MS * DM / 4; e += (size_t)F.G * NWAVES * 64) {
                f32x4 a = *((const GAS f32x4*)(H + (size_t)MP * DM) + e);
#pragma unroll
                for (int sl = 0; sl < 8; ++sl) a += *((const GAS f32x4*)(YS + (size_t)sl * MS * DM) + e);
                *((GAS f32x4*)(F.out + O_YS) + e) = a; }
        }
    }
#if defined(CLKPROBE) || defined(SEGPROBE) || defined(CLKP8)
#ifndef CLKPROBE
#define CLKPROBE 0
#endif
    if (IN(9)) { xcd_barrier(bar); if (blockIdx.x == 0 && F.tid == 0) F.out[0] = WSP(float, WS_CTL + 524288)[CLKPROBE]; }
#endif
#ifdef ENTRY_FENCE
    asm volatile("s_waitcnt vmcnt(0)" ::: "memory"); __syncthreads();
    if (F.tid == 0) { __builtin_amdgcn_fence(__ATOMIC_RELEASE, "agent"); asm volatile("s_waitcnt vmcnt(0)" ::: "memory"); }
    __syncthreads();
#endif
#ifdef TAG_SMALL
    if (IN(9)) {
        xcd_barrier(bar);
        const size_t gt = (size_t)F.vcu * NWAVES * 64 + F.tid, NGT = (size_t)F.G * NWAVES * 64;
        for (size_t i = O_CP + gt; i < O_END; i += NGT) F.out[i] *= (float)(TAG_SMALL);
    }
#endif
#ifdef CHECK_C
    if (IN(9)) {
        xcd_barrier(bar);
        if (blockIdx.x == 0) {
            const float* xp = INP(0); const float* mt = INP(6); const float* ga = INP(7); const float* win = INP(8); const float* gk = INP(11);
            LAS float* res = (LAS float*)F.lds;
            if (F.wave < 4) {
                const int b = (F.wave == 0) ? 2 : (F.wave == 1 ? 1 : (F.wave == 2 ? 15 : 0));
                const int t = (F.wave == 0) ? 3 : (F.wave == 1 ? 116 : (F.wave == 2 ? 2063 : 16));
                const float* xr = t < 16 ? mt + (size_t)t * DM : xp + ((size_t)b * SEQ + (t - 16)) * DM;
                float ss = 0.f; for (int k = F.lane; k < DM; k += 64) ss += xr[k] * xr[k];
                const float rs = frsqrt(wave_sum(ss) / DM + EPS);
                float c[4] = {0.f, 0.f, 0.f, 0.f};
                for (int k = 0; k < DM; ++k) { const float xn = xr[k] * rs * ga[k];
                    for (int j = 0; j < 4; ++j) c[j] += xn * win[(size_t)k * DIN + 896 + F.lane * 4 + j]; }
                float s2 = c[0] * c[0] + c[1] * c[1] + c[2] * c[2] + c[3] * c[3];
                const float r2 = frsqrt(wave_sum(s2) / KVL + EPS);
                float err = 0.f, refn = 0.f;
                for (int j = 0; j < 4; ++j) { const float ref = c[j] * r2 * gk[F.lane * 4 + j]; const float got = F.out[O_CP + ((size_t)b * TT + t) * KVL + F.lane * 4 + j]; err += (got - ref) * (got - ref); refn += ref * ref; }
                err = wave_sum(err); refn = wave_sum(refn);
                if (F.lane == 0) res[F.wave] = (err > 0.0004f * refn) ? 1.f : 0.f;
            }
            __syncthreads();
            if (F.tid == 0) F.out[O_YP] = 1000.f * (1.f + res[0] + 2.f * res[1] + 4.f * res[2] + 8.f * res[3]);
        }
    }
#endif
#ifdef CHECK_PFM
    if (IN(9)) {
        xcd_barrier(bar);
        if (blockIdx.x == 0) {
            const float* mt = INP(6); const float* ga = INP(7); const float* win = INP(8);
            LAS float* res = (LAS float*)F.lds;
            if (F.wave < 4) {
                const int n = (F.wave == 0) ? 5 : (F.wave == 1 ? 300 : (F.wave == 2 ? 1160 : 200));
                const int col = n < 256 ? 896 + n : (n < 768 ? n - 256 : n);
                const float* xr = mt + (size_t)3 * DM;
                float ss = 0.f; for (int k = F.lane; k < DM; k += 64) ss += xr[k] * xr[k];
                const float rs = frsqrt(wave_sum(ss) / DM + EPS);
                float a = 0.f; for (int k = F.lane; k < DM; k += 64) a += xr[k] * rs * ga[k] * win[(size_t)k * DIN + col];
                a = wave_sum(a);
#if CHECK_PFM == 2
                { const bf16* XNM_ = WSP(bf16, WS_XNM); const bf16* W_ = WSP(bf16, WS_WIN); float a2 = 0.f;
                  for (int k = F.lane; k < DM; k += 64) a2 += bflo((unsigned)XNM_[3 * DM + k]) * bflo((unsigned)W_[(size_t)n * DM + k]);
                  a = wave_sum(a2); }
#elif CHECK_PFM == 3
                { const bf16* XNM_ = WSP(bf16, WS_XNM); float a2 = 0.f;
                  for (int k = F.lane; k < DM; k += 64) a2 += fabsf(bflo((unsigned)XNM_[3 * DM + k]) - xr[k] * rs * ga[k]);
                  a = wave_sum(a2); }
#endif
                const float got = (CHECK_PFM == 3) ? 0.f : WSP(float, WS_PFM)[3 * PFW + n];
                if (F.lane == 0) res[F.wave] = (fabsf(got - a) > 0.03f * fabsf(a) + 0.02f) ? 1.f : 0.f;
            }
            __syncthreads();
            if (F.tid == 0) F.out[O_YP] = 1000.f * (1.f + res[0] + 2.f * res[1] + 4.f * res[2] + 8.f * res[3]);
        }
    }
#endif
#ifdef CHECK_S
    if (IN(9)) {
        xcd_barrier(bar);
        if (blockIdx.x == 0) {
            const float* xp = INP(0); const float* xs = INP(1); const float* sp = INP(4); const float* mt = INP(6); const float* ga = INP(7); const float* win = INP(8); const float* gk = INP(11);
            LAS float* res = (LAS float*)F.lds;
            if (F.wave < 4) {
                const int w = F.wave + 4 * (CHECK_S - 1);
                const int kind = (w == 2 || w == 3 || w == 6 || w == 5) ? 1 : 0;
                const int b = (w == 0) ? 2 : (w == 1 ? 1 : (w == 2 ? 5 : (w == 3 ? 5 : (w == 4 ? 3 : (w == 5 ? 9 : (w == 6 ? 9 : 0))))));
                const int t = (w == 0) ? 3 : (w == 1 ? 116 : (w == 2 ? 3 : (w == 3 ? 3 : (w == 4 ? 2056 : (w == 5 ? 0 : (w == 6 ? 3 : 0))))));
                const float* xr = kind ? xs + ((size_t)b * DSEQ + t) * DM : (t < 16 ? mt + (size_t)t * DM : xp + ((size_t)b * SEQ + (t - 16)) * DM);
                const int pos = kind ? PAST + t : t;
                float ss = 0.f; for (int k = F.lane; k < DM; k += 64) ss += xr[k] * xr[k];
                const float rs = frsqrt(wave_sum(ss) / DM + EPS);
                float err = 0.f, refn = 0.f;
                if (w <= 2) {
                    float a1 = 0.f, a2 = 0.f; const int i = F.lane & 15;
                    for (int k = 0; k < DM; ++k) { const float xn = xr[k] * rs * ga[k]; a1 += xn * win[(size_t)k * DIN + 1152 + i]; a2 += xn * win[(size_t)k * DIN + 1168 + i]; }
                    const double ang = (double)pos * ROPE_INV[i]; const float cs = (float)cos(ang), sn = (float)sin(ang);
                    const float o1 = a1 * cs - a2 * sn, o2 = a2 * cs + a1 * sn;
                    const float* gp = kind ? F.out + O_KRS + ((size_t)b * DSEQ + t) * QKR : F.out + O_KRP + ((size_t)b * TT + t) * QKR;
                    if (F.lane < 16) { err = (gp[i] - o1) * (gp[i] - o1) + (gp[16 + i] - o2) * (gp[16 + i] - o2); refn = o1 * o1 + o2 * o2; }
                } else if (w == 3 || w == 5) {
                    float c[4] = {0.f, 0.f, 0.f, 0.f};
                    for (int k = 0; k < DM; ++k) { const float xn = xr[k] * rs * ga[k]; for (int j = 0; j < 4; ++j) c[j] += xn * win[(size_t)k * DIN + 896 + F.lane * 4 + j]; }
                    const float r2 = frsqrt(wave_sum(c[0] * c[0] + c[1] * c[1] + c[2] * c[2] + c[3] * c[3]) / KVL + EPS);
                    for (int j = 0; j < 4; ++j) { const float ref = c[j] * r2 * gk[F.lane * 4 + j]; const float got = F.out[O_CS + ((size_t)b * DSEQ + t) * KVL + F.lane * 4 + j]; err += (got - ref) * (got - ref); refn += ref * ref; }
                } else if (w == 4 || w == 6) {
                    float u[8] = {0.f, 0.f, 0.f, 0.f, 0.f, 0.f, 0.f, 0.f};
                    for (int k = 0; k < DM; ++k) { const float xn = xr[k] * rs * ga[k]; for (int j = 0; j < 8; ++j) u[j] += xn * win[(size_t)k * DIN + F.lane * 8 + j]; }
                    const float* gp = (w == 4) ? F.out + O_PSP + ((size_t)b * 15 + (t - 2049)) * PW : F.out + O_PSS + ((size_t)b * 15 + 7 + t) * PW;
                    for (int j = 0; j < 8; ++j) { const float got = gp[F.lane * 8 + j]; err += (got - u[j]) * (got - u[j]); refn += u[j] * u[j]; }
                } else if (w == 55) {
                    for (int j = 0; j < 8; ++j) { const float ref = sp[((size_t)b * 15 + 8 + 2) * PW + F.lane * 8 + j]; const float got = F.out[O_PSS + ((size_t)b * 15 + 2) * PW + F.lane * 8 + j]; err += (got - ref) * (got - ref); refn += ref * ref; }
                } else if (w == 7) {
                    const bf16* W_ = WSP(bf16, WS_WIN);
                    for (int j = 0; j < 8; ++j) { const int n = F.lane * 8 + j;
                        for (int k = 0; k < DM; ++k) { const float ref = win[(size_t)k * DIN + n], got = bflo((unsigned)W_[(size_t)(256 + n) * DM + k]); err += (got - ref) * (got - ref); refn += ref * ref; } }
                } else { err = 0.f; refn = 1.f; }
                err = wave_sum(err); refn = wave_sum(refn);
#ifdef CHECK_MAG
                if (F.lane == 0) res[F.wave] = floorf(200.f * sqrtf(err / refn) + 0.5f);
            }
            __syncthreads();
            if (F.tid == 0) F.out[O_YP] = 1000.f * (1.f + res[CHECK_MAG]);
#else
                if (F.lane == 0) res[F.wave] = (err > 0.0004f * refn) ? 1.f : 0.f;
            }
            __syncthreads();
            if (F.tid == 0) F.out[O_YP] = 1000.f * (1.f + res[0] + 2.f * res[1] + 4.f * res[2] + 8.f * res[3]);
#endif
        }
    }
#endif
#ifdef ZERO_META_C
    if (IN(9)) {
        xcd_barrier(bar);
        const size_t gt = (size_t)F.vcu * NWAVES * 64 + F.tid, NGT = (size_t)F.G * NWAVES * 64;
        for (size_t i = gt; i < (size_t)NBATCH * NMETA * KVL; i += NGT) { const size_t b = i / (NMETA * KVL), r = i % (NMETA * KVL); F.out[O_CP + b * TT * KVL + r] = 0.f; }
    }
#endif
#ifdef TAG_Y
    if (IN(9)) {
        xcd_barrier(bar);
        const size_t gt = (size_t)F.vcu * NWAVES * 64 + F.tid, NGT = (size_t)F.G * NWAVES * 64;
        for (size_t i = TAG_Y_LO + gt; i < TAG_Y_HI; i += NGT) F.out[i] *= 1.3f;
    }
#endif
#if defined(DUMP) && DUMP == 99
    if (lo <= 10 && 10 < hi) {
        unsigned e1 = 0, e2 = 0, e3 = 0;
        LAS unsigned* L = (LAS unsigned*)F.lds;
        for (int r = 0; r < 200; ++r) {
            const int slot = (F.tid * 33 + r * 4099) & 32767;
            L[F.tid + 512 * (r & 63)] = (unsigned)(F.tid * 2654435761u + r);
            __syncthreads();
            const int o = (F.tid + 257) & 511;
            if (L[o + 512 * (r & 63)] != (unsigned)(o * 2654435761u + r)) ++e1;
            __syncthreads();
            (void)slot;
        }
        {
            const int fr = F.lane & 15, fq = F.lane >> 4;
            pg8::bf16x8 a, b;
            for (int j = 0; j < 8; ++j) { const int k = 8 * fq + j; a[j] = (short)f2bf((float)((fr + k) % 5 - 2)); b[j] = (short)f2bf((float)((k * 3 + fr) % 7 - 3)); }
            pg8::f32x4 d = (pg8::f32x4){0.f, 0.f, 0.f, 0.f};
            for (int rep = 0; rep < 64; ++rep) d = __builtin_amdgcn_mfma_f32_16x16x32_bf16(a, b, d, 0, 0, 0);
            for (int e = 0; e < 4; ++e) { const int i = 4 * fq + e, jj = fr; float s = 0.f; for (int k = 0; k < 32; ++k) s += (float)((i + k) % 5 - 2) * (float)((k * 3 + jj) % 7 - 3);
                if (d[e] != 64.f * s) ++e2; }
        }
        if (blockDim.x != 512 || gridDim.x != 256 || blockDim.y != 1 || gridDim.y != 1) e3 = 1;
        unsigned e4 = 0, e5 = 0, e6 = 0;
        { const float v = (float)(F.lane + 1); if (wave_sum(v) != 2080.f) e4 = 1;
          const int row = F.lane >> 4; const float want16 = (float)(16 * (16 * row) + 136);
          if (sum_row16(v) != want16) e5 = 1;
          if (wave_max(v) != 64.f) e6 = 1; }
        const float code = (e1 ? 1000.f : 0.f) + (e2 ? 2000.f : 0.f) + (e3 ? 4000.f : 0.f) + (e4 ? 8000.f : 0.f) + (e5 ? 16000.f : 0.f) + (e6 ? 32000.f : 0.f) + 500.f;
#ifdef PROBE_VAL
        { const float v = (float)(F.lane + 1); float r_ = 0.f;
          if (PROBE_VAL == 1) r_ = wave_sum(v); else if (PROBE_VAL == 2) r_ = sum_x16(v); else if (PROBE_VAL == 3) r_ = sum_x32(v); else if (PROBE_VAL == 4) r_ = sum_x16(sum_row16(v)); else if (PROBE_VAL == 5) r_ = sum_x32(sum_row16(v));
          const int pl = PROBE_LANE;
          const float got = __shfl(r_, pl);
          for (int i = F.tid; i < 4096; i += 512) F.out[O_YP + (size_t)blockIdx.x * 4096 + i] = 10.f * got; }
#else
        for (int i = F.tid; i < 4096; i += 512) F.out[O_YP + (size_t)blockIdx.x * 4096 + i] = code;
#endif
    }
#elif defined(DUMP)
    if (lo <= 10 && 10 < hi) {
        const size_t gt = (size_t)F.vcu * NWAVES * 64 + F.tid, NGT = (size_t)F.G * NWAVES * 64;
        for (size_t i = gt; i < (size_t)MP * DM; i += NGT) {
            float v = 0.f;
#if DUMP == 1
            v = WSP(float, WS_PF)[i % ((size_t)MC * PFW)] + bflo((unsigned)WSP(bf16, WS_GATE)[i]) + bflo((unsigned)WSP(bf16, WS_GATE)[i + (size_t)MP * DM]);
#elif DUMP == 99
            v = 0.f;
#elif DUMP == 7
            v = bflo((unsigned)WSP(bf16, WS_XN)[i]) + bflo((unsigned)WSP(bf16, WS_WIN)[i % ((size_t)NIN * DM)]) + bflo((unsigned)WSP(bf16, WS_W1)[i % ((size_t)DFF * DM)]) + bflo((unsigned)WSP(bf16, WS_W2)[i % ((size_t)DFF * DM)])
              + bflo((unsigned)WSP(bf16, WS_WO)[i % ((size_t)DM * DM)]) + bflo((unsigned)WSP(bf16, WS_WKV)[i % ((size_t)1536 * 256)]) + bflo((unsigned)WSP(bf16, WS_WUK)[i % ((size_t)512 * 256)])
              + bflo((unsigned)WSP(bf16, WS_WPL)[i % ((size_t)1024 * 512)]) + bflo((unsigned)WSP(bf16, WS_WUQ)[i % ((size_t)768 * 384)]) + WSP(float, WS_ROPE)[i % (size_t)(2072 * 32)] + bflo((unsigned)WSP(bf16, WS_XNM)[i % (size_t)(16 * 1024)]);
#elif DUMP == 2
            v = bflo((unsigned)WSP(bf16, WS_CB)[i % ((size_t)MC * 256)]) + bflo((unsigned)WSP(bf16, WS_QL)[i % ((size_t)MC * 384)]) + bflo((unsigned)WSP(bf16, WS_DP)[i % ((size_t)MC * 512)])
              + bflo((unsigned)WSP(bf16, WS_KRG)[i % ((size_t)RB * 32)]) + WSP(float, WS_KSS)[i % (size_t)RB];
#elif DUMP == 3
            v = bflo((unsigned)WSP(bf16, WS_QR)[i % ((size_t)MC * 768)]) + bflo((unsigned)WSP(bf16, WS_KH)[i % ((size_t)RB * 768)]) + bflo((unsigned)WSP(bf16, WS_VH)[i % ((size_t)RB * 1024)]) + bflo((unsigned)WSP(bf16, WS_PG)[i]);
#elif DUMP == 4
            v = bflo((unsigned)WSP(bf16, WS_AM)[i]) + WSP(float, WS_SAC)[i % ((size_t)256 * 64 * 256)] + WSP(float, WS_SAL)[i % (size_t)(256 * 64)];
#elif DUMP == 5
            v = bflo((unsigned)WSP(bf16, WS_AM)[i + (size_t)MS * DM]);
#elif DUMP == 6
            v = WSP(float, WS_H)[i + (size_t)MS * DM];
#endif
            F.out[O_YP + i] = v;
        }
    }
#endif
#ifdef STAMP_IDX
    STAMP();
    if (blockIdx.x == 0 && F.tid == 0) { const unsigned long long d_ = stamp_[STAMP_IDX + 1] - stamp_[STAMP_IDX]; F.out[O_YP] = (float)d_ * 0.001f;     }
#endif
#undef IN
#undef SEAM
}

#ifndef MK_N_LAUNCHES
#define MK_N_LAUNCHES 1
#endif
extern "C" void kernel_launch(void* const* d_in, const int* in_sizes, int n_in, void* d_out, int out_size, void* d_ws, size_t ws_size, hipStream_t stream) {
    static int grid = 0;
    if (grid == 0) {
        if (n_in != 24 || out_size != (int)O_END || ws_size < WS_END) { fprintf(stderr, "kernel_launch: unexpected shapes (n_in %d out %d ws %zu need %zu); nothing launched\n", n_in, out_size, ws_size, (size_t)WS_END); grid = -1; return; }
        int dev = 0, cus = 0, per_cu = 0;
        if (hipGetDevice(&dev) != hipSuccess || hipDeviceGetAttribute(&cus, hipDeviceAttributeMultiprocessorCount, dev) != hipSuccess) { grid = -1; return; }
        if (hipFuncSetAttribute((const void*)mk_fwd, hipFuncAttributeMaxDynamicSharedMemorySize, LDS_BYTES) != hipSuccess) { fprintf(stderr, "kernel_launch: hipFuncSetAttribute failed\n"); grid = -1; return; }
        if (hipOccupancyMaxActiveBlocksPerMultiprocessor(&per_cu, (const void*)mk_fwd, NWAVES * 64, LDS_BYTES) != hipSuccess || per_cu < 1) { fprintf(stderr, "kernel_launch: occupancy query says %d blocks per CU\n", per_cu); }
        (void)hipGetLastError();
        grid = cus;
    }
    if (grid < 0) return;
    if (hipMemsetAsync((char*)d_ws + WS_CTL, 0, 32768, stream) != hipSuccess) return;
    Args a{};
    for (int i = 0; i < 24; ++i) a.in[i] = d_in[i];
    a.out = (float*)d_out; a.ws = (unsigned char*)d_ws;
#if MK_N_LAUNCHES == 1
#ifdef DUMP
    a.ph_lo = 0; a.ph_hi = 11;
#else
    a.ph_lo = 0; a.ph_hi = 10;
#endif
    hipLaunchKernelGGL(mk_fwd, dim3(grid), dim3(NWAVES * 64), LDS_BYTES, stream, a);
#else
#ifdef DUMP
    constexpr int NPH = 11;
#else
    constexpr int NPH = 10;
#endif
    for (int p = 0; p < NPH; ++p) { a.ph_lo = p; a.ph_hi = p + 1; hipLaunchKernelGGL(mk_fwd, dim3(grid), dim3(NWAVES * 64), LDS_BYTES, stream, a); }
#endif
}
```

```cpp
#include <hip/hip_runtime.h>
#include <cstdio>
#include <cstdint>
#define USE_PG8 1
namespace pg8 {
#define PG8_LAS __attribute__((address_space(3)))
typedef unsigned short bf16_t;
typedef short bf16x8 __attribute__((ext_vector_type(8)));
typedef float f32x4 __attribute__((ext_vector_type(4)));
typedef unsigned u32x4 __attribute__((ext_vector_type(4)));
constexpr int BM = 256, BK = 64, HALF = 128, HTB = HALF * BK * 2  , STAGE_BYTES = 8 * HTB, NXCD = 8, WGM = 8;

__host__ __device__ __forceinline__ int lds_byte(int r, int c) { const int st = (r >> 4) * 2 + (c >> 5), rr = r & 15, cc = c & 31, ob = rr * 64 + cc * 2; return st * 1024 + (ob ^ (((ob >> 9) & 1) << 5)); }
__host__ __device__ __forceinline__ void stage_rc(int b, int& R, int& C) { const int st = b / 1024, sb = b % 1024, swz = sb ^ (((sb >> 9) & 1) << 5); R = (st >> 1) * 16 + swz / 64; C = (st & 1) * 32 + (swz % 64) / 2; }
__host__ __device__ __forceinline__ int perm32(int rho) { const int n = rho >> 4, i = rho & 15; return 8 * (i >> 2) + 4 * n + (i & 3); }

struct Unit { int pm, pn; };
struct Gemm { const bf16_t* A; const bf16_t* Bt; int M, N, K; };

struct StaticOrder {
    int nM, nN, nwg, G, c;
    __host__ __device__ void init(int M, int N, int G_, int c_) { nM = M / BM; nN = N / BM; nwg = nM * nN; G = G_; c = c_; }
    __host__ __device__ bool next(int i, Unit& u) const {
        const long L = (long)i * G + c; if (L >= nwg) return false;
        int wgid = (int)L; { const int q = nwg / NXCD, r = nwg % NXCD, xcd = wgid % NXCD, off = wgid / NXCD; wgid = (xcd < r ? xcd * (q + 1) : r * (q + 1) + (xcd - r) * q) + off; }
        const int nig = WGM * nN, gid = wgid / nig, fm = gid * WGM, gsz = (nM - fm) < WGM ? (nM - fm) : WGM;
        u.pm = fm + ((wgid % nig) % gsz); u.pn = (wgid % nig) / gsz; return true;
    }
    __device__ __forceinline__ void a_ready(const Unit&) const {}
    __device__ __forceinline__ void done(const Unit&) const {}
};

template <class Epi, class Sched, bool ALIGN_EPI = false, bool SP2 = false>
__device__ __forceinline__ void gemm_phase(PG8_LAS unsigned char* lds, const Gemm g, const Sched& S, const Epi& E) {
    const int tid = threadIdx.x, wid = __builtin_amdgcn_readfirstlane(tid >> 6), lane = tid & 63, wr = wid >> 2, wc = wid & 3, fr = lane & 15, fq = lane >> 4;
    const int K = g.K, nt = K / BK;
    unsigned voffA[2], voffB[2];
#pragma unroll
    for (int i = 0; i < 2; ++i) { int R, C; stage_rc(tid * 16 + i * 8192, R, C); const int Rb = Epi::PERM ? ((R & ~31) + perm32(R & 31)) : R;
        voffA[i] = (unsigned)(R * K + C) * 2u; voffB[i] = (unsigned)(Rb * K + C) * 2u; }
    const size_t kstep = (size_t)(BK * 2);
    const size_t hstep = (size_t)HALF * K * 2;
    const size_t tstep = 2 * hstep;
    const unsigned ldsw = (unsigned)wid * 1024u;
    const int aoff = lds_byte(wr * 64 + fr, fq * 8), boff = lds_byte(wc * 32 + fr, fq * 8);
#define PG8_SA(b, h) (((b) * 2 + (h)) * HTB)
#define PG8_SB(b, h) ((4 + (b) * 2 + (h)) * HTB)
#define PG8_STAGE(bufoff, gbase, voff) do { _Pragma("unroll") for (int _i = 0; _i < 2; ++_i) \
        __builtin_amdgcn_global_load_lds((const unsigned*)((const char*)(gbase) + (voff)[_i]), (PG8_LAS unsigned*)(lds + (bufoff) + ldsw + _i * 8192), 16, 0, 0); } while (0)
#define PG8_LDA(dst, b, h) do { _Pragma("unroll") for (int m = 0; m < 4; ++m) _Pragma("unroll") for (int k = 0; k < 2; ++k) dst[m][k] = *(const PG8_LAS bf16x8*)(lds + PG8_SA(b, h) + aoff + m * 2048 + k * 1024); } while (0)
#define PG8_LDB(dst, b, h) do { _Pragma("unroll") for (int n = 0; n < 2; ++n) _Pragma("unroll") for (int k = 0; k < 2; ++k) dst[n][k] = *(const PG8_LAS bf16x8*)(lds + PG8_SB(b, h) + boff + n * 2048 + k * 1024); } while (0)
#define PG8_MMA(ai, bj, At, Bt) do { __builtin_amdgcn_s_setprio(1); _Pragma("unroll") for (int m = 0; m < 4; ++m) _Pragma("unroll") for (int n = 0; n < 2; ++n) _Pragma("unroll") for (int k = 0; k < 2; ++k) \
        acc[ai][bj][m][n] = __builtin_amdgcn_mfma_f32_16x16x32_bf16(Bt[n][k], At[m][k], acc[ai][bj][m][n], 0, 0, 0); __builtin_amdgcn_s_setprio(0); } while (0)
#ifdef SAFE_WAITS
#define PG8_WAIT_V(n) asm volatile("s_waitcnt vmcnt(0)" ::: "memory")
#else
#define PG8_WAIT_V(n) asm volatile("s_waitcnt vmcnt(" #n ")" ::: "memory")
#endif
#define PG8_WAIT_L(n) asm volatile("s_waitcnt lgkmcnt(" #n ")" ::: "memory")
#define PG8_BAR __builtin_amdgcn_s_barrier()
#define PG8_SCHED __builtin_amdgcn_sched_barrier(0)
    Unit cur, nxt; int ui = 0;
    if (!S.next(0, cur)) return;
    f32x4 acc[2][2][4][2];
#pragma unroll
    for (int a = 0; a < 2; ++a)
#pragma unroll
        for (int b = 0; b < 2; ++b)
#pragma unroll
            for (int m = 0; m < 4; ++m)
#pragma unroll
                for (int n = 0; n < 2; ++n) acc[a][b][m][n] = (f32x4){0.f, 0.f, 0.f, 0.f};
    bf16x8 At[4][2], B0[2][2], B1[2][2];
    const char* cA = (const char*)g.A + (size_t)cur.pm * tstep; const char* cB = (const char*)g.Bt + (size_t)cur.pn * tstep;
    S.a_ready(cur);
    if constexpr (SP2) {
        PG8_STAGE(PG8_SB(0, 0), cB, voffB); PG8_STAGE(PG8_SB(0, 1), cB + hstep, voffB); PG8_STAGE(PG8_SA(0, 0), cA, voffA); PG8_STAGE(PG8_SA(0, 1), cA + hstep, voffA);
        if (wr == 1) PG8_BAR;
        PG8_WAIT_V(2); PG8_BAR;
        PG8_STAGE(PG8_SB(1, 0), cB + kstep, voffB); PG8_STAGE(PG8_SA(1, 0), cA + kstep, voffA); PG8_STAGE(PG8_SB(1, 1), cB + hstep + kstep, voffB);
        PG8_WAIT_V(6); PG8_BAR;
    } else {
        PG8_STAGE(PG8_SB(0, 0), cB, voffB); PG8_STAGE(PG8_SA(0, 0), cA, voffA); PG8_STAGE(PG8_SB(0, 1), cB + hstep, voffB); PG8_STAGE(PG8_SA(0, 1), cA + hstep, voffA);
        if (wr == 1) PG8_BAR;
        PG8_WAIT_V(4); PG8_BAR;
        PG8_STAGE(PG8_SB(1, 0), cB + kstep, voffB); PG8_STAGE(PG8_SA(1, 0), cA + kstep, voffA); PG8_STAGE(PG8_SB(1, 1), cB + hstep + kstep, voffB);
        PG8_WAIT_V(6); PG8_BAR;
    }
    for (;;) {
        const bool has_next = S.next(ui + 1, nxt);
        const char* nA = has_next ? (const char*)g.A + (size_t)nxt.pm * tstep : cA; const char* nB = has_next ? (const char*)g.Bt + (size_t)nxt.pn * tstep : cB;
        for (int t = 0; t < nt; t += 2) {
            const bool last = (t == nt - 2);
            const char* a1 = cA + (size_t)(t + 1) * kstep;
            const char* a2 = last ? nA : cA + (size_t)(t + 2) * kstep; const char* b2 = last ? nB : cB + (size_t)(t + 2) * kstep;
            const char* a3 = a2 + kstep; const char* b3 = b2 + kstep;
            if (last && has_next) S.a_ready(nxt);
            if constexpr (SP2) {
            PG8_LDB(B0, 0, 0); PG8_LDB(B1, 0, 1); PG8_SCHED; PG8_LDA(At, 0, 0); PG8_STAGE(PG8_SA(1, 1), a1 + hstep, voffA);
            PG8_WAIT_V(8); PG8_WAIT_L(0); PG8_BAR; PG8_MMA(0, 0, At, B0); PG8_MMA(0, 1, At, B1); PG8_BAR; PG8_SCHED;
            PG8_LDA(At, 0, 1); PG8_STAGE(PG8_SB(0, 0), b2, voffB); PG8_STAGE(PG8_SB(0, 1), b2 + hstep, voffB); PG8_STAGE(PG8_SA(0, 0), a2, voffA);
            PG8_WAIT_V(8); PG8_WAIT_L(0); PG8_BAR; PG8_MMA(1, 0, At, B0); PG8_MMA(1, 1, At, B1); PG8_BAR; PG8_SCHED;
            PG8_LDB(B0, 1, 0); PG8_LDB(B1, 1, 1); PG8_SCHED; PG8_LDA(At, 1, 0); PG8_STAGE(PG8_SA(0, 1), a2 + hstep, voffA);
            PG8_WAIT_V(8); PG8_WAIT_L(0); PG8_BAR; PG8_MMA(0, 0, At, B0); PG8_MMA(0, 1, At, B1); PG8_BAR; PG8_SCHED;
            PG8_LDA(At, 1, 1); PG8_STAGE(PG8_SB(1, 0), b3, voffB); PG8_STAGE(PG8_SB(1, 1), b3 + hstep, voffB); PG8_STAGE(PG8_SA(1, 0), a3, voffA);
            PG8_WAIT_V(8); PG8_WAIT_L(0); PG8_BAR; PG8_MMA(1, 0, At, B0); PG8_MMA(1, 1, At, B1); PG8_BAR; PG8_SCHED;
            } else {
            PG8_LDB(B0, 0, 0); PG8_SCHED; PG8_LDA(At, 0, 0); PG8_STAGE(PG8_SA(1, 1), a1 + hstep, voffA);
            PG8_WAIT_L(8); PG8_BAR; PG8_WAIT_L(0); PG8_MMA(0, 0, At, B0); PG8_BAR; PG8_SCHED;
            PG8_LDB(B1, 0, 1); PG8_STAGE(PG8_SB(0, 0), b2, voffB);
            PG8_BAR; PG8_WAIT_L(0); PG8_MMA(0, 1, At, B1); PG8_BAR;
            PG8_LDA(At, 0, 1); PG8_STAGE(PG8_SA(0, 0), a2, voffA);
            PG8_BAR; PG8_WAIT_L(0); PG8_MMA(1, 0, At, B0); PG8_BAR; PG8_SCHED;
            PG8_STAGE(PG8_SB(0, 1), b2 + hstep, voffB);
            PG8_WAIT_V(6); PG8_BAR; PG8_MMA(1, 1, At, B1); PG8_BAR;
            PG8_LDB(B0, 1, 0); PG8_SCHED; PG8_LDA(At, 1, 0); PG8_STAGE(PG8_SA(0, 1), a2 + hstep, voffA);
            PG8_WAIT_L(8); PG8_BAR; PG8_WAIT_L(0); PG8_MMA(0, 0, At, B0); PG8_BAR; PG8_SCHED;
            PG8_LDB(B1, 1, 1); PG8_STAGE(PG8_SB(1, 0), b3, voffB);
            PG8_BAR; PG8_WAIT_L(0); PG8_MMA(0, 1, At, B1); PG8_BAR;
            PG8_LDA(At, 1, 1); PG8_STAGE(PG8_SA(1, 0), a3, voffA);
            PG8_BAR; PG8_WAIT_L(0); PG8_MMA(1, 0, At, B0); PG8_BAR; PG8_SCHED;
            PG8_STAGE(PG8_SB(1, 1), b3 + hstep, voffB);
            PG8_WAIT_V(6); PG8_BAR; PG8_MMA(1, 1, At, B1); PG8_BAR;
            }
        }
        if constexpr (ALIGN_EPI) { if (wr == 0) PG8_BAR; }
        if constexpr (!Epi::AFTER_DRAIN) { E(acc, cur, wr, wc, fr, fq); S.done(cur); }
        if (!has_next) break;
#pragma unroll
        for (int a = 0; a < 2; ++a)
#pragma unroll
            for (int b = 0; b < 2; ++b)
#pragma unroll
                for (int m = 0; m < 4; ++m)
#pragma unroll
                    for (int n = 0; n < 2; ++n) acc[a][b][m][n] = (f32x4){0.f, 0.f, 0.f, 0.f};
        cur = nxt; cA = nA; cB = nB; ++ui;
        if constexpr (ALIGN_EPI) { if (wr == 1) PG8_BAR; }
    }
    PG8_WAIT_V(0);
    if constexpr (!ALIGN_EPI) { if (wr == 0) PG8_BAR; }
    PG8_BAR;
    if constexpr (Epi::AFTER_DRAIN) { E.fused(acc, cur, wr, wc, fr, fq, lds, wid, lane); S.done(cur); }
#undef PG8_SA
#undef PG8_SB
#undef PG8_STAGE
#undef PG8_LDA
#undef PG8_LDB
#undef PG8_MMA
#undef PG8_WAIT_V
#undef PG8_WAIT_L
#undef PG8_BAR
#undef PG8_SCHED
}
}
#ifndef PG8_SP2
#define PG8_SP2 true
#endif
#ifndef PG8_ALIGN
#define PG8_ALIGN true
#endif
constexpr int NWAVES = 8;
constexpr int DM = 1024, NBATCH = 16, SEQ = 2048, NMETA = 16, TT = SEQ + NMETA, DBATCH = 128, DSEQ = 8, PAST = 8192, PAGE = 128, NPAGES = 64;
constexpr int NHEAD = 8, QKN = 64, QKR = 32, QKH = 96, VHD = 128, QLORA = 384, KVL = 256, PW = 512, DFF = 4096, DIN = 3232;
constexpr int MP = NBATCH * SEQ, MS = DBATCH * DSEQ, MC = MP + MS, MCX = MC + 256;
constexpr int NIN = 3328, PFW = 1280;
constexpr int RB = NBATCH * TT;
constexpr float EPS = 1e-6f;
constexpr float SCALE_L2E = 0.10206207261596575f * 1.4426950408889634f;
constexpr size_t O_YP = 0, O_YS = O_YP + (size_t)MP * DM, O_CP = O_YS + (size_t)MS * DM, O_KRP = O_CP + (size_t)RB * KVL, O_PSP = O_KRP + (size_t)RB * QKR,
                 O_CS = O_PSP + (size_t)NBATCH * 15 * PW, O_KRS = O_CS + (size_t)MS * KVL, O_PSS = O_KRS + (size_t)MS * QKR, O_END = O_PSS + (size_t)DBATCH * 15 * PW;
static_assert(O_END == 45514752, "d_out size");
constexpr size_t al256(size_t x) { return (x + 255) & ~(size_t)255; }
constexpr size_t WS_CTL = 0, CTL_BYTES = 1u << 20;
constexpr size_t WS_WIN = CTL_BYTES;
constexpr size_t WS_WUQ = WS_WIN + al256((size_t)NIN * DM * 2);
constexpr size_t WS_WKV = WS_WUQ + al256((size_t)768 * 384 * 2);
constexpr size_t WS_WUK = WS_WKV + al256((size_t)1536 * 256 * 2);
constexpr size_t WS_WPL = WS_WUK + al256((size_t)512 * 256 * 2);
constexpr size_t WS_WO = WS_WPL + al256((size_t)1024 * 512 * 2);
constexpr size_t WS_W1 = WS_WO + al256((size_t)DM * DM * 2);
constexpr size_t WS_W2 = WS_W1 + al256((size_t)DFF * DM * 2);
constexpr size_t WS_ROPE = WS_W2 + al256((size_t)DFF * DM * 2);
constexpr size_t WS_XNM = WS_ROPE + al256((size_t)2072 * 32 * 4);
constexpr size_t WS_PFM = WS_XNM + al256(16 * 1024 * 2);
constexpr size_t WS_CM = WS_PFM + al256(16 * 1280 * 4);
constexpr size_t WS_KRM = WS_CM + al256(16 * 256 * 4);
constexpr size_t WS_KSM = WS_KRM + al256(16 * 32 * 4);
constexpr size_t WS_XN = WS_KSM + 256;
constexpr size_t WS_PF = WS_XN + al256((size_t)MCX * DM * 2);
constexpr size_t WS_GATE = WS_PF + al256((size_t)MCX * PFW * 4);
constexpr size_t WS_CB = WS_GATE + al256((size_t)MCX * 2048 * 2);
constexpr size_t WS_KRG = WS_CB + al256((size_t)MC * 256 * 2);
constexpr size_t WS_KSS = WS_KRG + al256((size_t)(RB + 64) * 32 * 2);
constexpr size_t WS_QL = WS_KSS + al256((size_t)(RB + 64) * 4);
constexpr size_t WS_DP = WS_QL + al256((size_t)MC * 384 * 2);
constexpr size_t WS_QR = WS_DP + al256((size_t)MC * 512 * 2);
constexpr size_t WS_KH = WS_QR + al256((size_t)MC * 768 * 2);
constexpr size_t WS_VH = WS_KH + al256((size_t)(RB + 64) * 768 * 2);
constexpr size_t WS_PG = WS_VH + al256((size_t)(RB + 64) * 1024 * 2);
constexpr size_t WS_AM = WS_PG + al256((size_t)MC * DM * 2);
constexpr size_t WS_SAC = WS_AM + al256((size_t)MC * DM * 2);
constexpr size_t WS_SAL = WS_SAC + al256((size_t)256 * 64 * 256 * 4);
constexpr size_t WS_H = WS_SAL + al256((size_t)256 * 64 * 4);
constexpr size_t WS_HN = WS_H + al256((size_t)MC * DM * 4);
constexpr size_t WS_Z = WS_HN + al256((size_t)MC * DM * 2);
constexpr size_t WS_WOS = WS_Z + al256((size_t)MC * DFF * 2);
constexpr size_t WS_W2S = WS_WOS + al256((size_t)DM * DM * 2);
constexpr size_t WS_AMS = WS_W2S + al256((size_t)DFF * DM * 2);
constexpr size_t WS_HS = WS_AMS + al256((size_t)MS * DM * 2);
constexpr size_t WS_ZS = WS_HS + al256((size_t)4 * MS * DM * 4);
constexpr size_t WS_YS = WS_ZS + al256((size_t)MS * DFF * 2);
constexpr size_t WS_PB = WS_YS + al256((size_t)8 * MS * DM * 4);
constexpr size_t WS_HB = WS_PB + al256((size_t)MCX * PFW * 2);
constexpr size_t WS_END = WS_HB + al256((size_t)MP * DM * 2);
constexpr int CW_TMO = 0, CW_CODE = 1, CW_BAR = 4096;
#ifdef SMALL_LDS
constexpr int RING_OFF = 0, RING_BYTES = 147456;
#else
constexpr int RING_OFF = 0, RING_BYTES = 161792;
#endif
constexpr int LDSCTL_OFF = RING_BYTES, MISC_OFF = LDSCTL_OFF + 320;
constexpr int LDS_BYTES = RING_BYTES + 512;
static_assert(LDS_BYTES <= 163840, "LDS");

#define GAS __attribute__((address_space(1)))
#define LAS __attribute__((address_space(3)))
typedef unsigned short bf16;
typedef unsigned v4u __attribute__((ext_vector_type(4)));
typedef unsigned v2u __attribute__((ext_vector_type(2)));
typedef float f32x4 __attribute__((ext_vector_type(4)));
typedef float f32x2 __attribute__((ext_vector_type(2)));
typedef float f32x16 __attribute__((ext_vector_type(16)));
typedef short bf16x8 __attribute__((ext_vector_type(8)));
typedef short s16x4 __attribute__((ext_vector_type(4)));
typedef GAS unsigned gu32;
#define RLX_AGENT __ATOMIC_RELAXED, __HIP_MEMORY_SCOPE_AGENT
#define LDS_WAIT() asm volatile("s_waitcnt lgkmcnt(0)" ::: "memory")
#define VM_WAIT() asm volatile("s_waitcnt vmcnt(0)" ::: "memory")
#define SBAR() __builtin_amdgcn_sched_barrier(0)
__device__ __forceinline__ unsigned f2bf(float f) { unsigned u = __builtin_bit_cast(unsigned, f); return (u + 0x7fffu + ((u >> 16) & 1u)) >> 16; }
typedef float f32x2_t __attribute__((ext_vector_type(2))); typedef __bf16 bf16x2_t __attribute__((ext_vector_type(2)));
__device__ __forceinline__ unsigned pk2(float lo, float hi) { const f32x2_t v = {lo, hi}; const bf16x2_t b = __builtin_convertvector(v, bf16x2_t); return __builtin_bit_cast(unsigned, b); }
__device__ __forceinline__ float bflo(unsigned u) { return __builtin_bit_cast(float, u << 16); }
__device__ __forceinline__ float bfhi(unsigned u) { return __builtin_bit_cast(float, u & 0xffff0000u); }
template <int CTRL> __device__ __forceinline__ float dppf(float v) { return __builtin_bit_cast(float, __builtin_amdgcn_update_dpp(0, __builtin_bit_cast(int, v), CTRL, 0xf, 0xf, true)); }
__device__ __forceinline__ float sum_x16(float v) { const unsigned u = __float_as_uint(v); auto r = __builtin_amdgcn_permlane16_swap(u, u, false, false); return __uint_as_float(r[0]) + __uint_as_float(r[1]); }
__device__ __forceinline__ float sum_x32(float v) { const unsigned u = __float_as_uint(v); auto r = __builtin_amdgcn_permlane32_swap(u, u, false, false); return __uint_as_float(r[0]) + __uint_as_float(r[1]); }
__device__ __forceinline__ float max_x16(float v) { const unsigned u = __float_as_uint(v); auto r = __builtin_amdgcn_permlane16_swap(u, u, false, false); return fmaxf(__uint_as_float(r[0]), __uint_as_float(r[1])); }
__device__ __forceinline__ float max_x32(float v) { const unsigned u = __float_as_uint(v); auto r = __builtin_amdgcn_permlane32_swap(u, u, false, false); return fmaxf(__uint_as_float(r[0]), __uint_as_float(r[1])); }
__device__ __forceinline__ float sum_quad(float v) { v += dppf<0xB1>(v); v += dppf<0x4E>(v); return v; }
__device__ __forceinline__ float sum_oct(float v) { v = sum_quad(v); v += dppf<0x141>(v); return v; }
__device__ __forceinline__ float sum_row16(float v) { v = sum_oct(v); v += dppf<0x140>(v); return v; }
__device__ __forceinline__ float wave_sum(float v) { return sum_x32(sum_x16(sum_row16(v))); }
__device__ __forceinline__ float wave_max(float v) { v = fmaxf(v, dppf<0xB1>(v)); v = fmaxf(v, dppf<0x4E>(v)); v = fmaxf(v, dppf<0x141>(v)); v = fmaxf(v, dppf<0x140>(v)); return max_x32(max_x16(v)); }
__device__ __forceinline__ float frsqrt(float x) { return 1.0f / sqrtf(x); }
__constant__ double ROPE_INV[16] = { 1.0, 0.5623413251903491, 0.31622776601683794, 0.1778279410038923, 0.1, 0.05623413251903491, 0.03162277660168379, 0.01778279410038923,
    0.01, 0.005623413251903491, 0.0031622776601683794, 0.001778279410038923, 0.001, 0.0005623413251903491, 0.00031622776601683794, 0.0001778279410038923 };
#define XB_TMO      128
#define XB_XCNT(j)  (256  + 64 * (j))
#define XB_XSUB(j)  (1280 + 64 * (j))
#define XB_XGEN(j)  (2304 + 64 * (j))
#define XB_TOP      3328
#define XB_TOPGEN   3392
#define XCD_BAR_WORDS 3456
#define XB_SPIN_CAP (1u << 18)

__device__ __forceinline__ unsigned xb_ld(unsigned* p)              { return __hip_atomic_load(p, __ATOMIC_RELAXED, __HIP_MEMORY_SCOPE_AGENT); }
__device__ __forceinline__ unsigned xb_add(unsigned* p, unsigned v) { return __hip_atomic_fetch_add(p, v, __ATOMIC_RELAXED, __HIP_MEMORY_SCOPE_AGENT); }
__device__ __forceinline__ unsigned xb_xcc_id() { return (unsigned)__builtin_amdgcn_s_getreg((3 << 11) | 20) & 0xFu; }
#define XB_SPIN(cond, bar) do { unsigned _sp = 0; while (cond) { __builtin_amdgcn_s_sleep(1); \
    if ((++_sp & 255u) == 0u) { if (xb_ld(&(bar)[XB_TMO])) break; if (_sp > XB_SPIN_CAP) { atomicAdd(&(bar)[XB_TMO], 1u); break; } } } } while (0)

struct XcdBarrier {
    unsigned* bar; unsigned x;
    volatile LAS unsigned* st;
};

__device__ __forceinline__ XcdBarrier xcd_barrier_post(unsigned* bar, volatile LAS unsigned* st) {
    XcdBarrier b; b.bar = bar; b.x = xb_xcc_id(); b.st = st;
    if (threadIdx.x == 0) (void)xb_add(&bar[XB_XCNT(b.x)], 1u);
    return b;
}
__device__ __forceinline__ void xcd_barrier_complete(unsigned* bar, unsigned x, unsigned& nloc, unsigned& nx) {
    const unsigned G = gridDim.x * gridDim.y * gridDim.z;
    unsigned sum, cnt, mine, sp = 0u;
    for (;;) {
        sum = 0u; cnt = 0u; mine = 0u;
#pragma unroll
        for (unsigned j = 0; j < 16; ++j) { const unsigned c = xb_ld(&bar[XB_XCNT(j)]); sum += c; cnt += (c > 0u) ? 1u : 0u; mine = (j == x) ? c : mine; }
        if (sum == G) break;
        __builtin_amdgcn_s_sleep(1);
        if ((++sp & 255u) == 0u) { if (xb_ld(&bar[XB_TMO])) break; if (sp > XB_SPIN_CAP) { atomicAdd(&bar[XB_TMO], 1u); break; } }
    }
    nloc = mine > 0u ? mine : 1u; nx = cnt > 0u ? cnt : 1u;
}

__device__ __forceinline__ void xcd_barrier(const XcdBarrier& b) {
    asm volatile("s_waitcnt vmcnt(0)" ::: "memory");
    __syncthreads();
    if (threadIdx.x == 0) {
        unsigned* bar = b.bar;
        __builtin_amdgcn_s_waitcnt(0);
        unsigned nloc = b.st[0], nx = b.st[1];
        if (nloc == 0u) { xcd_barrier_complete(bar, b.x, nloc, nx); b.st[0] = nloc; b.st[1] = nx; }
        const unsigned old = xb_add(&bar[XB_XSUB(b.x)], 1u);
        const unsigned gen = old / nloc;
        if (old + 1u == (gen + 1u) * nloc) {
            __builtin_amdgcn_fence(__ATOMIC_RELEASE, "agent");
            asm volatile("s_waitcnt vmcnt(0)" ::: "memory");
            const unsigned og = xb_add(&bar[XB_TOP], 1u);
            const unsigned tg = og / nx;
            if (og + 1u == (tg + 1u) * nx) xb_add(&bar[XB_TOPGEN], 1u);
            else XB_SPIN(xb_ld(&bar[XB_TOPGEN]) == tg, bar);
            __builtin_amdgcn_fence(__ATOMIC_ACQUIRE, "agent");
            xb_add(&bar[XB_XGEN(b.x)], 1u);
            asm volatile("s_waitcnt vmcnt(0)" ::: "memory");
        } else {
            XB_SPIN(xb_ld(&bar[XB_XGEN(b.x)]) == gen, bar);
            __builtin_amdgcn_fence(__ATOMIC_ACQUIRE, "agent");
            asm volatile("s_waitcnt vmcnt(0)" ::: "memory");
        }
    }
    __syncthreads();
}
struct Frame {
    LAS unsigned char* lds;
    volatile LAS unsigned* MISC;
    gu32* ctl;
    int tid, lane, wave, vcu, G;
    const float *x_prompt, *x_sample, *cache_c, *cache_kr, *state_pool; const int* page_table;
    const float *meta_tokens, *g_attn, *w_in, *g_q_lat, *w_uq, *g_kv_lat, *g_qn_nope, *g_qn_rope, *w_uk, *g_kn_nope, *g_kn_rope, *w_uv, *w_pool_map, *pool_scale, *w_o, *g_mlp, *w_ff1, *w_ff2;
    float* out; unsigned char* ws;
};
#define WSP(T, off) ((T*)(F.ws + (off)))

__device__ __forceinline__ void p0_tr_block(const float* W, int ldw, bf16* dst, bf16* dst2, int pitch, int pitch2, bool zero, LAS float* scr, int lane) {
    const int c = lane & 7;
    if (zero) {
#pragma unroll
        for (int j = 0; j < 4; ++j) { const int n = (lane >> 3) + 8 * j; *(GAS v4u*)(dst + (size_t)n * pitch + 8 * c) = (v4u){0u, 0u, 0u, 0u}; }
        return;
    }
    {
        const int r8 = lane >> 3, c4 = lane & 7; const float* wp = W + (size_t)r8 * ldw + 4 * c4;
        f32x4 v[8];
#pragma unroll
        for (int i = 0; i < 8; ++i) v[i] = __builtin_nontemporal_load((const GAS f32x4*)(wp + (size_t)(8 * i) * ldw));
#pragma unroll
        for (int i = 0; i < 8; ++i) { LAS float* s = scr + (8 * i + r8) * 33 + 4 * c4; s[0] = v[i].x; s[1] = v[i].y; s[2] = v[i].z; s[3] = v[i].w; }
    }
    LDS_WAIT(); asm volatile("" ::: "memory");
#pragma unroll
    for (int j = 0; j < 4; ++j) { const int n = (lane >> 3) + 8 * j; const LAS float* s = scr + (8 * c) * 33 + n;
        v4u o; o.x = pk2(s[0 * 33], s[1 * 33]); o.y = pk2(s[2 * 33], s[3 * 33]); o.z = pk2(s[4 * 33], s[5 * 33]); o.w = pk2(s[6 * 33], s[7 * 33]);
        *(GAS v4u*)(dst + (size_t)n * pitch + 8 * c) = o;
        if (dst2) *(GAS v4u*)(dst2 + (size_t)n * pitch2 + 8 * c) = o; }
    LDS_WAIT(); asm volatile("" ::: "memory");
}
__device__ __forceinline__ int in_row(int n0) { return n0 < 512 ? 256 + n0 : (n0 < 896 ? 768 + (n0 - 512) : (n0 < 1152 ? n0 - 896 : (n0 < 1184 ? n0 : 1280 + (n0 - 1184)))); }

__device__ __forceinline__ void p0_weights(Frame& F, int it0, int it1, int gw, int NGW) {
    LAS float* scr = (LAS float*)(F.lds + RING_OFF + F.wave * 16384);
    const int lane = F.lane;
    bf16* Win_t = WSP(bf16, WS_WIN); bf16* Wuq_t = WSP(bf16, WS_WUQ); bf16* Wkv_t = WSP(bf16, WS_WKV); bf16* Wuk_t = WSP(bf16, WS_WUK); bf16* Wpl_t = WSP(bf16, WS_WPL);
    bf16* Wo_t = WSP(bf16, WS_WO); bf16* W1_t = WSP(bf16, WS_W1); bf16* W2_t = WSP(bf16, WS_W2);
    constexpr int I_1 = 16 * 128, I_2 = 64 * 32, I_O = 16 * 32, I_IN = 16 * 101, I_PL = 2 * 32, I_UQ = 6 * 24, I_UV = 4 * 32, I_UK = 4 * 16, I_INZ = 16 * 3;
    for (int it = it0 + gw; it < it1; it += NGW) {
        int r = it; const float* W; int ldw, pitch, pitch2 = 0; bf16* dst; bf16* dst2 = nullptr; bool zero = false;
        if (r < I_1) { const int kb = r / 128, nb = r % 128; W = F.w_ff1 + (size_t)(64 * kb) * DFF + 32 * nb; ldw = DFF; pitch = DM; dst = W1_t + (size_t)(32 * nb) * DM + 64 * kb; }
        else if ((r -= I_1) < I_2) { const int kb = r / 32, nb = r % 32; W = F.w_ff2 + (size_t)(64 * kb) * DM + 32 * nb; ldw = DM; pitch = DFF; dst = W2_t + (size_t)(32 * nb) * DFF + 64 * kb;
            dst2 = WSP(bf16, WS_W2S) + ((size_t)(kb >> 3) * DM + 32 * nb) * 512 + 64 * (kb & 7); pitch2 = 512; }
        else if ((r -= I_2) < I_O) { const int kb = r / 32, nb = r % 32; W = F.w_o + (size_t)(64 * kb) * DM + 32 * nb; ldw = DM; pitch = DM; dst = Wo_t + (size_t)(32 * nb) * DM + 64 * kb;
            dst2 = WSP(bf16, WS_WOS) + ((size_t)(kb >> 2) * DM + 32 * nb) * 256 + 64 * (kb & 3); pitch2 = 256; }
        else if ((r -= I_O) < I_IN) { const int kb = r / 101, nb = r % 101; W = F.w_in + (size_t)(64 * kb) * DIN + 32 * nb; ldw = DIN; pitch = DM; dst = Win_t + (size_t)in_row(32 * nb) * DM + 64 * kb; }
        else if ((r -= I_IN) < I_PL) { const int kb = r / 32, nb = r % 32, g = nb / 8;
            pitch = 128; dst = Wpl_t + (size_t)(32 * nb) * 128 + 64 * kb; ldw = 256;
            W = F.w_pool_map + (size_t)g * 128 * 256 + (size_t)(64 * kb) * 256 + (32 * nb - 256 * g); }
        else if ((r -= I_PL) < I_UQ) { const int kb = r / 24, nb = r % 24; W = F.w_uq + (size_t)(64 * kb) * 768 + 32 * nb; ldw = 768; pitch = QLORA; dst = Wuq_t + (size_t)(32 * nb) * QLORA + 64 * kb; }
        else if ((r -= I_UQ) < I_UV) { const int kb = r / 32, nb = r % 32; W = F.w_uv + (size_t)(64 * kb) * 1024 + 32 * nb; ldw = 1024; pitch = KVL; dst = Wkv_t + (size_t)(512 + 32 * nb) * KVL + 64 * kb; }
        else if ((r -= I_UV) < I_UK) { const int kb = r / 16, nb = r % 16, h = nb >> 1, d0 = (nb & 1) * 32; W = F.w_uk + (size_t)(64 * kb) * 512 + 32 * nb; ldw = 512; pitch = KVL;
            dst = Wkv_t + (size_t)(256 * (h >> 2) + 128 * (d0 >> 5) + 32 * (h & 3)) * KVL + 64 * kb; dst2 = Wuk_t + (size_t)(32 * nb) * KVL + 64 * kb; pitch2 = KVL; }
        else { r -= I_UK; const int kb = r / 3, nb = r % 3; W = F.w_in; ldw = DIN; pitch = DM; dst = Win_t + (size_t)(1184 + 32 * nb) * DM + 64 * kb; zero = true; }
        p0_tr_block(W, ldw, dst, dst2, pitch, pitch2, zero, scr, lane);
    }
}
constexpr int P0_LATE_ITEMS = 16 * 128 + 64 * 32 + 16 * 32, P0_ALL_ITEMS = P0_LATE_ITEMS + 16 * 101 + 2 * 32 + 6 * 24 + 4 * 32 + 4 * 16 + 16 * 3;
__device__ __forceinline__ void p0_prologue(Frame& F) {
    const int gw = F.vcu * NWAVES + F.wave, NGW = F.G * NWAVES, lane = F.lane;
    p0_weights(F, P0_LATE_ITEMS, P0_ALL_ITEMS, gw, NGW);
    bf16* XN = WSP(bf16, WS_XN);
    f32x4 g4[4];
#pragma unroll
    for (int j = 0; j < 4; ++j) g4[j] = *((const GAS f32x4*)F.g_attn + lane + 64 * j);
    for (int m = gw; m < MC + NMETA; m += NGW) {
        const float* xrow = m < MP ? F.x_prompt + (size_t)m * DM : (m < MC ? F.x_sample + (size_t)(m - MP) * DM : F.meta_tokens + (size_t)(m - MC) * DM);
        bf16* orow = XN + (size_t)m * DM;
        const GAS f32x4* xr = (const GAS f32x4*)xrow + lane;
        f32x4 v[4]; float s = 0.f;
#pragma unroll
        for (int j = 0; j < 4; ++j) { v[j] = __builtin_nontemporal_load(xr + 64 * j); s += (v[j].x * v[j].x + v[j].y * v[j].y) + (v[j].z * v[j].z + v[j].w * v[j].w); }
        const float rstd = frsqrt(wave_sum(s) * (1.f / DM) + EPS);
        GAS v2u* o8 = (GAS v2u*)orow + lane;
#pragma unroll
        for (int j = 0; j < 4; ++j) { v2u o; o.x = pk2(v[j].x * rstd * g4[j].x, v[j].y * rstd * g4[j].y); o.y = pk2(v[j].z * rstd * g4[j].z, v[j].w * rstd * g4[j].w); o8[64 * j] = o; }
    }
    { GAS v4u* zp = (GAS v4u*)(XN + (size_t)(MC + NMETA) * DM);
      for (int e = (F.vcu * NWAVES * 64) + F.tid; e < (MCX - MC - NMETA) * DM / 8; e += F.G * NWAVES * 64) zp[e] = (v4u){0u, 0u, 0u, 0u}; }
    float* ROPE = WSP(float, WS_ROPE);
    for (int e = (F.vcu * NWAVES * 64) + F.tid; e < 2072 * 16; e += F.G * NWAVES * 64) {
        const int p = e >> 4, i = e & 15; const int pos = p < TT ? p : PAST + (p - TT);
        const double ang = (double)pos * ROPE_INV[i];
        const double k = __builtin_rint(ang * 0.15915494309189535);
        const double r = __builtin_fma(-k, 6.283185307179586, ang) - k * 2.4492935982947064e-16;
        const float rf = (float)r;
        ROPE[p * 32 + i] = cosf(rf); ROPE[p * 32 + 16 + i] = sinf(rf);
    }
    { GAS v4u* kp = (GAS v4u*)(WSP(bf16, WS_KH) + (size_t)RB * 768); GAS v4u* vp = (GAS v4u*)(WSP(bf16, WS_VH) + (size_t)RB * 1024);
      for (int e = (F.vcu * NWAVES * 64) + F.tid; e < 64 * 768 / 8 + 64 * 1024 / 8; e += F.G * NWAVES * 64) { if (e < 64 * 768 / 8) kp[e] = (v4u){0u, 0u, 0u, 0u}; else vp[e - 64 * 768 / 8] = (v4u){0u, 0u, 0u, 0u}; } }
}

__device__ __forceinline__ void p1_meta(Frame& F) {
    const int gw = F.vcu * NWAVES + F.wave, NGW = F.G * NWAVES, lane = F.lane;
    const bf16* Win_t = WSP(bf16, WS_WIN); const bf16* XNM = WSP(bf16, WS_XNM); float* PFM = WSP(float, WS_PFM);
    for (int t = gw; t < 800; t += NGW) {
        const int n = t < 768 ? t : 1152 + (t - 768);
        const GAS v4u* wp = (const GAS v4u*)(Win_t + (size_t)n * DM + lane * 16);
        const v4u w0 = wp[0], w1 = wp[1];
        float wf[16];
        wf[0] = bflo(w0.x); wf[1] = bfhi(w0.x); wf[2] = bflo(w0.y); wf[3] = bfhi(w0.y); wf[4] = bflo(w0.z); wf[5] = bfhi(w0.z); wf[6] = bflo(w0.w); wf[7] = bfhi(w0.w);
        wf[8] = bflo(w1.x); wf[9] = bfhi(w1.x); wf[10] = bflo(w1.y); wf[11] = bfhi(w1.y); wf[12] = bflo(w1.z); wf[13] = bfhi(w1.z); wf[14] = bflo(w1.w); wf[15] = bfhi(w1.w);
        float mine = 0.f;
#pragma unroll 4
        for (int i = 0; i < 16; ++i) {
            const GAS v4u* xp = (const GAS v4u*)(XNM + (size_t)i * DM + lane * 16);
            const v4u x0 = xp[0], x1 = xp[1];
            float a = bflo(x0.x) * wf[0] + bfhi(x0.x) * wf[1] + bflo(x0.y) * wf[2] + bfhi(x0.y) * wf[3] + bflo(x0.z) * wf[4] + bfhi(x0.z) * wf[5] + bflo(x0.w) * wf[6] + bfhi(x0.w) * wf[7]
                    + bflo(x1.x) * wf[8] + bfhi(x1.x) * wf[9] + bflo(x1.y) * wf[10] + bfhi(x1.y) * wf[11] + bflo(x1.z) * wf[12] + bfhi(x1.z) * wf[13] + bflo(x1.w) * wf[14] + bfhi(x1.w) * wf[15];
            a = wave_sum(a);
            mine = (lane == i) ? a : mine;
        }
        if (lane < 16) PFM[lane * PFW + n] = mine;
    }
}

__device__ __forceinline__ void p2_rows(Frame& F) {
    const int gw = F.vcu * NWAVES + F.wave, NGW = F.G * NWAVES, lane = F.lane;
    const bf16* PB = WSP(bf16, WS_PB); const float* ROPE = WSP(float, WS_ROPE);
    bf16* CB = WSP(bf16, WS_CB); bf16* KRG = WSP(bf16, WS_KRG); float* KSS = WSP(float, WS_KSS); bf16* QL = WSP(bf16, WS_QL);
    float* CM = WSP(float, WS_CM); float* KRM = WSP(float, WS_KRM); float* KSM = WSP(float, WS_KSM);
    const f32x4 gkv = *((const GAS f32x4*)F.g_kv_lat + lane);
    const f32x4 gqa = *((const GAS f32x4*)F.g_q_lat + lane);
    const f32x2 gqb = *((const GAS f32x2*)(F.g_q_lat + 256) + lane);
    const float gkr = F.g_kn_rope[lane & 15];
    struct RowIn { v2u c; unsigned short k1, k2; float cs, sn; v2u qa; unsigned qb; };
    auto row_load = [&](int m, RowIn& r) {
        const bool meta = m >= MC, samp = !meta && m >= MP;
        const bf16* pf = PB + (size_t)m * PFW;
        const int pos = meta ? m - MC : (samp ? PAST + ((m - MP) & 7) : (m & (SEQ - 1)) + NMETA);
        const int ridx = pos < TT ? pos : TT + (pos - PAST);
        r.c = *((const GAS v2u*)pf + lane);
        r.k1 = 0; r.k2 = 0; r.cs = 1.f; r.sn = 0.f;
        if (lane < 16) { r.k1 = pf[1152 + lane]; r.k2 = pf[1152 + 16 + lane]; r.cs = ROPE[ridx * 32 + lane]; r.sn = ROPE[ridx * 32 + 16 + lane]; }
        r.qa = (v2u){0u, 0u}; r.qb = 0u;
        if (!meta) { r.qa = *((const GAS v2u*)(pf + 768) + lane); r.qb = *((const GAS unsigned*)(pf + 1024) + lane); }
    };
    auto row_do = [&](int m, const RowIn& r) {
        const bool meta = m >= MC, samp = !meta && m >= MP;
        const f32x4 c4 = (f32x4){bflo(r.c.x), bfhi(r.c.x), bflo(r.c.y), bfhi(r.c.y)};
        const float x1 = bflo((unsigned)r.k1), x2 = bflo((unsigned)r.k2), cs = r.cs, sn = r.sn;
        const f32x4 qa = (f32x4){bflo(r.qa.x), bfhi(r.qa.x), bflo(r.qa.y), bfhi(r.qa.y)}; const f32x2 qb = (f32x2){bflo(r.qb), bfhi(r.qb)};
        float sc = (c4.x * c4.x + c4.y * c4.y) + (c4.z * c4.z + c4.w * c4.w), sk = x1 * x1 + x2 * x2, sq = (qa.x * qa.x + qa.y * qa.y) + (qa.z * qa.z + qa.w * qa.w) + (qb.x * qb.x + qb.y * qb.y);
        sc = wave_sum(sc); sk = wave_sum(sk); sq = wave_sum(sq);
        const float rc = frsqrt(sc * (1.f / KVL) + EPS), rq = frsqrt(sq * (1.f / QLORA) + EPS);
        const f32x4 cn = (f32x4){c4.x * rc * gkv.x, c4.y * rc * gkv.y, c4.z * rc * gkv.z, c4.w * rc * gkv.w};
        const float o1 = x1 * cs - x2 * sn, o2 = x2 * cs + x1 * sn;
        if (meta) {
            const int i = m - MC;
            *((GAS f32x4*)(CM + (size_t)i * KVL) + lane) = cn;
            if (lane < 16) { KRM[i * 32 + lane] = o1 * gkr; KRM[i * 32 + 16 + lane] = o2 * gkr; }
            if (lane == 0) KSM[i] = sk;
#pragma unroll 4
            for (int b = 0; b < NBATCH; ++b) { const size_t R = (size_t)b * TT + i;
                *((GAS f32x4*)(F.out + O_CP + R * KVL) + lane) = cn;
                if (lane < 16) { F.out[O_KRP + R * QKR + lane] = o1; F.out[O_KRP + R * QKR + 16 + lane] = o2;
                    KRG[R * 32 + lane] = (bf16)f2bf(o1 * gkr); KRG[R * 32 + 16 + lane] = (bf16)f2bf(o2 * gkr); }
                if (lane == 0) KSS[R] = sk; }
        } else {
            v2u cb; cb.x = pk2(cn.x, cn.y); cb.y = pk2(cn.z, cn.w);
            *((GAS v2u*)(CB + (size_t)m * KVL) + lane) = cb;
            if (!samp) { const size_t R = (size_t)m + NMETA * ((m >> 11) + 1);
                *((GAS f32x4*)(F.out + O_CP + R * KVL) + lane) = cn;
                if (lane < 16) { F.out[O_KRP + R * QKR + lane] = o1; F.out[O_KRP + R * QKR + 16 + lane] = o2;
                    KRG[R * 32 + lane] = (bf16)f2bf(o1 * gkr); KRG[R * 32 + 16 + lane] = (bf16)f2bf(o2 * gkr); }
                if (lane == 0) KSS[R] = sk;
            } else { const size_t R = (size_t)(m - MP);
                *((GAS f32x4*)(F.out + O_CS + R * KVL) + lane) = cn;
                if (lane < 16) { F.out[O_KRS + R * QKR + lane] = o1; F.out[O_KRS + R * QKR + 16 + lane] = o2; } }
            v2u qo; qo.x = pk2(qa.x * rq * gqa.x, qa.y * rq * gqa.y); qo.y = pk2(qa.z * rq * gqa.z, qa.w * rq * gqa.w);
            *((GAS v2u*)(QL + (size_t)m * QLORA) + lane) = qo;
            *((GAS unsigned*)(QL + (size_t)m * QLORA + 256) + lane) = pk2(qb.x * rq * gqb.x, qb.y * rq * gqb.y);
        }
    };
    {
        RowIn ra, rb; int m = gw;
        if (m < MC + NMETA) row_load(m, ra);
        for (; m < MC + NMETA; m += 2 * NGW) {
            const int m2 = m + NGW, m3 = m + 2 * NGW;
            if (m2 < MC + NMETA) row_load(m2, rb);
            row_do(m, ra);
            if (m3 < MC + NMETA) row_load(m3, ra);
            if (m2 < MC + NMETA) row_do(m2, rb);
        }
    }
}
__device__ __forceinline__ void ldu8(const bf16* p, f32x4& a, f32x4& b) { const v4u v = *(const GAS v4u*)p;
    a = (f32x4){bflo(v.x), bfhi(v.x), bflo(v.y), bfhi(v.y)}; b = (f32x4){bflo(v.z), bfhi(v.z), bflo(v.w), bfhi(v.w)}; }
__device__ __forceinline__ void p2_pool(Frame& F) {
    const int gw = F.vcu * NWAVES + F.wave, NGW = F.G * NWAVES, lane = F.lane;
    const bf16* PB = WSP(bf16, WS_PB); bf16* DP = WSP(bf16, WS_DP);
    const int w = 2 << (lane >> 4); const float iw = 1.0f / (float)w; const int col = 256 + 8 * lane;
    for (int t = gw; t < MP / 16; t += NGW) {
        const int b = t >> 7, t0 = (t & 127) * 16;
        const bf16* base = PB + (size_t)b * SEQ * PFW + col;
#define UROW(tp) (((tp) >= 0) ? base + (size_t)(tp) * PFW : PB + (size_t)(MC + (tp) + NMETA) * PFW + col)
        f32x4 ra = (f32x4){0.f, 0.f, 0.f, 0.f}, rb = ra;
#pragma unroll
        for (int j = 1; j < 16; ++j) { f32x4 a, bq; ldu8(UROW(t0 - j), a, bq); if (j < w) { ra += a; rb += bq; } }
#pragma unroll 8
        for (int r = 0; r < 16; ++r) {
            f32x4 ca, cb, oa, ob; ldu8(UROW(t0 + r), ca, cb); ldu8(UROW(t0 + r - w + 1), oa, ob);
            ra += ca; rb += cb;
            const f32x4 da = ra * iw - ca, db = rb * iw - cb;
            v4u o; o.x = pk2(da.x, da.y); o.y = pk2(da.z, da.w); o.z = pk2(db.x, db.y); o.w = pk2(db.z, db.w);
            *((GAS v4u*)(DP + ((size_t)(lane >> 4) * MC + (b * SEQ + t0 + r)) * 128) + (lane & 15)) = o;
            ra -= oa; rb -= ob;
        }
#undef UROW
    }
    for (int db = gw; db < DBATCH; db += NGW) {
        const float* sp = F.state_pool + (size_t)db * 15 * PW + 8 * lane; const bf16* base = PB + (size_t)(MP + db * DSEQ) * PFW + col;
#define ULOAD(s, A, B) do { if ((s) >= 0) ldu8(base + (size_t)(s) * PFW, A, B); else { const float* p_ = sp + (size_t)(15 + (s)) * PW; A = *(const GAS f32x4*)p_; B = *(const GAS f32x4*)(p_ + 4); } } while (0)
        f32x4 ra = (f32x4){0.f, 0.f, 0.f, 0.f}, rb = ra;
#pragma unroll 5
        for (int j = 1; j < 16; ++j) { f32x4 a, bq; ULOAD(-j, a, bq); if (j < w) { ra += a; rb += bq; } }
#pragma unroll
        for (int r = 0; r < DSEQ; ++r) {
            f32x4 ca, cb, oa, ob; ULOAD(r, ca, cb); ULOAD(r - w + 1, oa, ob);
            ra += ca; rb += cb;
            const f32x4 da = ra * iw - ca, dbv = rb * iw - cb;
            v4u o; o.x = pk2(da.x, da.y); o.y = pk2(da.z, da.w); o.z = pk2(dbv.x, dbv.y); o.w = pk2(dbv.z, dbv.w);
            *((GAS v4u*)(DP + ((size_t)(lane >> 4) * MC + (MP + db * DSEQ + r)) * 128) + (lane & 15)) = o;
            ra -= oa; rb -= ob;
        }
#undef ULOAD
    }
    const int gt = F.vcu * NWAVES * 64 + F.tid, NGT = F.G * NWAVES * 64;
    for (int e = gt; e < NBATCH * 15 * (PW / 4); e += NGT) { const int c4 = e & 127, j = (e >> 7) % 15, b = e / (128 * 15);
        const v2u v = *((const GAS v2u*)(PB + (size_t)(b * SEQ + SEQ - 15 + j) * PFW + 256) + c4);
        *((GAS f32x4*)(F.out + O_PSP) + e) = (f32x4){bflo(v.x), bfhi(v.x), bflo(v.y), bfhi(v.y)}; }
    for (int e = gt; e < DBATCH * 15 * (PW / 4); e += NGT) { const int c4 = e & 127, j = (e >> 7) % 15, db = e / (128 * 15);
        f32x4 v;
        if (j < 7) v = *((const GAS f32x4*)(F.state_pool + (size_t)(db * 15 + 8 + j) * PW) + c4);
        else { const v2u q = *((const GAS v2u*)(PB + (size_t)(MP + db * DSEQ + j - 7) * PFW + 256) + c4); v = (f32x4){bflo(q.x), bfhi(q.x), bflo(q.y), bfhi(q.y)}; }
        *((GAS f32x4*)(F.out + O_PSS) + e) = v; }
}
using pg8::Unit;
__device__ __forceinline__ float sigmoidf_fast(float x) { return __builtin_amdgcn_rcpf(1.0f + __builtin_amdgcn_exp2f(-1.4426950408889634f * x)); }

struct EpiInProj {
    static constexpr bool PERM = true, AFTER_DRAIN = false;
    float* PF; bf16* GATE; bf16* PB;
    __device__ __forceinline__ void operator()(const f32x4 (&acc)[2][2][4][2], const Unit& u, int wr, int wc, int fr, int fq) const {
        const int row0 = u.pm * 256 + wr * 64 + fr, cw = wc * 32 + 8 * fq;
        if (u.pn < 5) {
#pragma unroll
            for (int ai = 0; ai < 2; ++ai)
#pragma unroll
                for (int m = 0; m < 4; ++m) { bf16* rowp = PB + (size_t)(row0 + ai * 128 + m * 16) * PFW + u.pn * 256 + cw;
#pragma unroll
                    for (int bj = 0; bj < 2; ++bj) { const f32x4 v0 = acc[ai][bj][m][0], v1 = acc[ai][bj][m][1]; v4u w;
                        w.x = pk2(v0[0], v0[1]); w.y = pk2(v0[2], v0[3]); w.z = pk2(v1[0], v1[1]); w.w = pk2(v1[2], v1[3]);
                        *(GAS v4u*)(rowp + bj * 128) = w; } }
        } else {
#pragma unroll
            for (int ai = 0; ai < 2; ++ai)
#pragma unroll
                for (int m = 0; m < 4; ++m) { bf16* rowp = GATE + (size_t)(row0 + ai * 128 + m * 16) * 2048 + (u.pn - 5) * 256 + cw;
#pragma unroll
                    for (int bj = 0; bj < 2; ++bj) { const f32x4 v0 = acc[ai][bj][m][0], v1 = acc[ai][bj][m][1]; v4u w;
                        w.x = pk2(sigmoidf_fast(v0[0]), sigmoidf_fast(v0[1])); w.y = pk2(sigmoidf_fast(v0[2]), sigmoidf_fast(v0[3]));
                        w.z = pk2(sigmoidf_fast(v1[0]), sigmoidf_fast(v1[1])); w.w = pk2(sigmoidf_fast(v1[2]), sigmoidf_fast(v1[3]));
                        *(GAS v4u*)(rowp + bj * 128) = w; } }
        }
    }
};
struct EpiInProjScalar {
    static constexpr bool PERM = true, AFTER_DRAIN = false;
    float* PF; bf16* GATE;
    __device__ __forceinline__ void operator()(const f32x4 (&acc)[2][2][4][2], const Unit& u, int wr, int wc, int fr, int fq) const {
        const int row0 = u.pm * 256 + wr * 64 + fr, cw = wc * 32 + 8 * fq;
#pragma unroll
        for (int ai = 0; ai < 2; ++ai)
#pragma unroll
            for (int m = 0; m < 4; ++m)
#pragma unroll
                for (int bj = 0; bj < 2; ++bj)
#pragma unroll
                    for (int n = 0; n < 2; ++n)
#pragma unroll
                        for (int e = 0; e < 4; ++e) { const size_t r = (size_t)(row0 + ai * 128 + m * 16); const int c = u.pn * 256 + bj * 128 + cw + 4 * n + e; const float v = acc[ai][bj][m][n][e];
                            if (c < PFW) PF[r * PFW + c] = v; else GATE[r * 2048 + (c - PFW)] = (bf16)f2bf(sigmoidf_fast(v)); }
    }
};
struct EpiPlainBf16 {
    static constexpr bool PERM = true, AFTER_DRAIN = false;
    bf16* O; int ldc;
    __device__ __forceinline__ void operator()(const f32x4 (&acc)[2][2][4][2], const Unit& u, int wr, int wc, int fr, int fq) const {
        const int row0 = u.pm * 256 + wr * 64 + fr, col0 = u.pn * 256 + wc * 32 + 8 * fq;
#pragma unroll
        for (int ai = 0; ai < 2; ++ai)
#pragma unroll
            for (int m = 0; m < 4; ++m) { bf16* rowp = O + (size_t)(row0 + ai * 128 + m * 16) * ldc + col0;
#pragma unroll
                for (int bj = 0; bj < 2; ++bj) { const f32x4 v0 = acc[ai][bj][m][0], v1 = acc[ai][bj][m][1]; v4u w;
                    w.x = pk2(v0[0], v0[1]); w.y = pk2(v0[2], v0[3]); w.z = pk2(v1[0], v1[1]); w.w = pk2(v1[2], v1[3]); *(GAS v4u*)(rowp + bj * 128) = w; } }
    }
};
struct EpiKV {
    static constexpr bool PERM = true, AFTER_DRAIN = false;
    bf16* KH; bf16* VH; const bf16* KRG; const float* KSS; const float* gkn;
    __device__ __forceinline__ void operator()(const f32x4 (&acc)[2][2][4][2], const Unit& u, int wr, int wc, int fr, int fq) const {
        const int row0 = u.pm * 256 + wr * 64 + fr, roff = NMETA * ((u.pm >> 3) + 1);
        if (u.pn < 2) {
            const int head = u.pn * 4 + wc;
            f32x4 g[2][2];
#pragma unroll
            for (int bj = 0; bj < 2; ++bj)
#pragma unroll
                for (int n = 0; n < 2; ++n) g[bj][n] = *(const GAS f32x4*)(gkn + 32 * bj + 8 * fq + 4 * n);
            float kss[2][4]; v4u krv[2][4];
#pragma unroll
            for (int ai = 0; ai < 2; ++ai)
#pragma unroll
                for (int m = 0; m < 4; ++m) { const size_t R = (size_t)(row0 + ai * 128 + m * 16 + roff); const float* ps_ = KSS + R; const bf16* pk_ = KRG + R * 32 + 8 * fq;
                    asm volatile("global_load_dword %0, %1, off" : "=v"(kss[ai][m]) : "v"(ps_)); asm volatile("global_load_dwordx4 %0, %1, off" : "=v"(krv[ai][m]) : "v"(pk_)); }
            asm volatile("s_waitcnt vmcnt(0)" : "+v"(kss[0][0]), "+v"(kss[0][1]), "+v"(kss[0][2]), "+v"(kss[0][3]), "+v"(kss[1][0]), "+v"(kss[1][1]), "+v"(kss[1][2]), "+v"(kss[1][3]),
                                                "+v"(krv[0][0]), "+v"(krv[0][1]), "+v"(krv[0][2]), "+v"(krv[0][3]), "+v"(krv[1][0]), "+v"(krv[1][1]), "+v"(krv[1][2]), "+v"(krv[1][3]));
#pragma unroll
            for (int ai = 0; ai < 2; ++ai)
#pragma unroll
                for (int m = 0; m < 4; ++m) { const size_t R = (size_t)(row0 + ai * 128 + m * 16 + roff);
                    float ss = 0.f;
#pragma unroll
                    for (int bj = 0; bj < 2; ++bj)
#pragma unroll
                        for (int n = 0; n < 2; ++n) { const f32x4 v = acc[ai][bj][m][n]; ss += (v[0] * v[0] + v[1] * v[1]) + (v[2] * v[2] + v[3] * v[3]); }
                    ss = sum_x32(sum_x16(ss));
                    const float rstd = frsqrt((ss + kss[ai][m]) * (1.f / QKH) + EPS);
                    bf16* kp = KH + R * 768 + head * QKH;
#pragma unroll
                    for (int bj = 0; bj < 2; ++bj) { const f32x4 v0 = acc[ai][bj][m][0] * g[bj][0] * rstd, v1 = acc[ai][bj][m][1] * g[bj][1] * rstd; v4u w;
                        w.x = pk2(v0[0], v0[1]); w.y = pk2(v0[2], v0[3]); w.z = pk2(v1[0], v1[1]); w.w = pk2(v1[2], v1[3]); *(GAS v4u*)(kp + 32 * bj + 8 * fq) = w; }
                    const v4u kr = krv[ai][m]; v4u w;
                    w.x = pk2(bflo(kr.x) * rstd, bfhi(kr.x) * rstd); w.y = pk2(bflo(kr.y) * rstd, bfhi(kr.y) * rstd); w.z = pk2(bflo(kr.z) * rstd, bfhi(kr.z) * rstd); w.w = pk2(bflo(kr.w) * rstd, bfhi(kr.w) * rstd);
                    *(GAS v4u*)(kp + 64 + 8 * fq) = w; }
        } else {
            const int col0 = (u.pn - 2) * 256 + wc * 32 + 8 * fq;
#pragma unroll
            for (int ai = 0; ai < 2; ++ai)
#pragma unroll
                for (int m = 0; m < 4; ++m) { bf16* rowp = VH + (size_t)(row0 + ai * 128 + m * 16 + roff) * 1024 + col0;
#pragma unroll
                    for (int bj = 0; bj < 2; ++bj) { const f32x4 v0 = acc[ai][bj][m][0], v1 = acc[ai][bj][m][1]; v4u w;
                        w.x = pk2(v0[0], v0[1]); w.y = pk2(v0[2], v0[3]); w.z = pk2(v1[0], v1[1]); w.w = pk2(v1[2], v1[3]); *(GAS v4u*)(rowp + bj * 128) = w; } }
        }
    }
};
struct PoolOrder {
    int G, c;
    __device__ __forceinline__ bool next(int i, Unit& u) const { const int L = i * G + c; if (L >= 4 * (MC / 256)) return false; const int pn = L & 3, pm = L >> 2; u.pm = pn * (MC / 256) + pm; u.pn = pn; return true; }
    __device__ __forceinline__ void a_ready(const Unit&) const {}
    __device__ __forceinline__ void done(const Unit&) const {}
};
struct EpiPool {
    static constexpr bool PERM = true, AFTER_DRAIN = false;
    bf16* PG; const bf16* GATE; const float* pscale;
    __device__ __forceinline__ void operator()(const f32x4 (&acc)[2][2][4][2], const Unit& u, int wr, int wc, int fr, int fq) const {
        const int row0 = (u.pm - u.pn * (MC / 256)) * 256 + wr * 64 + fr, col0 = u.pn * 256 + wc * 32 + 8 * fq;
        f32x4 ps[2][2];
#pragma unroll
        for (int bj = 0; bj < 2; ++bj)
#pragma unroll
            for (int n = 0; n < 2; ++n) ps[bj][n] = *(const GAS f32x4*)(pscale + col0 + bj * 128 + 4 * n);
        v4u gt[2][4][2];
#pragma unroll
        for (int ai = 0; ai < 2; ++ai)
#pragma unroll
            for (int m = 0; m < 4; ++m) { const bf16* p = GATE + (size_t)(row0 + ai * 128 + m * 16) * 2048 + col0;
                asm volatile("global_load_dwordx4 %0, %1, off" : "=v"(gt[ai][m][0]) : "v"(p));
                asm volatile("global_load_dwordx4 %0, %1, off offset:256" : "=v"(gt[ai][m][1]) : "v"(p)); }
        asm volatile("s_waitcnt vmcnt(0)" : "+v"(gt[0][0][0]), "+v"(gt[0][0][1]), "+v"(gt[0][1][0]), "+v"(gt[0][1][1]), "+v"(gt[0][2][0]), "+v"(gt[0][2][1]), "+v"(gt[0][3][0]), "+v"(gt[0][3][1]),
                                            "+v"(gt[1][0][0]), "+v"(gt[1][0][1]), "+v"(gt[1][1][0]), "+v"(gt[1][1][1]), "+v"(gt[1][2][0]), "+v"(gt[1][2][1]), "+v"(gt[1][3][0]), "+v"(gt[1][3][1]));
#pragma unroll
        for (int ai = 0; ai < 2; ++ai)
#pragma unroll
            for (int m = 0; m < 4; ++m) { const size_t r = (size_t)(row0 + ai * 128 + m * 16);
#pragma unroll
                for (int bj = 0; bj < 2; ++bj) { const v4u g = gt[ai][m][bj];
                    const f32x4 v0 = acc[ai][bj][m][0] * ps[bj][0], v1 = acc[ai][bj][m][1] * ps[bj][1]; v4u w;
                    w.x = pk2(v0[0] * bflo(g.x), v0[1] * bfhi(g.x)); w.y = pk2(v0[2] * bflo(g.y), v0[3] * bfhi(g.y)); w.z = pk2(v1[0] * bflo(g.z), v1[1] * bfhi(g.z)); w.w = pk2(v1[2] * bflo(g.w), v1[3] * bfhi(g.w));
                    *(GAS v4u*)(PG + r * DM + col0 + bj * 128) = w; } }
    }
};
struct EpiResF32 {
    static constexpr bool PERM = true, AFTER_DRAIN = false;
    float* C; const float* R0; const float* R1; int split_pm;
    __device__ __forceinline__ void operator()(const f32x4 (&acc)[2][2][4][2], const Unit& u, int wr, int wc, int fr, int fq) const {
        const int row0 = u.pm * 256 + wr * 64 + fr, col0 = u.pn * 256 + wc * 32 + 8 * fq;
        const float* rb = u.pm < split_pm ? R0 : R1 - (size_t)split_pm * 256 * DM;
#pragma unroll
        for (int ai = 0; ai < 2; ++ai)
#pragma unroll
            for (int m = 0; m < 4; ++m) { const size_t o = (size_t)(row0 + ai * 128 + m * 16) * DM + col0;
#pragma unroll
                for (int bj = 0; bj < 2; ++bj) { const f32x4 r0 = *(const GAS f32x4*)(rb + o + bj * 128), r1 = *(const GAS f32x4*)(rb + o + bj * 128 + 4);
                    *(GAS f32x4*)(C + o + bj * 128) = acc[ai][bj][m][0] + r0; *(GAS f32x4*)(C + o + bj * 128 + 4) = acc[ai][bj][m][1] + r1; } }
    }
};
struct EpiResToBf16 {
    static constexpr bool PERM = true, AFTER_DRAIN = false;
    bf16* C; const float* R;
    __device__ __forceinline__ void operator()(const f32x4 (&acc)[2][2][4][2], const Unit& u, int wr, int wc, int fr, int fq) const {
        const int row0 = u.pm * 256 + wr * 64 + fr, col0 = u.pn * 256 + wc * 32 + 8 * fq;
#pragma unroll
        for (int ai = 0; ai < 2; ++ai) {
            f32x4 r[4][4];
#pragma unroll
            for (int m = 0; m < 4; ++m) { const float* p = R + (size_t)(row0 + ai * 128 + m * 16) * DM + col0;
                asm volatile("global_load_dwordx4 %0, %1, off nt" : "=v"(r[m][0]) : "v"(p));
                asm volatile("global_load_dwordx4 %0, %1, off offset:16 nt" : "=v"(r[m][1]) : "v"(p));
                asm volatile("global_load_dwordx4 %0, %1, off offset:512 nt" : "=v"(r[m][2]) : "v"(p));
                asm volatile("global_load_dwordx4 %0, %1, off offset:528 nt" : "=v"(r[m][3]) : "v"(p)); }
            asm volatile("s_waitcnt vmcnt(0)" : "+v"(r[0][0]), "+v"(r[0][1]), "+v"(r[0][2]), "+v"(r[0][3]), "+v"(r[1][0]), "+v"(r[1][1]), "+v"(r[1][2]), "+v"(r[1][3]),
                                                "+v"(r[2][0]), "+v"(r[2][1]), "+v"(r[2][2]), "+v"(r[2][3]), "+v"(r[3][0]), "+v"(r[3][1]), "+v"(r[3][2]), "+v"(r[3][3]));
#pragma unroll
            for (int m = 0; m < 4; ++m) { const size_t o = (size_t)(row0 + ai * 128 + m * 16) * DM + col0;
#pragma unroll
                for (int bj = 0; bj < 2; ++bj) { const f32x4 a = acc[ai][bj][m][0] + r[m][2 * bj], b = acc[ai][bj][m][1] + r[m][2 * bj + 1]; v4u w;
                    w.x = pk2(a[0], a[1]); w.y = pk2(a[2], a[3]); w.z = pk2(b[0], b[1]); w.w = pk2(b[2], b[3]);
                    *(GAS v4u*)(C + o + bj * 128) = w; } }
        }
    }
};
struct EpiResFromBf16 {
    static constexpr bool PERM = true, AFTER_DRAIN = false;
    float* C; const bf16* R;
    __device__ __forceinline__ void operator()(const f32x4 (&acc)[2][2][4][2], const Unit& u, int wr, int wc, int fr, int fq) const {
        const int row0 = u.pm * 256 + wr * 64 + fr, col0 = u.pn * 256 + wc * 32 + 8 * fq;
        v4u r[2][4][2];
#pragma unroll
        for (int ai = 0; ai < 2; ++ai)
#pragma unroll
            for (int m = 0; m < 4; ++m) { const bf16* p = R + (size_t)(row0 + ai * 128 + m * 16) * DM + col0;
                asm volatile("global_load_dwordx4 %0, %1, off" : "=v"(r[ai][m][0]) : "v"(p));
                asm volatile("global_load_dwordx4 %0, %1, off offset:256" : "=v"(r[ai][m][1]) : "v"(p)); }
        asm volatile("s_waitcnt vmcnt(0)" : "+v"(r[0][0][0]), "+v"(r[0][0][1]), "+v"(r[0][1][0]), "+v"(r[0][1][1]), "+v"(r[0][2][0]), "+v"(r[0][2][1]), "+v"(r[0][3][0]), "+v"(r[0][3][1]),
                                            "+v"(r[1][0][0]), "+v"(r[1][0][1]), "+v"(r[1][1][0]), "+v"(r[1][1][1]), "+v"(r[1][2][0]), "+v"(r[1][2][1]), "+v"(r[1][3][0]), "+v"(r[1][3][1]));
#pragma unroll
        for (int ai = 0; ai < 2; ++ai)
#pragma unroll
            for (int m = 0; m < 4; ++m) { const size_t o = (size_t)(row0 + ai * 128 + m * 16) * DM + col0;
#pragma unroll
                for (int bj = 0; bj < 2; ++bj) { const v4u t = r[ai][m][bj];
                    *(GAS f32x4*)(C + o + bj * 128) = acc[ai][bj][m][0] + (f32x4){bflo(t.x), bfhi(t.x), bflo(t.y), bfhi(t.y)};
                    *(GAS f32x4*)(C + o + bj * 128 + 4) = acc[ai][bj][m][1] + (f32x4){bflo(t.z), bfhi(t.z), bflo(t.w), bfhi(t.w)}; } }
    }
};
struct SliceOrder {
    int NS, G, c;
    __device__ __forceinline__ bool next(int i, Unit& u) const { const int L = i * G + c; if (L >= NS * 16) return false; const int s = L >> 4; u.pm = 4 * s + ((L >> 2) & 3); u.pn = 4 * s + (L & 3); return true; }
    __device__ __forceinline__ void a_ready(const Unit&) const {}
    __device__ __forceinline__ void done(const Unit&) const {}
};
struct EpiSlab {
    static constexpr bool PERM = true, AFTER_DRAIN = false;
    float* S;
    __device__ __forceinline__ void operator()(const f32x4 (&acc)[2][2][4][2], const Unit& u, int wr, int wc, int fr, int fq) const {
        const int row0 = (u.pm & 3) * 256 + wr * 64 + fr, col0 = (u.pn & 3) * 256 + wc * 32 + 8 * fq; float* base = S + (size_t)(u.pm >> 2) * MS * DM;
#pragma unroll
        for (int ai = 0; ai < 2; ++ai)
#pragma unroll
            for (int m = 0; m < 4; ++m) { const size_t o = (size_t)(row0 + ai * 128 + m * 16) * DM + col0;
#pragma unroll
                for (int bj = 0; bj < 2; ++bj) { *(GAS f32x4*)(base + o + bj * 128) = acc[ai][bj][m][0]; *(GAS f32x4*)(base + o + bj * 128 + 4) = acc[ai][bj][m][1]; } }
    }
};
struct EpiRelu2 {
    static constexpr bool PERM = true, AFTER_DRAIN = false;
    bf16* Z; bf16* ZS;
    __device__ __forceinline__ void operator()(const f32x4 (&acc)[2][2][4][2], const Unit& u, int wr, int wc, int fr, int fq) const {
        const int row0 = u.pm * 256 + wr * 64 + fr, col0 = u.pn * 256 + wc * 32 + 8 * fq;
        const bool smp = u.pm >= MP / 256;
        bf16* zb = smp ? ZS + ((size_t)(col0 >> 9) * MS - MP) * 512 + (col0 & 511) : Z + col0; const int zp = smp ? 512 : DFF;
#pragma unroll
        for (int ai = 0; ai < 2; ++ai)
#pragma unroll
            for (int m = 0; m < 4; ++m) { bf16* rowp = zb + (size_t)(row0 + ai * 128 + m * 16) * zp;
#pragma unroll
                for (int bj = 0; bj < 2; ++bj) { f32x4 v0 = acc[ai][bj][m][0], v1 = acc[ai][bj][m][1];
#pragma unroll
                    for (int j = 0; j < 4; ++j) { const float a = fmaxf(v0[j], 0.f), b = fmaxf(v1[j], 0.f); v0[j] = a * a; v1[j] = b * b; }
                    v4u w; w.x = pk2(v0[0], v0[1]); w.y = pk2(v0[2], v0[3]); w.z = pk2(v1[0], v1[1]); w.w = pk2(v1[2], v1[3]); *(GAS v4u*)(rowp + bj * 128) = w; } }
    }
};
namespace pa {
constexpr int SHM = 16384;
#define PA_KSWZ(row, colB) ((row) * 256 + ((colB) ^ (((row) & 7) << 4)))
__device__ __forceinline__ int v_st(int k, int c) { const int kk = (k & ~0xC) | ((k & 4) << 1) | ((k & 8) >> 1); return ((kk >> 3) * 4 + (c >> 5)) * 512 + ((kk & 7) * 32 + (c & 31)) * 2; }
__device__ __forceinline__ int v_rd_base(int lane) { return ((lane & 3) << 3) | (((lane >> 2) & 3) << 6) | (((lane >> 4) & 1) << 5) | (((lane >> 5) & 1) << 8); }
constexpr int v_rd_off(int d0, int ks, int half) { return d0 * 512 + ks * 4096 + half * 2048; }
__device__ __forceinline__ int crow(int r, int hi) { return (r & 3) + 8 * (r >> 2) + 4 * hi; }

template <int KB>
__device__ __forceinline__ void qkt(f32x16& p0, f32x16& p1, const char* K_lds, int r32, int hi, const bf16x8* qr) {
    p0 = f32x16{}; p1 = f32x16{};
    const char* kb[4];
#pragma unroll
    for (int dd = 0; dd < 4; ++dd) kb[dd] = K_lds + KB * SHM + PA_KSWZ(r32, (dd * 16 + hi * 8) * 2);
#pragma unroll
    for (int d0 = 0; d0 < 6; ++d0) { const char* a = kb[d0 & 3] + (d0 >> 2) * 128;
        const bf16x8 b0 = *reinterpret_cast<const bf16x8*>(a);
        const bf16x8 b1 = *reinterpret_cast<const bf16x8*>(a + 32 * 256);
        p0 = __builtin_amdgcn_mfma_f32_32x32x16_bf16(b0, qr[d0], p0, 0, 0, 0);
        p1 = __builtin_amdgcn_mfma_f32_32x32x16_bf16(b1, qr[d0], p1, 0, 0, 0); }
}
template <int VB>
__device__ __forceinline__ void pv_tile(f32x16* o, int vb0, bf16x8 pa0, bf16x8 pa1, bf16x8 pa2, bf16x8 pa3) {
#define TRRD(dst, off) asm volatile("ds_read_b64_tr_b16 %0, %1 offset:%2" : "=&v"(dst) : "v"(vb0), "i"(off) : "memory")
#define PV_D0(d0) do { s16x4 l0, l1, l2, l3, h0, h1, h2, h3; constexpr int b_ = VB * SHM + v_rd_off(d0, 0, 0); \
        TRRD(l0, b_); TRRD(h0, b_ + 2048); TRRD(l1, b_ + 4096); TRRD(h1, b_ + 6144); TRRD(l2, b_ + 8192); TRRD(h2, b_ + 10240); TRRD(l3, b_ + 12288); TRRD(h3, b_ + 14336); \
        asm volatile("s_waitcnt lgkmcnt(0)" ::: "memory"); SBAR(); \
        o[d0] = __builtin_amdgcn_mfma_f32_32x32x16_bf16(pa0, (bf16x8){l0[0], l0[1], l0[2], l0[3], h0[0], h0[1], h0[2], h0[3]}, o[d0], 0, 0, 0); \
        o[d0] = __builtin_amdgcn_mfma_f32_32x32x16_bf16(pa1, (bf16x8){l1[0], l1[1], l1[2], l1[3], h1[0], h1[1], h1[2], h1[3]}, o[d0], 0, 0, 0); \
        o[d0] = __builtin_amdgcn_mfma_f32_32x32x16_bf16(pa2, (bf16x8){l2[0], l2[1], l2[2], l2[3], h2[0], h2[1], h2[2], h2[3]}, o[d0], 0, 0, 0); \
        o[d0] = __builtin_amdgcn_mfma_f32_32x32x16_bf16(pa3, (bf16x8){l3[0], l3[1], l3[2], l3[3], h3[0], h3[1], h3[2], h3[3]}, o[d0], 0, 0, 0); } while (0)
    PV_D0(0); PV_D0(1); PV_D0(2); PV_D0(3);
#undef PV_D0
#undef TRRD
}
__device__ __forceinline__ void mask_tile(f32x16& p0, f32x16& p1, int dq) {
    const float NEG = -__builtin_inff();
#pragma unroll
    for (int r = 0; r < 16; ++r) { const int c = (r & 3) + 8 * (r >> 2);
        if (dq - c < 0) p0[r] = NEG;
        if (dq - c - 32 < 0) p1[r] = NEG; }
}
__device__ __forceinline__ void exp_half(f32x16& p, float b2) {
#pragma unroll
    for (int r = 0; r < 16; ++r) p[r] = __builtin_amdgcn_exp2f(p[r] - b2);
}
__device__ __forceinline__ void finish(f32x16& p0, f32x16& p1, float b2, float& l_reg, bf16x8& pa0, bf16x8& pa1, bf16x8& pa2, bf16x8& pa3) {
    exp_half(p1, b2);
    float ps = 0.f;
#pragma unroll
    for (int r = 0; r < 16; ++r) ps += p0[r];
#pragma unroll
    for (int r = 0; r < 16; ++r) ps += p1[r];
    ps = sum_x32(ps);
    l_reg += ps;
#define PK4(P, B_, OUT) do { unsigned a0 = pk2(P[B_ + 0], P[B_ + 1]), a1 = pk2(P[B_ + 2], P[B_ + 3]); unsigned b0 = pk2(P[B_ + 4], P[B_ + 5]), b1 = pk2(P[B_ + 6], P[B_ + 7]); \
        auto r0 = __builtin_amdgcn_permlane32_swap(a0, b0, false, false); auto r1 = __builtin_amdgcn_permlane32_swap(a1, b1, false, false); \
        v4u w = {r0[0], r1[0], r0[1], r1[1]}; OUT = *reinterpret_cast<bf16x8*>(&w); } while (0)
    PK4(p0, 0, pa0); PK4(p0, 8, pa1); PK4(p1, 0, pa2); PK4(p1, 8, pa3);
#undef PK4
}
struct Ctx { const bf16* QR; const bf16* KH; const bf16* VH; const bf16* PG; const bf16* GATE; bf16* AM; const float* ROPE; const float* gqn; const float* gqr; float b2; };

__device__ __forceinline__ void unit(const Ctx& C, int b, int h, int j, char* lds, LAS unsigned char* F_lds) {
    int tid = threadIdx.x; asm volatile("" : "+v"(tid));
    const int wid = __builtin_amdgcn_readfirstlane(tid >> 6), lane = tid & 63, r32 = lane & 31, hi = lane >> 5;
    const int P0 = NMETA + 256 * j, NT = 4 * j + 5;
    const int m0 = b * SEQ + 256 * j;
    char* V_lds = lds; char* K_lds = lds + 3 * SHM; float* li_l = (float*)(lds + 5 * SHM) + wid * 64;
    const bf16* Kh = C.KH + (size_t)b * TT * 768 + h * QKH; const bf16* Vh = C.VH + (size_t)b * TT * 1024 + h * VHD;
    bf16x8 qr[6];
    { const int mrow = m0 + wid * 32 + r32, pos = P0 + wid * 32 + r32;
      const bf16* qp = C.QR + (size_t)mrow * 768 + h * QKH + hi * 8;
      float f[6][8]; float ss = 0.f;
#pragma unroll
      for (int d0 = 0; d0 < 6; ++d0) { const v4u q = *(const GAS v4u*)(qp + d0 * 16);
          f[d0][0] = bflo(q.x); f[d0][1] = bfhi(q.x); f[d0][2] = bflo(q.y); f[d0][3] = bfhi(q.y); f[d0][4] = bflo(q.z); f[d0][5] = bfhi(q.z); f[d0][6] = bflo(q.w); f[d0][7] = bfhi(q.w);
#pragma unroll
          for (int e = 0; e < 8; ++e) ss += f[d0][e] * f[d0][e]; }
      ss = sum_x32(ss);
      const float rs = frsqrt(ss * (1.f / QKH) + EPS) * SCALE_L2E;
      const float* rp = C.ROPE + (size_t)pos * 32 + hi * 8;
#pragma unroll
      for (int e = 0; e < 8; ++e) { const float cs = rp[e], sn = rp[16 + e], x1 = f[4][e], x2 = f[5][e], g = C.gqr[hi * 8 + e] * rs;
          f[4][e] = (x1 * cs - x2 * sn) * g; f[5][e] = (x2 * cs + x1 * sn) * g; }
#pragma unroll
      for (int d0 = 0; d0 < 4; ++d0)
#pragma unroll
          for (int e = 0; e < 8; ++e) f[d0][e] *= C.gqn[d0 * 16 + hi * 8 + e] * rs;
#pragma unroll
      for (int d0 = 0; d0 < 6; ++d0) { v4u w; w.x = pk2(f[d0][0], f[d0][1]); w.y = pk2(f[d0][2], f[d0][3]); w.z = pk2(f[d0][4], f[d0][5]); w.w = pk2(f[d0][6], f[d0][7]); qr[d0] = *reinterpret_cast<bf16x8*>(&w); }
    }
    const int sr = tid >> 4, sc = (tid & 15) * 8, vst0 = v_st(sr, sc), vst1 = v_st(32 + sr, sc), kws = PA_KSWZ(sr, sc * 2);
    const int vb0 = (int)(uintptr_t)V_lds + v_rd_base(lane);
    const int qpos = P0 + wid * 32 + r32 - 4 * hi, qlo = P0 + wid * 32;
    const float b2 = C.b2;
    bf16x8 st_v0, st_v1, st_k0, st_k1;
    const unsigned kvo = (unsigned)(sr * 768 + sc) * 2u, vvo = (unsigned)(sr * 1024 + sc) * 2u;
#define SLOAD(k0) do { const char* kt_ = (const char*)Kh + (size_t)(k0) * 1536; const char* vt_ = (const char*)Vh + (size_t)(k0) * 2048; \
        st_v0 = *(const GAS bf16x8*)(vt_ + vvo); st_v1 = *(const GAS bf16x8*)(vt_ + 65536 + vvo); st_k0 = *(const GAS bf16x8*)(kt_ + kvo); st_k1 = *(const GAS bf16x8*)(kt_ + 49152 + kvo); } while (0)
#define SWRITE(kbf, voff) do { *(bf16x8*)(V_lds + (voff) + vst0) = st_v0; *(bf16x8*)(V_lds + (voff) + vst1) = st_v1; *(bf16x8*)(K_lds + (kbf) * SHM + kws) = st_k0; *(bf16x8*)(K_lds + (kbf) * SHM + kws + 32 * 256) = st_k1; } while (0)
#define MASKT(PX0, PX1, t) do { const int kb_ = (t) * 64; if (kb_ + 63 > qlo) mask_tile(PX0, PX1, qpos - kb_); } while (0)
    float l_reg = 0.f; f32x16 o[4] = {};
    f32x16 pA0, pA1, pB0, pB1; bf16x8 pa0, pa1, pa2, pa3;
    SLOAD(0); VM_WAIT(); SWRITE(0, 0); SBAR();
    SLOAD(64);
    __syncthreads();
    SBAR(); qkt<0>(pA0, pA1, K_lds, r32, hi, qr);
    MASKT(pA0, pA1, 0); exp_half(pA0, b2);
    VM_WAIT(); SWRITE(1, SHM);
    __syncthreads();
    int vr = 0;
#define HALF_STEP(PX0, PX1, PY0, PY1, t, KB, SB) do { \
        if ((t) + 1 < NT) { SLOAD(((t) + 1) * 64); }   \
        SBAR(); qkt<KB>(PX0, PX1, K_lds, r32, hi, qr); \
        finish(PY0, PY1, b2, l_reg, pa0, pa1, pa2, pa3); SBAR(); \
        pv_tile<0>(o, vb0 + vr, pa0, pa1, pa2, pa3); MASKT(PX0, PX1, (t)); exp_half(PX0, b2); \
        { const int vw = (vr >= SHM) ? vr - SHM : vr + 2 * SHM;                  \
          if ((t) + 1 < NT) { VM_WAIT(); SWRITE(SB, vw); } } \
        vr = (vr == 2 * SHM) ? 0 : vr + SHM; \
        __syncthreads(); } while (0)
    for (int t = 1; t + 1 < NT; t += 2) {
        HALF_STEP(pB0, pB1, pA0, pA1, t, 1, 0);
        HALF_STEP(pA0, pA1, pB0, pB1, t + 1, 0, 1);
    }
    finish(pA0, pA1, b2, l_reg, pa0, pa1, pa2, pa3); SBAR();
    pv_tile<0>(o, vb0 + vr, pa0, pa1, pa2, pa3);
    if (hi == 0) li_l[r32] = l_reg;
    asm volatile("s_waitcnt lgkmcnt(0)" ::: "memory");
    float rli[16];
#pragma unroll
    for (int r = 0; r < 16; ++r) rli[r] = __builtin_amdgcn_rcpf(li_l[crow(r, hi)]);
    __syncthreads();
    {
        LAS float* ot = (LAS float*)F_lds + wid * (32 * 132);
#pragma unroll
        for (int r = 0; r < 16; ++r)
#pragma unroll
            for (int d0 = 0; d0 < 4; ++d0) ot[crow(r, hi) * 132 + d0 * 32 + r32] = o[d0][r] * rli[r];
        asm volatile("s_waitcnt lgkmcnt(0)" ::: "memory");
        const int row = lane & 31, hf = lane >> 5; const size_t mrow = (size_t)(m0 + wid * 32 + row); const int col0 = h * VHD + hf * 64;
        const GAS v4u* gp = (const GAS v4u*)(C.GATE + mrow * 2048 + DM + col0); const GAS v4u* pp = (const GAS v4u*)(C.PG + mrow * DM + col0); GAS v4u* ap = (GAS v4u*)(C.AM + mrow * DM + col0);
        const LAS f32x4* orow = (const LAS f32x4*)(ot + row * 132 + hf * 64);
#pragma unroll
        for (int c = 0; c < 8; ++c) { const v4u g = gp[c], q = pp[c]; const f32x4 a = orow[2 * c], b = orow[2 * c + 1]; v4u w;
            w.x = pk2(bflo(q.x) + bflo(g.x) * a.x, bfhi(q.x) + bfhi(g.x) * a.y); w.y = pk2(bflo(q.y) + bflo(g.y) * a.z, bfhi(q.y) + bfhi(g.y) * a.w);
            w.z = pk2(bflo(q.z) + bflo(g.z) * b.x, bfhi(q.z) + bfhi(g.z) * b.y); w.w = pk2(bflo(q.w) + bflo(g.w) * b.z, bfhi(q.w) + bfhi(g.w) * b.w);
            ap[c] = w; }
    }
    __syncthreads();
#undef HALF_STEP
#undef MASKT
#undef SWRITE
#undef SLOAD
}
}
namespace sa {
constexpr int TK = 32, CT_HALF = 8192, CT_BYTES = 16384, KRT_PITCH = 80, KRT_BYTES = TK * KRT_PITCH, PL_PITCH = 96, PL_BYTES = 72 * PL_PITCH  , LZ_BYTES = 32768 + 4096;
constexpr int OFF_CT = 0, OFF_LZ = 3 * CT_BYTES, OFF_KRT = OFF_LZ + 2 * LZ_BYTES, OFF_KSS = OFF_KRT + 3 * KRT_BYTES, OFF_PL = OFF_KSS + 3 * 128, OFF_PT = OFF_PL + 2 * PL_BYTES,
              OFF_QF = OFF_PT + 256, OFF_END = OFF_QF + 8 * 1536;
#ifndef SMALL_LDS
static_assert(OFF_END <= RING_BYTES, "sample attention LDS");
#endif
__device__ __forceinline__ unsigned off_b(unsigned row, unsigned ch) { return 256u * row + 16u * (ch ^ (((row & 3) << 2) | ((0u - (row >> 2)) & 3))); }
typedef float f32x4_t __attribute__((ext_vector_type(4)));
struct Ctx { const float* cache_c; const float* cache_kr; const int* page_table; const float* new_c; const float* new_kr; const bf16* QR; const bf16* Wuk_t; const float* ROPE;
             const float *gqn, *gqr, *gkn, *gkr; float* SAC; float* SAL; float b2; };

typedef short v4i16_t __attribute__((ext_vector_type(4)));
__device__ __forceinline__ s16x4 tr_read(unsigned addr) { return __builtin_bit_cast(s16x4, __builtin_amdgcn_ds_read_tr16_b64_v4i16((__attribute__((address_space(3))) v4i16_t*)(uintptr_t)addr)); }

__device__ __forceinline__ void item(const Ctx& C, int db, int hf, LAS unsigned char* lds) {
    int tid = threadIdx.x; asm volatile("" : "+v"(tid));
    const int wid = __builtin_amdgcn_readfirstlane(tid >> 6), lane = tid & 63, fr = lane & 15, fq = lane >> 4;
    const int h = wid;
    volatile LAS int* pt = (volatile LAS int*)(lds + OFF_PT);
    { const int* ptg = C.page_table + db * NPAGES + hf * 32; asm volatile("" : "+s"(ptg)); if (tid < 32) pt[tid] = ptg[tid]; }
    {
        bf16x8 Aq0, Aq1, Aqr;
        const int s = fr & 7; const int mrow = MP + db * DSEQ + s;
        const bf16* qrb = C.QR; asm volatile("" : "+s"(qrb));
        const bf16* qp = qrb + (size_t)mrow * 768 + h * QKH;
        float qn[2][8], qro[8], ss = 0.f;
#pragma unroll
        for (int ii = 0; ii < 2; ++ii)
#pragma unroll
            for (int j = 0; j < 8; ++j) { const int d = 16 * (2 * ii + (j >> 2)) + 4 * fq + (j & 3); const float v = bflo((unsigned)qp[d]); qn[ii][j] = v; ss += v * v; }
        const float* rp = C.ROPE + (size_t)(TT + s) * 32;
#pragma unroll
        for (int j = 0; j < 8; ++j) { const int i = 8 * fq + j, i2 = i & 15; const float own = bflo((unsigned)qp[64 + i]), oth = bflo((unsigned)qp[64 + (i ^ 16)]);
            ss += own * own;
            const float cs = rp[i2], sn = rp[16 + i2];
            qro[j] = (i < 16) ? own * cs - oth * sn : own * cs + oth * sn; }
        ss = sum_x32(sum_x16(ss));
        const float rs = (fr < 8) ? frsqrt(ss * (1.f / QKH) + EPS) * SCALE_L2E : 0.f;
#pragma unroll
        for (int ii = 0; ii < 2; ++ii)
#pragma unroll
            for (int j = 0; j < 8; ++j) { const int d = 16 * (2 * ii + (j >> 2)) + 4 * fq + (j & 3); qn[ii][j] *= rs * C.gqn[d] * C.gkn[d]; }
#pragma unroll
        for (int j = 0; j < 8; ++j) { const int i2 = (8 * fq + j) & 15; qro[j] *= rs * C.gqr[i2] * C.gkr[i2]; }
        v4u w; w.x = pk2(qn[0][0], qn[0][1]); w.y = pk2(qn[0][2], qn[0][3]); w.z = pk2(qn[0][4], qn[0][5]); w.w = pk2(qn[0][6], qn[0][7]); Aq0 = *reinterpret_cast<bf16x8*>(&w);
        w.x = pk2(qn[1][0], qn[1][1]); w.y = pk2(qn[1][2], qn[1][3]); w.z = pk2(qn[1][4], qn[1][5]); w.w = pk2(qn[1][6], qn[1][7]); Aq1 = *reinterpret_cast<bf16x8*>(&w);
        w.x = pk2(qro[0], qro[1]); w.y = pk2(qro[2], qro[3]); w.z = pk2(qro[4], qro[5]); w.w = pk2(qro[6], qro[7]); Aqr = *reinterpret_cast<bf16x8*>(&w);
        if (fr < 8) { LAS bf16x8* qf = (LAS bf16x8*)(lds + OFF_QF + wid * 1536) + fq * 8 + fr; qf[0] = Aq0; qf[32] = Aq1; qf[64] = Aqr; }
    }
    __syncthreads();
    bf16x8 Wf[4][8];
    { const bf16* wp = C.Wuk_t + (size_t)(h * 64 + fr) * KVL + 8 * fq;
#pragma unroll
      for (int i = 0; i < 4; ++i)
#pragma unroll
          for (int ks = 0; ks < 8; ++ks) Wf[i][ks] = *(const GAS bf16x8*)(wp + (size_t)(16 * i) * KVL + 32 * ks);
#pragma unroll
      for (int i = 0; i < 4; ++i)
#pragma unroll
          for (int ks = 0; ks < 8; ++ks) asm volatile("" : "+v"(Wf[i][ks])); }
    const int NT = hf ? 129 : 128;
    const unsigned xr = ((fr & 3) << 2) | ((0u - (unsigned)(fr >> 2)) & 3);
#define SA_DMA(uu) do { const int u_ = (uu); LAS unsigned char* lz_ = lds + OFF_LZ + (u_ & 1) * LZ_BYTES; \
        if (u_ < 128) { const size_t phys = (size_t)__builtin_amdgcn_readfirstlane(pt[u_ >> 2]);     const float* cp = C.cache_c + (phys * PAGE + (u_ & 3) * TK) * KVL + lane * 4; \
            _Pragma("unroll") for (int i = 0; i < 4; ++i) __builtin_amdgcn_global_load_lds((const unsigned*)(cp + (size_t)(i * 8 + wid) * KVL), (LAS unsigned*)(lz_ + (i * 8 + wid) * 1024), 16, 0, 2); \
            if (wid < 4) { const float* kp = C.cache_kr + (phys * PAGE + (u_ & 3) * TK) * QKR + (wid * 64 + lane) * 4; __builtin_amdgcn_global_load_lds((const unsigned*)kp, (LAS unsigned*)(lz_ + 32768 + wid * 1024), 16, 0, 2); } } \
        else { int ln_ = lane; asm volatile("" : "+v"(ln_));   \
            const float* sp_ = C.new_c + (size_t)(db * DSEQ + wid) * KVL + ln_ * 4; \
            _Pragma("unroll") for (int i = 0; i < 4; ++i) __builtin_amdgcn_global_load_lds((const unsigned*)sp_, (LAS unsigned*)(lz_ + (i * 8 + wid) * 1024), 16, 0, 0); \
            if (wid < 4) __builtin_amdgcn_global_load_lds((const unsigned*)(C.new_kr + (size_t)db * DSEQ * QKR + ln_ * 4), (LAS unsigned*)(lz_ + 32768 + wid * 1024), 16, 0, 0); } } while (0)
#define SA_CONVERT(uu, bb) do { const int u_ = (uu); const unsigned lz_ = (unsigned)(uintptr_t)(lds + OFF_LZ) + (u_ & 1) * LZ_BYTES + wid * 1024 + lane * 16; \
        LAS unsigned char* ct_ = lds + OFF_CT + (bb) * CT_BYTES + (lane >> 5) * CT_HALF; const unsigned co_ = ((lane & 31) >> 1), cb_ = 8 * (lane & 1); \
        f32x4 v0_, v1_, v2_, v3_, k_;   \
        asm volatile("ds_read_b128 %0, %1" : "=v"(v0_) : "v"(lz_)); asm volatile("ds_read_b128 %0, %1 offset:8192" : "=v"(v1_) : "v"(lz_)); \
        asm volatile("ds_read_b128 %0, %1 offset:16384" : "=v"(v2_) : "v"(lz_)); asm volatile("ds_read_b128 %0, %1 offset:24576" : "=v"(v3_) : "v"(lz_)); \
        if (wid < 4) asm volatile("ds_read_b128 %0, %1 offset:32768" : "=v"(k_) : "v"(lz_)); \
        asm volatile("s_waitcnt lgkmcnt(0)" : "+v"(v0_), "+v"(v1_), "+v"(v2_), "+v"(v3_)); \
        if (u_ >= 128) { v1_ = v1_ * 0.f; v2_ = v2_ * 0.f; v3_ = v3_ * 0.f; } \
        { v2u w_; w_.x = pk2(v0_.x, v0_.y); w_.y = pk2(v0_.z, v0_.w); *(LAS v2u*)(ct_ + off_b(wid, co_) + cb_) = w_; } \
        { v2u w_; w_.x = pk2(v1_.x, v1_.y); w_.y = pk2(v1_.z, v1_.w); *(LAS v2u*)(ct_ + off_b(8 + wid, co_) + cb_) = w_; } \
        { v2u w_; w_.x = pk2(v2_.x, v2_.y); w_.y = pk2(v2_.z, v2_.w); *(LAS v2u*)(ct_ + off_b(16 + wid, co_) + cb_) = w_; } \
        { v2u w_; w_.x = pk2(v3_.x, v3_.y); w_.y = pk2(v3_.z, v3_.w); *(LAS v2u*)(ct_ + off_b(24 + wid, co_) + cb_) = w_; } \
        if (wid < 4) { asm volatile("" : "+v"(k_)); if (u_ >= 128 && wid > 0) k_ = k_ * 0.f; \
          v2u w_; w_.x = pk2(k_.x, k_.y); w_.y = pk2(k_.z, k_.w); *(LAS v2u*)(lds + OFF_KRT + (bb) * KRT_BYTES + (wid * 8 + (lane >> 3)) * KRT_PITCH + (lane & 7) * 8) = w_; \
          float s_ = (k_.x * k_.x + k_.y * k_.y) + (k_.z * k_.z + k_.w * k_.w); s_ = sum_oct(s_); if ((lane & 7) == 0) *(LAS float*)(lds + OFF_KSS + (bb) * 128 + (wid * 8 + (lane >> 3)) * 4) = s_; } } while (0)
#define SA_BAR() do { asm volatile("s_waitcnt lgkmcnt(0)" ::: "memory"); __builtin_amdgcn_s_barrier(); asm volatile("" ::: "memory"); } while (0)
#define SA_WAIT_OLDER() do { if (wid < 4) asm volatile("s_waitcnt vmcnt(5)" ::: "memory"); else asm volatile("s_waitcnt vmcnt(4)" ::: "memory"); } while (0)
#define SA_CTX(bb, pb) do { int lc_ = lane; asm volatile("" : "+v"(lc_)); const int frc = lc_ & 15, fqc = lc_ >> 4; \
        const unsigned ctb = (unsigned)(uintptr_t)(lds + OFF_CT) + (bb) * CT_BYTES + hh * CT_HALF; \
        const LAS unsigned char* plb = lds + OFF_PL + (pb) * PL_BYTES + frc * PL_PITCH + fqc * 16; \
        s16x4 tv[2][2]; \
        { const unsigned row = 8 * fqc + (frc >> 2), pp = lc_ & 3; const unsigned a0_ = ctb + off_b(row, 2 * c0 + (pp >> 1)) + 8 * (pp & 1); \
            \
          const unsigned a1_ = a0_ ^ 0x20u, a2_ = a0_ ^ 0x30u, a3_ = a0_ ^ 0x10u; \
          asm volatile("ds_read_b64_tr_b16 %0, %1" : "=&v"(tv[0][0]) : "v"(a0_) : "memory"); asm volatile("ds_read_b64_tr_b16 %0, %1 offset:1024" : "=&v"(tv[0][1]) : "v"(a2_) : "memory"); \
          asm volatile("ds_read_b64_tr_b16 %0, %1" : "=&v"(tv[1][0]) : "v"(a1_) : "memory"); asm volatile("ds_read_b64_tr_b16 %0, %1 offset:1024" : "=&v"(tv[1][1]) : "v"(a3_) : "memory"); } \
        bf16x8 A[4]; _Pragma("unroll") for (int rt = 0; rt < 4; ++rt) A[rt] = *(const LAS bf16x8*)(plb + rt * 16 * PL_PITCH); \
        const bf16x8 Al = *(const LAS bf16x8*)(plb + srt * 16 * PL_PITCH); \
        asm volatile("s_waitcnt lgkmcnt(0)" ::: "memory"); __builtin_amdgcn_sched_barrier(0); \
        const bf16x8 B0 = (bf16x8){tv[0][0][0], tv[0][0][1], tv[0][0][2], tv[0][0][3], tv[0][1][0], tv[0][1][1], tv[0][1][2], tv[0][1][3]}; \
        const bf16x8 B1 = (bf16x8){tv[1][0][0], tv[1][0][1], tv[1][0][2], tv[1][0][3], tv[1][1][0], tv[1][1][1], tv[1][1][2], tv[1][1][3]}; \
        _Pragma("unroll") for (int rt = 0; rt < 4; ++rt) { ctx[rt][0] = __builtin_amdgcn_mfma_f32_16x16x32_bf16(A[rt], B0, ctx[rt][0], 0, 0, 0); \
                                                            ctx[rt][1] = __builtin_amdgcn_mfma_f32_16x16x32_bf16(A[rt], B1, ctx[rt][1], 0, 0, 0); } \
        { const v4u au = *reinterpret_cast<const v4u*>(&Al); \
          lacc += ((bflo(au.x) + bfhi(au.x)) + (bflo(au.y) + bfhi(au.y))) + ((bflo(au.z) + bfhi(au.z)) + (bflo(au.w) + bfhi(au.w))); } } while (0)
    f32x4 ctx[4][2];
#pragma unroll
    for (int rt = 0; rt < 4; ++rt) { ctx[rt][0] = (f32x4){0.f, 0.f, 0.f, 0.f}; ctx[rt][1] = (f32x4){0.f, 0.f, 0.f, 0.f}; }
    float lacc = 0.f;
    const float b2 = C.b2;
    const int hh = wid >> 2, c0 = 2 * (wid & 3), srt = wid >> 1;
    const int prow = (fq < 2) ? h * 8 + 4 * fq : 64 + 4 * (fq - 2);
    SA_DMA(0); SA_DMA(1); SA_WAIT_OLDER(); SA_CONVERT(0, 0); SA_DMA(2);
#ifdef SYNTH_MFMA
    {
        f32x4 Y[4]; for (int i = 0; i < 4; ++i) Y[i] = (f32x4){0.f, 0.f, 0.f, 0.f};
        bf16x8 Bs = Wf[0][0]; int nsy_ = 258; asm volatile("" : "+s"(nsy_));
        for (int r = 0; r < nsy_; ++r) {
#if SYNTH_MFMA == 2
            { const unsigned a_ = (unsigned)(uintptr_t)(lds + OFF_CT) + 256 * fr + 16 * (fq ^ xr); asm volatile("ds_read_b128 %0, %1\n\ts_waitcnt lgkmcnt(0)" : "=v"(Bs) : "v"(a_)); }
#endif
#pragma unroll
            for (int ks = 0; ks < 8; ++ks) {
#pragma unroll
                for (int i = 0; i < 4; ++i) Y[i] = __builtin_amdgcn_mfma_f32_16x16x32_bf16(Wf[i][ks], Bs, Y[i], 0, 0, 0); }
            asm volatile("" : "+v"(Bs));
        }
        float z_ = 0.f; asm volatile("" : "+v"(z_));
        lacc += (Y[0].x + Y[1].x + Y[2].x + Y[3].x) * z_;
    }
#endif
    SA_BAR();
#ifndef SA_NO_PRIO
    if (wid < 4) __builtin_amdgcn_s_setprio(2);
#endif
    int bc = 0;
    for (int u = 0; u < NT; ++u) {
        const int bn = (bc == 2) ? 0 : bc + 1, bp = (bc == 0) ? 2 : bc - 1;
        const int pb = u & 1;
        const int qlim = (u == 128) ? 0 : 1000;
        if (wid >= 4) { if (u > 0) SA_CTX(bp, pb ^ 1); }
        unsigned ba[4];
#pragma unroll
        for (int j = 0; j < 4; ++j) ba[j] = (unsigned)(uintptr_t)(lds + OFF_CT) + bc * CT_BYTES + 256 * fr + 16 * ((j * 4 + fq) ^ xr);
#define SA_RD(dst, j, off_) asm volatile("ds_read_b128 %0, %1 offset:%2" : "=v"(dst) : "v"(ba[j]), "i"(off_))
#define SA_WT(n, b) asm volatile("s_waitcnt lgkmcnt(" #n ")" : "+v"(b))
#define SA_MF(X, ks, b) do { _Pragma("unroll") for (int i = 0; i < 4; ++i) X[i] = __builtin_amdgcn_mfma_f32_16x16x32_bf16(Wf[i][ks], b, X[i], 0, 0, 0); } while (0)
#define SA_PRE(KO, B0, B1, B2) do { SA_RD(B0, 0, KO); SA_RD(B1, 1, KO); SA_RD(B2, 2, KO); } while (0)
#define SA_BURST(KO, X, B0, B1, B2) do { \
            SA_WT(2, B0); SA_MF(X, 0, B0); SA_RD(B0, 3, KO); \
            SA_WT(2, B1); SA_MF(X, 1, B1); SA_RD(B1, 0, KO + CT_HALF); \
            SA_WT(2, B2); SA_MF(X, 2, B2); SA_RD(B2, 1, KO + CT_HALF); \
            SA_WT(2, B0); SA_MF(X, 3, B0); SA_RD(B0, 2, KO + CT_HALF); \
            SA_WT(2, B1); SA_MF(X, 4, B1); SA_RD(B1, 3, KO + CT_HALF); \
            SA_WT(2, B2); SA_MF(X, 5, B2); \
            SA_WT(1, B0); SA_MF(X, 6, B0); \
            SA_WT(0, B1); SA_MF(X, 7, B1); } while (0)
#define SA_TAIL(kg, X) do { \
            float ss = 0.f; \
            _Pragma("unroll") for (int i = 0; i < 4; ++i) ss += (X[i].x * X[i].x + X[i].y * X[i].y) + (X[i].z * X[i].z + X[i].w * X[i].w); \
            ss = sum_x32(sum_x16(ss)); \
            const float krss = *(const LAS float*)(lds + OFF_KSS + bc * 128 + (kg * 16 + fr) * 4); \
            const float rstd = __builtin_amdgcn_rsqf((ss + krss) * (1.f / QKH) + EPS); \
            v4u w0, w1; w0.x = pk2(X[0].x, X[0].y); w0.y = pk2(X[0].z, X[0].w); w0.z = pk2(X[1].x, X[1].y); w0.w = pk2(X[1].z, X[1].w); \
            w1.x = pk2(X[2].x, X[2].y); w1.y = pk2(X[2].z, X[2].w); w1.z = pk2(X[3].x, X[3].y); w1.w = pk2(X[3].z, X[3].w); \
            const bf16x8 krf = *(const LAS bf16x8*)(lds + OFF_KRT + bc * KRT_BYTES + (kg * 16 + fr) * KRT_PITCH + fq * 16); \
            f32x4 S = (f32x4){0.f, 0.f, 0.f, 0.f}; \
            const LAS bf16x8* qf = (const LAS bf16x8*)(lds + OFF_QF + wid * 1536) + fq * 8 + (fr & 7); \
            const bf16x8 Aq0 = qf[0], Aq1 = qf[32], Aqr = qf[64];                \
            S = __builtin_amdgcn_mfma_f32_16x16x32_bf16(Aq0, *reinterpret_cast<bf16x8*>(&w0), S, 0, 0, 0); \
            S = __builtin_amdgcn_mfma_f32_16x16x32_bf16(Aq1, *reinterpret_cast<bf16x8*>(&w1), S, 0, 0, 0); \
            S = __builtin_amdgcn_mfma_f32_16x16x32_bf16(Aqr, krf, S, 0, 0, 0); \
            f32x4 p; \
            _Pragma("unroll") for (int e = 0; e < 4; ++e) p[e] = __builtin_amdgcn_exp2f(S[e] * rstd - b2); \
            { const int kk = kg * 16 + fr - 4 * fq;                               \
              _Pragma("unroll") for (int e = 0; e < 4; ++e) p[e] = (kk > e + qlim) ? 0.f : p[e]; } \
            { LAS bf16* pl = (LAS bf16*)(lds + OFF_PL + pb * PL_BYTES + prow * PL_PITCH) + kg * 16 + fr;     \
              _Pragma("unroll") for (int e = 0; e < 4; ++e) pl[e * (PL_PITCH / 2)] = (bf16)pk2(p[e], 0.f); } } while (0)
#ifdef SA_REP_SCORE
        int nrs_ = 2; asm volatile("" : "+s"(nrs_)); for (int rs_ = 0; rs_ < nrs_; ++rs_)
#endif
        {
            f32x4 Xa[4], Xb[4];
#pragma unroll
            for (int i = 0; i < 4; ++i) { Xa[i] = (f32x4){0.f, 0.f, 0.f, 0.f}; Xb[i] = (f32x4){0.f, 0.f, 0.f, 0.f}; }
            bf16x8 Ba0, Ba1, Ba2, Bb0, Bb1, Bb2;
            SA_PRE(0, Ba0, Ba1, Ba2);
            SA_BURST(0, Xa, Ba0, Ba1, Ba2);
            SA_PRE(4096, Bb0, Bb1, Bb2);
            SA_BURST(4096, Xb, Bb0, Bb1, Bb2);
            SA_TAIL(0, Xa);
            SA_TAIL(1, Xb);
#ifdef SA_REP_TAIL
            { int nt_ = 1; asm volatile("" : "+s"(nt_)); for (int r_ = 0; r_ < nt_; ++r_) { asm volatile("" : "+v"(Xb[0]), "+v"(Xb[1]), "+v"(Xb[2]), "+v"(Xb[3])); SA_TAIL(1, Xb); } }
#endif
        }
#undef SA_RD
#undef SA_WT
#undef SA_MF
#undef SA_PRE
#undef SA_BURST
#undef SA_TAIL
        if (wid < 4) { if (u > 0) SA_CTX(bp, pb ^ 1); }
        if (u + 1 < NT) {
            if (u + 2 < NT) SA_WAIT_OLDER(); else VM_WAIT();
            SA_CONVERT(u + 1, bn);
            if (u + 3 < NT) SA_DMA(u + 3);
        }
        SA_BAR();
        bc = bn;
    }
    { const int bl = (bc == 0) ? 2 : bc - 1; SA_CTX(bl, (NT - 1) & 1); }
#ifndef SA_NO_PRIO
    __builtin_amdgcn_s_setprio(0);
#endif
    const int it = db * 2 + hf;
    lacc = sum_x32(sum_x16(lacc));
    if (fq == 0 && (fr >> 3) == (wid & 1)) C.SAL[(size_t)it * 64 + h * 8 + (fr & 7)] = lacc;
    float* cp = C.SAC + (size_t)it * 64 * 256;
#pragma unroll
    for (int rt = 0; rt < 4; ++rt)
#pragma unroll
        for (int cb = 0; cb < 2; ++cb)
#pragma unroll
            for (int e = 0; e < 4; ++e) cp[(size_t)(rt * 16 + 4 * fq + e) * 256 + hh * 128 + 16 * (c0 + cb) + fr] = ctx[rt][cb][e];
    __syncthreads();
#undef SA_DMA
#undef SA_CONVERT
#undef SA_BAR
#undef SA_WAIT_OLDER
#undef SA_CTX
}
}
namespace g2 {
using pg8::Unit; using pg8::Gemm;
constexpr int TILE_BYTES = 32768, BUF_BYTES = 65536;
template <class Epi, class Sched>
__device__ __forceinline__ void gemm_phase(LAS unsigned char* lds, const Gemm g, const Sched& S, const Epi& E) {
    int tid = threadIdx.x; asm volatile("" : "+v"(tid));
    const int wid = __builtin_amdgcn_readfirstlane(tid >> 6), lane = tid & 63, wr = wid >> 2, wc = wid & 3, fr = lane & 15, fq = lane >> 4;
    const int K = g.K, nt = K / 64;
    Unit cur, nxt;
    if (!S.next(0, cur)) return;
    const int srow = tid >> 3, sch = tid & 7;
    const int rb0 = Epi::PERM ? ((srow & ~31) + pg8::perm32(srow & 31)) : srow;
    const unsigned goffA0 = (unsigned)(srow * K + sch * 8) * 2u, goffB0 = (unsigned)(rb0 * K + sch * 8) * 2u, loff0 = (unsigned)(srow * 128 + ((sch ^ (srow & 7)) << 4));
    const size_t rstep = (size_t)64 * K * 2;
    const size_t tstep = (size_t)256 * K * 2;
    const unsigned cx0 = (unsigned)(((0 + fq) ^ (fr & 7)) << 4), cx1 = (unsigned)(((4 + fq) ^ (fr & 7)) << 4);
    const unsigned abase = (unsigned)((64 * wr + fr) * 128), bbase = (unsigned)(TILE_BYTES + (32 * wc + fr) * 128);
    v4u sa[4], sb[4];
#define G2_LOAD(pa, pb, kt) do { const char* a_ = (pa) + (size_t)(kt) * 128; const char* b_ = (pb) + (size_t)(kt) * 128; \
        _Pragma("unroll") for (int i = 0; i < 4; ++i) { sa[i] = *(const GAS v4u*)(a_ + i * rstep + goffA0); sb[i] = *(const GAS v4u*)(b_ + i * rstep + goffB0); } } while (0)
#define G2_WRITE(buf) do { LAS unsigned char* d_ = lds + (buf) * BUF_BYTES; \
        _Pragma("unroll") for (int i = 0; i < 4; ++i) { *(LAS v4u*)(d_ + i * 8192 + loff0) = sa[i]; *(LAS v4u*)(d_ + TILE_BYTES + i * 8192 + loff0) = sb[i]; } } while (0)
    pg8::f32x4 acc[2][2][4][2];
#define G2_ZERO() do { _Pragma("unroll") for (int a = 0; a < 2; ++a) _Pragma("unroll") for (int b = 0; b < 2; ++b) _Pragma("unroll") for (int m = 0; m < 4; ++m) _Pragma("unroll") for (int n = 0; n < 2; ++n) acc[a][b][m][n] = (pg8::f32x4){0.f, 0.f, 0.f, 0.f}; } while (0)
    G2_ZERO();
    const char* cA = (const char*)g.A + (size_t)cur.pm * tstep; const char* cB = (const char*)g.Bt + (size_t)cur.pn * tstep;
    G2_LOAD(cA, cB, 0); VM_WAIT(); G2_WRITE(0);
    __syncthreads();
    int buf = 0, ui = 0;
    for (;;) {
        const bool has_next = S.next(ui + 1, nxt);
        const char* nA = has_next ? (const char*)g.A + (size_t)nxt.pm * tstep : cA; const char* nB = has_next ? (const char*)g.Bt + (size_t)nxt.pn * tstep : cB;
        for (int kt = 0; kt < nt; ++kt) {
            const bool last = (kt == nt - 1);
            const bool pre = !last || has_next;
            if (pre) { if (last) G2_LOAD(nA, nB, 0); else G2_LOAD(cA, cB, kt + 1); }
            const LAS unsigned char* tb = lds + buf * BUF_BYTES;
#pragma unroll
            for (int ks = 0; ks < 2; ++ks) {
                const unsigned cx = ks ? cx1 : cx0;
                pg8::bf16x8 bf[2][2];
#pragma unroll
                for (int bj = 0; bj < 2; ++bj)
#pragma unroll
                    for (int n = 0; n < 2; ++n) bf[bj][n] = *(const LAS pg8::bf16x8*)(tb + bbase + (128 * bj + 16 * n) * 128 + cx);
#pragma unroll
                for (int ai = 0; ai < 2; ++ai) {
                    pg8::bf16x8 af[4];
#pragma unroll
                    for (int m = 0; m < 4; ++m) af[m] = *(const LAS pg8::bf16x8*)(tb + abase + (128 * ai + 16 * m) * 128 + cx);
#pragma unroll
                    for (int bj = 0; bj < 2; ++bj)
#pragma unroll
                        for (int m = 0; m < 4; ++m)
#pragma unroll
                            for (int n = 0; n < 2; ++n) acc[ai][bj][m][n] = __builtin_amdgcn_mfma_f32_16x16x32_bf16(bf[bj][n], af[m], acc[ai][bj][m][n], 0, 0, 0);
                }
            }
#ifdef G2_SINGLE_BUF
            __syncthreads();
            if (pre) { VM_WAIT(); G2_WRITE(0); }
            __syncthreads();
#else
            if (pre) { VM_WAIT(); G2_WRITE(buf ^ 1); }
            __syncthreads();
            buf ^= 1;
#endif
        }
        E(acc, cur, wr, wc, fr, fq);
        if (!has_next) break;
        G2_ZERO();
        cur = nxt; cA = nA; cB = nB; ++ui;
    }
    __syncthreads();
#undef G2_LOAD
#undef G2_WRITE
#undef G2_ZERO
}
}
__device__ __forceinline__ void p3_meta_kv(Frame& F) {
    const int lane = F.lane, wv = F.wave;
    const float* CM = WSP(float, WS_CM); const float* KRM = WSP(float, WS_KRM); const float* KSM = WSP(float, WS_KSM);
    bf16* KH = WSP(bf16, WS_KH); bf16* VH = WSP(bf16, WS_VH);
    LAS float* part = (LAS float*)F.lds;
    for (int t = F.vcu; t < 256; t += F.G) {
        const int i = (t >> 3) & 15, h = t & 7; const float* c = CM + i * KVL + 32 * wv;
        float a0 = 0.f, a1 = 0.f;
        if (t < 128) {
#pragma unroll
            for (int r = 0; r < 32; ++r) a0 += c[r] * F.w_uk[(size_t)(32 * wv + r) * 512 + h * 64 + lane];
        } else {
#pragma unroll
            for (int r = 0; r < 32; ++r) { const float cr = c[r]; a0 += cr * F.w_uv[(size_t)(32 * wv + r) * 1024 + h * 128 + lane]; a1 += cr * F.w_uv[(size_t)(32 * wv + r) * 1024 + h * 128 + 64 + lane]; }
        }
        part[wv * 128 + lane] = a0; part[wv * 128 + 64 + lane] = a1;
        __syncthreads();
        if (wv == 0) {
            float s0 = 0.f, s1 = 0.f;
#pragma unroll
            for (int w = 0; w < 8; ++w) { s0 += part[w * 128 + lane]; s1 += part[w * 128 + 64 + lane]; }
            if (t < 128) {
                const float ss = wave_sum(s0 * s0);
                const float rstd = frsqrt((ss + KSM[i]) * (1.f / QKH) + EPS);
                const bf16 kv = (bf16)f2bf(s0 * rstd * F.g_kn_nope[lane]);
                const bf16 kr = (bf16)f2bf(KRM[i * 32 + (lane & 31)] * rstd);
                for (int b = 0; b < NBATCH; ++b) { bf16* kp = KH + (size_t)(b * TT + i) * 768 + h * QKH; kp[lane] = kv; if (lane < 32) kp[64 + lane] = kr; }
            } else {
                const bf16 v0 = (bf16)f2bf(s0), v1 = (bf16)f2bf(s1);
                for (int b = 0; b < NBATCH; ++b) { bf16* vp = VH + (size_t)(b * TT + i) * 1024 + h * VHD; vp[lane] = v0; vp[64 + lane] = v1; }
            }
        }
        __syncthreads();
    }
}
__device__ __forceinline__ void p1_naive(Frame& F) {
    const bf16* XN = WSP(bf16, WS_XN); const bf16* Win_t = WSP(bf16, WS_WIN); float* PF = WSP(float, WS_PF); bf16* GATE = WSP(bf16, WS_GATE);
    const size_t gt = (size_t)F.vcu * NWAVES * 64 + F.tid, NGT = (size_t)F.G * NWAVES * 64;
    for (size_t idx = gt; idx < (size_t)MC * (NIN / 8); idx += NGT) {
        const size_t m = idx / (NIN / 8); const int n0 = (int)(idx % (NIN / 8)) * 8;
        float acc[8];
#pragma unroll
        for (int j = 0; j < 8; ++j) acc[j] = 0.f;
        for (int k = 0; k < DM; k += 8) {
            const v4u x = *(const GAS v4u*)(XN + m * DM + k);
            const float xf[8] = {bflo(x.x), bfhi(x.x), bflo(x.y), bfhi(x.y), bflo(x.z), bfhi(x.z), bflo(x.w), bfhi(x.w)};
#pragma unroll
            for (int j = 0; j < 8; ++j) { const v4u w = *(const GAS v4u*)(Win_t + (size_t)(n0 + j) * DM + k);
                acc[j] += xf[0] * bflo(w.x) + xf[1] * bfhi(w.x) + xf[2] * bflo(w.y) + xf[3] * bfhi(w.y) + xf[4] * bflo(w.z) + xf[5] * bfhi(w.z) + xf[6] * bflo(w.w) + xf[7] * bfhi(w.w); }
        }
        if (n0 < PFW) {
#pragma unroll
            for (int j = 0; j < 8; ++j) PF[m * PFW + n0 + j] = acc[j];
        } else {
#pragma unroll
            for (int j = 0; j < 8; ++j) GATE[m * 2048 + (n0 - PFW) + j] = (bf16)f2bf(sigmoidf_fast(acc[j]));
        }
    }
}
__device__ __forceinline__ void p5_unit(Frame& F, int h, int tb) {
    constexpr int PITCH = 528;
    const int tid = F.tid, lane = F.lane, wid = F.wave, fr = lane & 15, fq = lane >> 4;
    LAS unsigned char* At = F.lds; LAS unsigned char* Bt = F.lds + 32 * PITCH;
    const float* SAC = WSP(float, WS_SAC); const float* SAL = WSP(float, WS_SAL); const bf16* Wuv_t = WSP(bf16, WS_WKV) + (size_t)512 * KVL;
    for (int e = tid; e < 32 * 64; e += NWAVES * 64) { const int row = e >> 6, c4 = e & 63, tok = tb * 32 + row, db = tok >> 3, r = h * 8 + (tok & 7);
        const f32x4 a = *((const GAS f32x4*)(SAC + ((size_t)(2 * db) * 64 + r) * 256) + c4), b = *((const GAS f32x4*)(SAC + ((size_t)(2 * db + 1) * 64 + r) * 256) + c4);
        const float il = 1.0f / (SAL[(2 * db) * 64 + r] + SAL[(2 * db + 1) * 64 + r]);
        v2u w; w.x = pk2((a.x + b.x) * il, (a.y + b.y) * il); w.y = pk2((a.z + b.z) * il, (a.w + b.w) * il);
        *(LAS v2u*)(At + row * PITCH + c4 * 8) = w; }
    for (int e = tid; e < 128 * 32; e += NWAVES * 64) { const int row = e >> 5, ch = e & 31;
        *(LAS v4u*)(Bt + row * PITCH + ch * 16) = *(const GAS v4u*)(Wuv_t + (size_t)(h * 128 + row) * KVL + ch * 8); }
    __syncthreads();
    f32x4 acc[2];
    acc[0] = (f32x4){0.f, 0.f, 0.f, 0.f}; acc[1] = (f32x4){0.f, 0.f, 0.f, 0.f};
    const int cbase = wid * 16;
#pragma unroll
    for (int ks = 0; ks < 8; ++ks) {
        const bf16x8 bfm = *(const LAS bf16x8*)(Bt + (cbase + fr) * PITCH + (32 * ks + 8 * fq) * 2);
#pragma unroll
        for (int rt = 0; rt < 2; ++rt) { const bf16x8 af = *(const LAS bf16x8*)(At + (rt * 16 + fr) * PITCH + (32 * ks + 8 * fq) * 2);
            acc[rt] = __builtin_amdgcn_mfma_f32_16x16x32_bf16(af, bfm, acc[rt], 0, 0, 0); }
    }
    const bf16* PG = WSP(bf16, WS_PG); const bf16* GATE = WSP(bf16, WS_GATE); bf16* AMS = WSP(bf16, WS_AMS);
    const int col = h * VHD + cbase + fr;
#pragma unroll
    for (int rt = 0; rt < 2; ++rt)
#pragma unroll
        for (int e = 0; e < 4; ++e) { const int tok = tb * 32 + rt * 16 + 4 * fq + e; const size_t m = (size_t)(MP + tok);
            const float g = bflo((unsigned)GATE[m * 2048 + DM + col]), pg = bflo((unsigned)PG[m * DM + col]);
            AMS[((size_t)(col >> 8) * MS + tok) * 256 + (col & 255)] = (bf16)f2bf(pg + g * acc[rt][e]); }
    __syncthreads();
}
__device__ __forceinline__ void p7_hn(Frame& F) {
    const int gw = F.vcu * NWAVES + F.wave, NGW = F.G * NWAVES, lane = F.lane;
    const float* H = WSP(float, WS_H); bf16* HN = WSP(bf16, WS_HN);
    f32x4 g4[4];
#pragma unroll
    for (int j = 0; j < 4; ++j) g4[j] = *((const GAS f32x4*)F.g_mlp + lane + 64 * j);
    for (int m = gw; m < MC; m += NGW) {
        const GAS f32x4* xr = (const GAS f32x4*)(H + (size_t)m * DM) + lane;
        f32x4 v[4]; float s = 0.f;
        if (m >= MP) {
            const GAS f32x4* xs = (const GAS f32x4*)(F.x_sample + (size_t)(m - MP) * DM) + lane; const float* HS = WSP(float, WS_HS);
#pragma unroll
            for (int j = 0; j < 4; ++j) { f32x4 a = xs[64 * j];
#pragma unroll
                for (int sl = 0; sl < 4; ++sl) a += *((const GAS f32x4*)(HS + ((size_t)sl * MS + (m - MP)) * DM) + lane + 64 * j);
                v[j] = a; *((GAS f32x4*)(H + (size_t)m * DM) + lane + 64 * j) = a; s += (a.x * a.x + a.y * a.y) + (a.z * a.z + a.w * a.w); }
        } else {
            const GAS v2u* hb = (const GAS v2u*)(WSP(bf16, WS_HB) + (size_t)m * DM) + lane;
#pragma unroll
            for (int j = 0; j < 4; ++j) { const v2u t = hb[64 * j]; v[j] = (f32x4){bflo(t.x), bfhi(t.x), bflo(t.y), bfhi(t.y)}; s += (v[j].x * v[j].x + v[j].y * v[j].y) + (v[j].z * v[j].z + v[j].w * v[j].w); }
        }
        const float rstd = frsqrt(wave_sum(s) * (1.f / DM) + EPS);
        GAS v2u* o8 = (GAS v2u*)(HN + (size_t)m * DM) + lane;
#pragma unroll
        for (int j = 0; j < 4; ++j) { v2u o; o.x = pk2(v[j].x * rstd * g4[j].x, v[j].y * rstd * g4[j].y); o.y = pk2(v[j].z * rstd * g4[j].z, v[j].w * rstd * g4[j].w); o8[64 * j] = o; }
    }
}

struct Args { const void* in[24]; float* out; unsigned char* ws; int ph_lo, ph_hi; };
#ifdef USE_PG8
#define GEMM_PHASE(EPI) pg8::gemm_phase<EPI, pg8::StaticOrder, PG8_ALIGN, PG8_SP2>
#define SLICE_PHASE(EPI) pg8::gemm_phase<EPI, SliceOrder, PG8_ALIGN, PG8_SP2>
#else
#define GEMM_PHASE(EPI) g2::gemm_phase<EPI, pg8::StaticOrder>
#define SLICE_PHASE(EPI) g2::gemm_phase<EPI, SliceOrder>
#endif
__device__ __forceinline__ int opaque(int v) { asm volatile("" : "+s"(v)); return v; }
__global__ void __launch_bounds__(NWAVES * 64, 2) mk_fwd(Args args) {
    extern __shared__ __attribute__((aligned(16))) unsigned char lds[];
    Frame F;
    F.lds = (LAS unsigned char*)lds;
    F.MISC = (volatile LAS unsigned*)(F.lds + MISC_OFF);
    F.tid = threadIdx.x; F.lane = F.tid & 63; F.wave = __builtin_amdgcn_readfirstlane(F.tid >> 6);
    F.G = gridDim.x; { const int bx = blockIdx.x; F.vcu = (F.G % 8 == 0) ? (bx % 8) * (F.G / 8) + bx / 8 : bx; }
    F.ws = args.ws; F.out = args.out; F.ctl = (gu32*)(args.ws + WS_CTL);
#define INP(k) ((const float*)args.in[opaque(k)])
    for (int u = F.tid; u < (LDS_BYTES - LDSCTL_OFF) / 4; u += NWAVES * 64) ((LAS unsigned*)(F.lds + LDSCTL_OFF))[u] = 0u;
    __syncthreads();
#ifdef ENTRY_FENCE
    if (F.tid == 0) { __builtin_amdgcn_fence(__ATOMIC_ACQ_REL, "agent"); asm volatile("s_waitcnt vmcnt(0)" ::: "memory"); }
    __syncthreads();
#endif
    XcdBarrier bar = xcd_barrier_post((unsigned*)(F.ctl + CW_BAR), F.MISC + 8);
    const int lo = args.ph_lo, hi = args.ph_hi;
#ifndef PHMASK
#define PHMASK 0x3ff
#endif
#define IN(k) ((((PHMASK) >> (k)) & 1) && lo <= (k) && (k) < hi)
#define SEAM(k) do { if (IN(k) && IN((k) + 1)) xcd_barrier(bar); } while (0)
#ifndef REPEAT_PHASE
#define REPEAT_PHASE -1
#endif
#define REP(k) for (int rep_ = 0; rep_ < ((REPEAT_PHASE == (k)) ? 2 : 1); ++rep_, ((REPEAT_PHASE == (k)) && rep_ == 1 ? (xcd_barrier(bar), 0) : 0))
    const int bx = (int)blockIdx.x;
#ifdef STAMP_IDX
    unsigned long long stamp_[16]; int nst_ = 0;
#define STAMP() do { stamp_[nst_ < 15 ? nst_ : 15] = __builtin_amdgcn_s_memrealtime(); ++nst_; } while (0)
    STAMP();
#else
#define STAMP() do { } while (0)
#endif

    if (IN(0)) REP(0) { F.x_prompt = INP(0); F.x_sample = INP(1); F.meta_tokens = INP(6); F.g_attn = INP(7); F.w_in = INP(8); F.w_uq = INP(10); F.w_uk = INP(14); F.w_uv = INP(17); F.w_pool_map = INP(18);
        F.w_o = INP(20); F.w_ff1 = INP(22); F.w_ff2 = INP(23); p0_prologue(F); }
    SEAM(0); STAMP();
    if (IN(1)) REP(1) {
#ifdef TOUCH_P1
        { const size_t gt = (size_t)F.vcu * NWAVES * 64 + F.tid, NGT = (size_t)F.G * NWAVES * 64; unsigned acc_ = 0;
          const GAS v4u* a_ = (const GAS v4u*)WSP(bf16, WS_XN); const GAS v4u* b_ = (const GAS v4u*)WSP(bf16, WS_WIN);
          for (size_t i = gt; i < (size_t)MC * DM / 8; i += NGT) { const v4u v = a_[i]; acc_ += v.x ^ v.y ^ v.z ^ v.w; }
          for (size_t i = gt; i < (size_t)NIN * DM / 8; i += NGT) { const v4u v = b_[i]; acc_ += v.x ^ v.y ^ v.z ^ v.w; }
          if (acc_ == 0x12345678u) F.ctl[8] = acc_; VM_WAIT(); __syncthreads(); }
#endif
#ifdef ZERO_LDS_P1
        for (int u = F.tid; u < 131072 / 16; u += NWAVES * 64) ((LAS v4u*)F.lds)[u] = (v4u){0u, 0u, 0u, 0u};
        __syncthreads();
#endif
#ifdef DELAY_P1
        { const unsigned long long t0 = __builtin_amdgcn_s_memrealtime(); while (__builtin_amdgcn_s_memrealtime() - t0 < 3000000ull) __builtin_amdgcn_s_sleep(8); }
#endif
#ifdef NAIVE_P1
        p1_naive(F);
#else
#ifdef P1_SHAPE_TEST
        pg8::Gemm g{WSP(bf16, WS_XN), WSP(bf16, WS_WIN), MP, 3072, DM}; pg8::StaticOrder S; S.init(MP, 3072, F.G, bx);
#else
        pg8::Gemm g{WSP(bf16, WS_XN), WSP(bf16, WS_WIN), MCX, NIN, DM}; pg8::StaticOrder S; S.init(MCX, NIN, F.G, bx);
#endif
#ifdef SCALAR_EPI
        EpiInProjScalar E{WSP(float, WS_PF), WSP(bf16, WS_GATE)};
        GEMM_PHASE(EpiInProjScalar)(F.lds + RING_OFF, g, S, E);
#else
        EpiInProj E{WSP(float, WS_PF), WSP(bf16, WS_GATE), WSP(bf16, WS_PB)};
        GEMM_PHASE(EpiInProj)(F.lds + RING_OFF, g, S, E);
#endif
#ifdef TWICE_P1
        __syncthreads();
        GEMM_PHASE(EpiInProj)(F.lds + RING_OFF, g, S, E);
#endif
#ifdef TWICE_DUMMY
        __syncthreads();
        { EpiInProj E2{WSP(float, WS_Z), WSP(bf16, WS_H), WSP(bf16, WS_HN)}; GEMM_PHASE(EpiInProj)(F.lds + RING_OFF, g, S, E2); }
#endif
#endif
    }
    SEAM(1); STAMP();
    if (IN(2)) REP(2) { F.g_kv_lat = INP(11); F.g_q_lat = INP(9); F.g_kn_rope = INP(16); F.state_pool = INP(4); p2_rows(F); p2_pool(F); }
    SEAM(2); STAMP();
    if (IN(3)) REP(3)
#ifdef REPEAT_P3
    for (int r3_ = 0, n3_ = opaque(2); r3_ < n3_; ++r3_, (r3_ < n3_ ? (xcd_barrier(bar), 0) : 0))
#endif
    {
        F.w_uk = INP(14); F.w_uv = INP(17); F.g_kn_nope = INP(15); F.pool_scale = INP(19);
#ifndef NO_P3M
#ifdef REPEAT_P3M
        for (int rm_ = 0, nm_ = opaque(2); rm_ < nm_; ++rm_)
#endif
        p3_meta_kv(F);
#endif
#ifdef REPEAT_P3Q
        for (int rq_ = 0, nq_ = opaque(2); rq_ < nq_; ++rq_)
#endif
#ifndef NO_P3Q
        { pg8::Gemm g{WSP(bf16, WS_QL), WSP(bf16, WS_WUQ), MC, 768, opaque(QLORA)}; pg8::StaticOrder S; S.init(MC, 768, F.G, bx);
          EpiPlainBf16 E{WSP(bf16, WS_QR), 768};
          GEMM_PHASE(EpiPlainBf16)(F.lds + RING_OFF, g, S, E); }
        __syncthreads();
#endif
#ifdef STAMP_P3
        STAMP();
#endif
#ifdef REPEAT_P3K
        for (int rk_ = 0, nk_ = opaque(2); rk_ < nk_; ++rk_)
#endif
#ifndef NO_P3K
        { pg8::Gemm g{WSP(bf16, WS_CB), WSP(bf16, WS_WKV), MP, 1536, opaque(KVL)}; pg8::StaticOrder S; S.init(MP, 1536, F.G, bx);
          EpiKV E{WSP(bf16, WS_KH), WSP(bf16, WS_VH), WSP(bf16, WS_KRG), WSP(float, WS_KSS), F.g_kn_nope};
          GEMM_PHASE(EpiKV)(F.lds + RING_OFF, g, S, E); }
        __syncthreads();
#endif
#ifdef STAMP_P3
        STAMP();
#endif
#ifdef REPEAT_P3P
        for (int rp_ = 0, np_ = opaque(2); rp_ < np_; ++rp_)
#endif
#ifndef NO_P3P
        { pg8::Gemm g{WSP(bf16, WS_DP), WSP(bf16, WS_WPL), 4 * MC, DM, opaque(128)}; PoolOrder S{F.G, (F.G == 256) ? ((F.vcu + 116) & 255) : F.vcu};
          EpiPool E{WSP(bf16, WS_PG), WSP(bf16, WS_GATE), F.pool_scale};
          pg8::gemm_phase<EpiPool, PoolOrder, PG8_ALIGN, PG8_SP2>(F.lds + RING_OFF, g, S, E); }
#endif
    }
    SEAM(3); STAMP();
    if (IN(4)) REP(4) {
        F.g_qn_nope = INP(12); F.g_qn_rope = INP(13); F.g_kn_nope = INP(15); F.g_kn_rope = INP(16);
        const float gq = fmaxf(wave_max(fabsf(F.g_qn_nope[F.lane])), wave_max(fabsf(F.g_qn_rope[F.lane & 15])));
        const float gk = fmaxf(wave_max(fabsf(F.g_kn_nope[F.lane])), wave_max(fabsf(F.g_kn_rope[F.lane & 15])));
        const float b2 = (float)QKH * SCALE_L2E * gq * gk;
#ifndef NO_PA
        {
            pa::Ctx C{WSP(bf16, WS_QR), WSP(bf16, WS_KH), WSP(bf16, WS_VH), WSP(bf16, WS_PG), WSP(bf16, WS_GATE), WSP(bf16, WS_AM), WSP(float, WS_ROPE), F.g_qn_nope, F.g_qn_rope, b2};
#ifdef REPEAT_PA
            for (int rpa_ = 0, npa_ = opaque(2); rpa_ < npa_; ++rpa_)
#endif
            for (int pr0 = F.vcu * 2; pr0 < 512; pr0 += 2 * F.G) {
#pragma unroll 1
                for (int k = 0; k < 4; ++k) {
                    const int pr = pr0 + (k >> 1); const int bh = pr >> 2, p = pr & 3, j = (k & 1) ? 7 - p : p;
                    pa::unit(C, bh >> 3, bh & 7, j, (char*)lds, F.lds);
                }
            }
        }
#endif
        STAMP();
#ifndef NO_SA
        {
            sa::Ctx C{INP(2), INP(3), (const int*)INP(5), F.out + O_CS, F.out + O_KRS, WSP(bf16, WS_QR), WSP(bf16, WS_WUK), WSP(float, WS_ROPE), F.g_qn_nope, F.g_qn_rope, F.g_kn_nope, F.g_kn_rope,
                      WSP(float, WS_SAC), WSP(float, WS_SAL), b2};
#ifdef REPEAT_SA
            for (int rsa_ = 0, nsa_ = opaque(2); rsa_ < nsa_; ++rsa_)
#endif
            for (int it = F.vcu; it < 256; it += F.G) sa::item(C, it >> 1, it & 1, F.lds);
        }
#endif
    }
    SEAM(4); STAMP();
    if (IN(5)) REP(5) {
        for (int u = F.vcu; u < 256; u += F.G) p5_unit(F, u >> 5, u & 31);
        F.w_o = INP(20); F.w_ff1 = INP(22); F.w_ff2 = INP(23); p0_weights(F, 0, P0_LATE_ITEMS, F.vcu * NWAVES + F.wave, F.G * NWAVES);
    }
    SEAM(5); STAMP();
    if (IN(6)) REP(6) {
        { pg8::Gemm g{WSP(bf16, WS_AM), WSP(bf16, WS_WO), MP, DM, opaque(DM)}; pg8::StaticOrder S; S.init(MP, DM, F.G, bx);
          EpiResToBf16 E{WSP(bf16, WS_HB), INP(0)};
          GEMM_PHASE(EpiResToBf16)(F.lds + RING_OFF, g, S, E); }
        __syncthreads();
        { pg8::Gemm g{WSP(bf16, WS_AMS), WSP(bf16, WS_WOS), 4 * MS, 4 * DM, opaque(256)}; SliceOrder S{4, F.G, F.vcu};
          EpiSlab E{WSP(float, WS_HS)};
          SLICE_PHASE(EpiSlab)(F.lds + RING_OFF, g, S, E); }
    }
    SEAM(6); STAMP();
    if (IN(7)) REP(7) { F.g_mlp = INP(21); F.x_sample = INP(1); p7_hn(F); }
    SEAM(7); STAMP();
    if (IN(8)) REP(8) {
        pg8::Gemm g{WSP(bf16, WS_HN), WSP(bf16, WS_W1), MC, DFF, opaque(DM)}; pg8::StaticOrder S; S.init(MC, DFF, F.G, bx);
        EpiRelu2 E{WSP(bf16, WS_Z), WSP(bf16, WS_ZS)};
#ifdef CLKP8
        const unsigned long long ck0_ = __builtin_amdgcn_s_memtime(), rt0_ = __builtin_amdgcn_s_memrealtime();
#endif
        GEMM_PHASE(EpiRelu2)(F.lds + RING_OFF, g, S, E);
#ifdef CLKP8
        { const unsigned long long ck1_ = __builtin_amdgcn_s_memtime(), rt1_ = __builtin_amdgcn_s_memrealtime();
          if (F.tid == 0) WSP(float, WS_CTL + 524288)[blockIdx.x] = (CLKP8 == 1) ? (float)(ck1_ - ck0_) / (float)(rt1_ - rt0_) * 3.f : (float)(rt1_ - rt0_) * 0.002f; }
#endif
    }
    SEAM(8); STAMP();
    if (IN(9)) REP(9) {
#ifdef REPEAT_P9M
        for (int r9_ = 0, n9_ = opaque(2); r9_ < n9_; ++r9_, __syncthreads())
#endif
        { pg8::Gemm g{WSP(bf16, WS_Z), WSP(bf16, WS_W2), MP, DM, opaque(DFF)}; pg8::StaticOrder S; S.init(MP, DM, F.G, bx);
          EpiResFromBf16 E{F.out + O_YP, WSP(bf16, WS_HB)};
          GEMM_PHASE(EpiResFromBf16)(F.lds + RING_OFF, g, S, E); }
        __syncthreads();
#ifdef REPEAT_P9T
        for (int r9_ = 0, n9_ = opaque(2); r9_ < n9_; ++r9_, __syncthreads())
#endif
        { pg8::Gemm g{WSP(bf16, WS_ZS), WSP(bf16, WS_W2S), 8 * MS, 8 * DM, opaque(512)}; SliceOrder S{8, F.G, F.vcu};
          EpiSlab E{WSP(float, WS_YS)};
          SLICE_PHASE(EpiSlab)(F.lds + RING_OFF, g, S, E); }
        xcd_barrier(bar);
        {
            const float* H = WSP(float, WS_H); const float* YS = WSP(float, WS_YS);
            for (size_t e = (size_t)F.vcu * NWAVES * 64 + F.tid; e < (size_t)MS * DM / 4; e += (size_t)F.G * NWAVES * 64) {
                f32x4 a = *((const GAS f32x4*)(H + (size_t)MP * DM) + e);
#pragma unroll
                for (int sl = 0; sl < 8; ++sl) a += *((const GAS f32x4*)(YS + (size_t)sl * MS * DM) + e);
                *((GAS f32x4*)(F.out + O_YS) + e) = a; }
        }
    }
#if defined(CLKPROBE) || defined(SEGPROBE) || defined(CLKP8)
#ifndef CLKPROBE
#define CLKPROBE 0
#endif
    if (IN(9)) { xcd_barrier(bar); if (blockIdx.x == 0 && F.tid == 0) F.out[0] = WSP(float, WS_CTL + 524288)[CLKPROBE]; }
#endif
#ifdef ENTRY_FENCE
    asm volatile("s_waitcnt vmcnt(0)" ::: "memory"); __syncthreads();
    if (F.tid == 0) { __builtin_amdgcn_fence(__ATOMIC_RELEASE, "agent"); asm volatile("s_waitcnt vmcnt(0)" ::: "memory"); }
    __syncthreads();
#endif
#ifdef TAG_SMALL
    if (IN(9)) {
        xcd_barrier(bar);
        const size_t gt = (size_t)F.vcu * NWAVES * 64 + F.tid, NGT = (size_t)F.G * NWAVES * 64;
        for (size_t i = O_CP + gt; i < O_END; i += NGT) F.out[i] *= (float)(TAG_SMALL);
    }
#endif
#ifdef CHECK_C
    if (IN(9)) {
        xcd_barrier(bar);
        if (blockIdx.x == 0) {
            const float* xp = INP(0); const float* mt = INP(6); const float* ga = INP(7); const float* win = INP(8); const float* gk = INP(11);
            LAS float* res = (LAS float*)F.lds;
            if (F.wave < 4) {
                const int b = (F.wave == 0) ? 2 : (F.wave == 1 ? 1 : (F.wave == 2 ? 15 : 0));
                const int t = (F.wave == 0) ? 3 : (F.wave == 1 ? 116 : (F.wave == 2 ? 2063 : 16));
                const float* xr = t < 16 ? mt + (size_t)t * DM : xp + ((size_t)b * SEQ + (t - 16)) * DM;
                float ss = 0.f; for (int k = F.lane; k < DM; k += 64) ss += xr[k] * xr[k];
                const float rs = frsqrt(wave_sum(ss) / DM + EPS);
                float c[4] = {0.f, 0.f, 0.f, 0.f};
                for (int k = 0; k < DM; ++k) { const float xn = xr[k] * rs * ga[k];
                    for (int j = 0; j < 4; ++j) c[j] += xn * win[(size_t)k * DIN + 896 + F.lane * 4 + j]; }
                float s2 = c[0] * c[0] + c[1] * c[1] + c[2] * c[2] + c[3] * c[3];
                const float r2 = frsqrt(wave_sum(s2) / KVL + EPS);
                float err = 0.f, refn = 0.f;
                for (int j = 0; j < 4; ++j) { const float ref = c[j] * r2 * gk[F.lane * 4 + j]; const float got = F.out[O_CP + ((size_t)b * TT + t) * KVL + F.lane * 4 + j]; err += (got - ref) * (got - ref); refn += ref * ref; }
                err = wave_sum(err); refn = wave_sum(refn);
                if (F.lane == 0) res[F.wave] = (err > 0.0004f * refn) ? 1.f : 0.f;
            }
            __syncthreads();
            if (F.tid == 0) F.out[O_YP] = 1000.f * (1.f + res[0] + 2.f * res[1] + 4.f * res[2] + 8.f * res[3]);
        }
    }
#endif
#ifdef CHECK_PFM
    if (IN(9)) {
        xcd_barrier(bar);
        if (blockIdx.x == 0) {
            const float* mt = INP(6); const float* ga = INP(7); const float* win = INP(8);
            LAS float* res = (LAS float*)F.lds;
            if (F.wave < 4) {
                const int n = (F.wave == 0) ? 5 : (F.wave == 1 ? 300 : (F.wave == 2 ? 1160 : 200));
                const int col = n < 256 ? 896 + n : (n < 768 ? n - 256 : n);
                const float* xr = mt + (size_t)3 * DM;
                float ss = 0.f; for (int k = F.lane; k < DM; k += 64) ss += xr[k] * xr[k];
                const float rs = frsqrt(wave_sum(ss) / DM + EPS);
                float a = 0.f; for (int k = F.lane; k < DM; k += 64) a += xr[k] * rs * ga[k] * win[(size_t)k * DIN + col];
                a = wave_sum(a);
#if CHECK_PFM == 2
                { const bf16* XNM_ = WSP(bf16, WS_XNM); const bf16* W_ = WSP(bf16, WS_WIN); float a2 = 0.f;
                  for (int k = F.lane; k < DM; k += 64) a2 += bflo((unsigned)XNM_[3 * DM + k]) * bflo((unsigned)W_[(size_t)n * DM + k]);
                  a = wave_sum(a2); }
#elif CHECK_PFM == 3
                { const bf16* XNM_ = WSP(bf16, WS_XNM); float a2 = 0.f;
                  for (int k = F.lane; k < DM; k += 64) a2 += fabsf(bflo((unsigned)XNM_[3 * DM + k]) - xr[k] * rs * ga[k]);
                  a = wave_sum(a2); }
#endif
                const float got = (CHECK_PFM == 3) ? 0.f : WSP(float, WS_PFM)[3 * PFW + n];
                if (F.lane == 0) res[F.wave] = (fabsf(got - a) > 0.03f * fabsf(a) + 0.02f) ? 1.f : 0.f;
            }
            __syncthreads();
            if (F.tid == 0) F.out[O_YP] = 1000.f * (1.f + res[0] + 2.f * res[1] + 4.f * res[2] + 8.f * res[3]);
        }
    }
#endif
#ifdef CHECK_S
    if (IN(9)) {
        xcd_barrier(bar);
        if (blockIdx.x == 0) {
            const float* xp = INP(0); const float* xs = INP(1); const float* sp = INP(4); const float* mt = INP(6); const float* ga = INP(7); const float* win = INP(8); const float* gk = INP(11);
            LAS float* res = (LAS float*)F.lds;
            if (F.wave < 4) {
                const int w = F.wave + 4 * (CHECK_S - 1);
                const int kind = (w == 2 || w == 3 || w == 6 || w == 5) ? 1 : 0;
                const int b = (w == 0) ? 2 : (w == 1 ? 1 : (w == 2 ? 5 : (w == 3 ? 5 : (w == 4 ? 3 : (w == 5 ? 9 : (w == 6 ? 9 : 0))))));
                const int t = (w == 0) ? 3 : (w == 1 ? 116 : (w == 2 ? 3 : (w == 3 ? 3 : (w == 4 ? 2056 : (w == 5 ? 0 : (w == 6 ? 3 : 0))))));
                const float* xr = kind ? xs + ((size_t)b * DSEQ + t) * DM : (t < 16 ? mt + (size_t)t * DM : xp + ((size_t)b * SEQ + (t - 16)) * DM);
                const int pos = kind ? PAST + t : t;
                float ss = 0.f; for (int k = F.lane; k < DM; k += 64) ss += xr[k] * xr[k];
                const float rs = frsqrt(wave_sum(ss) / DM + EPS);
                float err = 0.f, refn = 0.f;
                if (w <= 2) {
                    float a1 = 0.f, a2 = 0.f; const int i = F.lane & 15;
                    for (int k = 0; k < DM; ++k) { const float xn = xr[k] * rs * ga[k]; a1 += xn * win[(size_t)k * DIN + 1152 + i]; a2 += xn * win[(size_t)k * DIN + 1168 + i]; }
                    const double ang = (double)pos * ROPE_INV[i]; const float cs = (float)cos(ang), sn = (float)sin(ang);
                    const float o1 = a1 * cs - a2 * sn, o2 = a2 * cs + a1 * sn;
                    const float* gp = kind ? F.out + O_KRS + ((size_t)b * DSEQ + t) * QKR : F.out + O_KRP + ((size_t)b * TT + t) * QKR;
                    if (F.lane < 16) { err = (gp[i] - o1) * (gp[i] - o1) + (gp[16 + i] - o2) * (gp[16 + i] - o2); refn = o1 * o1 + o2 * o2; }
                } else if (w == 3 || w == 5) {
                    float c[4] = {0.f, 0.f, 0.f, 0.f};
                    for (int k = 0; k < DM; ++k) { const float xn = xr[k] * rs * ga[k]; for (int j = 0; j < 4; ++j) c[j] += xn * win[(size_t)k * DIN + 896 + F.lane * 4 + j]; }
                    const float r2 = frsqrt(wave_sum(c[0] * c[0] + c[1] * c[1] + c[2] * c[2] + c[3] * c[3]) / KVL + EPS);
                    for (int j = 0; j < 4; ++j) { const float ref = c[j] * r2 * gk[F.lane * 4 + j]; const float got = F.out[O_CS + ((size_t)b * DSEQ + t) * KVL + F.lane * 4 + j]; err += (got - ref) * (got - ref); refn += ref * ref; }
                } else if (w == 4 || w == 6) {
                    float u[8] = {0.f, 0.f, 0.f, 0.f, 0.f, 0.f, 0.f, 0.f};
                    for (int k = 0; k < DM; ++k) { const float xn = xr[k] * rs * ga[k]; for (int j = 0; j < 8; ++j) u[j] += xn * win[(size_t)k * DIN + F.lane * 8 + j]; }
                    const float* gp = (w == 4) ? F.out + O_PSP + ((size_t)b * 15 + (t - 2049)) * PW : F.out + O_PSS + ((size_t)b * 15 + 7 + t) * PW;
                    for (int j = 0; j < 8; ++j) { const float got = gp[F.lane * 8 + j]; err += (got - u[j]) * (got - u[j]); refn += u[j] * u[j]; }
                } else if (w == 55) {
                    for (int j = 0; j < 8; ++j) { const float ref = sp[((size_t)b * 15 + 8 + 2) * PW + F.lane * 8 + j]; const float got = F.out[O_PSS + ((size_t)b * 15 + 2) * PW + F.lane * 8 + j]; err += (got - ref) * (got - ref); refn += ref * ref; }
                } else if (w == 7) {
                    const bf16* W_ = WSP(bf16, WS_WIN);
                    for (int j = 0; j < 8; ++j) { const int n = F.lane * 8 + j;
                        for (int k = 0; k < DM; ++k) { const float ref = win[(size_t)k * DIN + n], got = bflo((unsigned)W_[(size_t)(256 + n) * DM + k]); err += (got - ref) * (got - ref); refn += ref * ref; } }
                } else { err = 0.f; refn = 1.f; }
                err = wave_sum(err); refn = wave_sum(refn);
#ifdef CHECK_MAG
                if (F.lane == 0) res[F.wave] = floorf(200.f * sqrtf(err / refn) + 0.5f);
            }
            __syncthreads();
            if (F.tid == 0) F.out[O_YP] = 1000.f * (1.f + res[CHECK_MAG]);
#else
                if (F.lane == 0) res[F.wave] = (err > 0.0004f * refn) ? 1.f : 0.f;
            }
            __syncthreads();
            if (F.tid == 0) F.out[O_YP] = 1000.f * (1.f + res[0] + 2.f * res[1] + 4.f * res[2] + 8.f * res[3]);
#endif
        }
    }
#endif
#ifdef ZERO_META_C
    if (IN(9)) {
        xcd_barrier(bar);
        const size_t gt = (size_t)F.vcu * NWAVES * 64 + F.tid, NGT = (size_t)F.G * NWAVES * 64;
        for (size_t i = gt; i < (size_t)NBATCH * NMETA * KVL; i += NGT) { const size_t b = i / (NMETA * KVL), r = i % (NMETA * KVL); F.out[O_CP + b * TT * KVL + r] = 0.f; }
    }
#endif
#ifdef TAG_Y
    if (IN(9)) {
        xcd_barrier(bar);
        const size_t gt = (size_t)F.vcu * NWAVES * 64 + F.tid, NGT = (size_t)F.G * NWAVES * 64;
        for (size_t i = TAG_Y_LO + gt; i < TAG_Y_HI; i += NGT) F.out[i] *= 1.3f;
    }
#endif
#if defined(DUMP) && DUMP == 99
    if (lo <= 10 && 10 < hi) {
        unsigned e1 = 0, e2 = 0, e3 = 0;
        LAS unsigned* L = (LAS unsigned*)F.lds;
        for (int r = 0; r < 200; ++r) {
            const int slot = (F.tid * 33 + r * 4099) & 32767;
            L[F.tid + 512 * (r & 63)] = (unsigned)(F.tid * 2654435761u + r);
            __syncthreads();
            const int o = (F.tid + 257) & 511;
            if (L[o + 512 * (r & 63)] != (unsigned)(o * 2654435761u + r)) ++e1;
            __syncthreads();
            (void)slot;
        }
        {
            const int fr = F.lane & 15, fq = F.lane >> 4;
            pg8::bf16x8 a, b;
            for (int j = 0; j < 8; ++j) { const int k = 8 * fq + j; a[j] = (short)f2bf((float)((fr + k) % 5 - 2)); b[j] = (short)f2bf((float)((k * 3 + fr) % 7 - 3)); }
            pg8::f32x4 d = (pg8::f32x4){0.f, 0.f, 0.f, 0.f};
            for (int rep = 0; rep < 64; ++rep) d = __builtin_amdgcn_mfma_f32_16x16x32_bf16(a, b, d, 0, 0, 0);
            for (int e = 0; e < 4; ++e) { const int i = 4 * fq + e, jj = fr; float s = 0.f; for (int k = 0; k < 32; ++k) s += (float)((i + k) % 5 - 2) * (float)((k * 3 + jj) % 7 - 3);
                if (d[e] != 64.f * s) ++e2; }
        }
        if (blockDim.x != 512 || gridDim.x != 256 || blockDim.y != 1 || gridDim.y != 1) e3 = 1;
        unsigned e4 = 0, e5 = 0, e6 = 0;
        { const float v = (float)(F.lane + 1); if (wave_sum(v) != 2080.f) e4 = 1;
          const int row = F.lane >> 4; const float want16 = (float)(16 * (16 * row) + 136);
          if (sum_row16(v) != want16) e5 = 1;
          if (wave_max(v) != 64.f) e6 = 1; }
        const float code = (e1 ? 1000.f : 0.f) + (e2 ? 2000.f : 0.f) + (e3 ? 4000.f : 0.f) + (e4 ? 8000.f : 0.f) + (e5 ? 16000.f : 0.f) + (e6 ? 32000.f : 0.f) + 500.f;
#ifdef PROBE_VAL
        { const float v = (float)(F.lane + 1); float r_ = 0.f;
          if (PROBE_VAL == 1) r_ = wave_sum(v); else if (PROBE_VAL == 2) r_ = sum_x16(v); else if (PROBE_VAL == 3) r_ = sum_x32(v); else if (PROBE_VAL == 4) r_ = sum_x16(sum_row16(v)); else if (PROBE_VAL == 5) r_ = sum_x32(sum_row16(v));
          const int pl = PROBE_LANE;
          const float got = __shfl(r_, pl);
          for (int i = F.tid; i < 4096; i += 512) F.out[O_YP + (size_t)blockIdx.x * 4096 + i] = 10.f * got; }
#else
        for (int i = F.tid; i < 4096; i += 512) F.out[O_YP + (size_t)blockIdx.x * 4096 + i] = code;
#endif
    }
#elif defined(DUMP)
    if (lo <= 10 && 10 < hi) {
        const size_t gt = (size_t)F.vcu * NWAVES * 64 + F.tid, NGT = (size_t)F.G * NWAVES * 64;
        for (size_t i = gt; i < (size_t)MP * DM; i += NGT) {
            float v = 0.f;
#if DUMP == 1
            v = WSP(float, WS_PF)[i % ((size_t)MC * PFW)] + bflo((unsigned)WSP(bf16, WS_GATE)[i]) + bflo((unsigned)WSP(bf16, WS_GATE)[i + (size_t)MP * DM]);
#elif DUMP == 99
            v = 0.f;
#elif DUMP == 7
            v = bflo((unsigned)WSP(bf16, WS_XN)[i]) + bflo((unsigned)WSP(bf16, WS_WIN)[i % ((size_t)NIN * DM)]) + bflo((unsigned)WSP(bf16, WS_W1)[i % ((size_t)DFF * DM)]) + bflo((unsigned)WSP(bf16, WS_W2)[i % ((size_t)DFF * DM)])
              + bflo((unsigned)WSP(bf16, WS_WO)[i % ((size_t)DM * DM)]) + bflo((unsigned)WSP(bf16, WS_WKV)[i % ((size_t)1536 * 256)]) + bflo((unsigned)WSP(bf16, WS_WUK)[i % ((size_t)512 * 256)])
              + bflo((unsigned)WSP(bf16, WS_WPL)[i % ((size_t)1024 * 512)]) + bflo((unsigned)WSP(bf16, WS_WUQ)[i % ((size_t)768 * 384)]) + WSP(float, WS_ROPE)[i % (size_t)(2072 * 32)] + bflo((unsigned)WSP(bf16, WS_XNM)[i % (size_t)(16 * 1024)]);
#elif DUMP == 2
            v = bflo((unsigned)WSP(bf16, WS_CB)[i % ((size_t)MC * 256)]) + bflo((unsigned)WSP(bf16, WS_QL)[i % ((size_t)MC * 384)]) + bflo((unsigned)WSP(bf16, WS_DP)[i % ((size_t)MC * 512)])
              + bflo((unsigned)WSP(bf16, WS_KRG)[i % ((size_t)RB * 32)]) + WSP(float, WS_KSS)[i % (size_t)RB];
#elif DUMP == 3
            v = bflo((unsigned)WSP(bf16, WS_QR)[i % ((size_t)MC * 768)]) + bflo((unsigned)WSP(bf16, WS_KH)[i % ((size_t)RB * 768)]) + bflo((unsigned)WSP(bf16, WS_VH)[i % ((size_t)RB * 1024)]) + bflo((unsigned)WSP(bf16, WS_PG)[i]);
#elif DUMP == 4
            v = bflo((unsigned)WSP(bf16, WS_AM)[i]) + WSP(float, WS_SAC)[i % ((size_t)256 * 64 * 256)] + WSP(float, WS_SAL)[i % (size_t)(256 * 64)];
#elif DUMP == 5
            v = bflo((unsigned)WSP(bf16, WS_AM)[i + (size_t)MS * DM]);
#elif DUMP == 6
            v = WSP(float, WS_H)[i + (size_t)MS * DM];
#endif
            F.out[O_YP + i] = v;
        }
    }
#endif
#ifdef STAMP_IDX
    STAMP();
    if (blockIdx.x == 0 && F.tid == 0) { const unsigned long long d_ = stamp_[STAMP_IDX + 1] - stamp_[STAMP_IDX]; F.out[O_YP] = (float)d_ * 0.001f;     }
#endif
#undef IN
#undef SEAM
}

#ifndef MK_N_LAUNCHES
#define MK_N_LAUNCHES 1
#endif
extern "C" void kernel_launch(void* const* d_in, const int* in_sizes, int n_in, void* d_out, int out_size, void* d_ws, size_t ws_size, hipStream_t stream) {
    static int grid = 0;
    if (grid == 0) {
        if (n_in != 24 || out_size != (int)O_END || ws_size < WS_END) { fprintf(stderr, "kernel_launch: unexpected shapes (n_in %d out %d ws %zu need %zu); nothing launched\n", n_in, out_size, ws_size, (size_t)WS_END); grid = -1; return; }
        int dev = 0, cus = 0, per_cu = 0;
        if (hipGetDevice(&dev) != hipSuccess || hipDeviceGetAttribute(&cus, hipDeviceAttributeMultiprocessorCount, dev) != hipSuccess) { grid = -1; return; }
        if (hipFuncSetAttribute((const void*)mk_fwd, hipFuncAttributeMaxDynamicSharedMemorySize, LDS_BYTES) != hipSuccess) { fprintf(stderr, "kernel_launch: hipFuncSetAttribute failed\n"); grid = -1; return; }
        if (hipOccupancyMaxActiveBlocksPerMultiprocessor(&per_cu, (const void*)mk_fwd, NWAVES * 64, LDS_BYTES) != hipSuccess || per_cu < 1) { fprintf(stderr, "kernel_launch: occupancy query says %d blocks per CU\n", per_cu); }
        (void)hipGetLastError();
        grid = cus;
    }
    if (grid < 0) return;
    if (hipMemsetAsync((char*)d_ws + WS_CTL, 0, 32768, stream) != hipSuccess) return;
    Args a{};
    for (int i = 0; i < 24; ++i) a.in[i] = d_in[i];
    a.out = (float*)d_out; a.ws = (unsigned char*)d_ws;
#if MK_N_LAUNCHES == 1
#ifdef DUMP
    a.ph_lo = 0; a.ph_hi = 11;
#else
    a.ph_lo = 0; a.ph_hi = 10;
#endif
    hipLaunchKernelGGL(mk_fwd, dim3(grid), dim3(NWAVES * 64), LDS_BYTES, stream, a);
#else
#ifdef DUMP
    constexpr int NPH = 11;
#else
    constexpr int NPH = 10;
#endif
    for (int p = 0; p < NPH; ++p) { a.ph_lo = p; a.ph_hi = p + 1; hipLaunchKernelGGL(mk_fwd, dim3(grid), dim3(NWAVES * 64), LDS_BYTES, stream, a); }
#endif
}
```

```cpp
#include <hip/hip_runtime.h>
#include <cstdio>
#include <cstdint>
#define USE_PG8 1
namespace pg8 {
#define PG8_LAS __attribute__((address_space(3)))
typedef unsigned short bf16_t;
typedef short bf16x8 __attribute__((ext_vector_type(8)));
typedef float f32x4 __attribute__((ext_vector_type(4)));
typedef unsigned u32x4 __attribute__((ext_vector_type(4)));
constexpr int BM = 256, BK = 64, HALF = 128, HTB = HALF * BK * 2  , STAGE_BYTES = 8 * HTB, NXCD = 8, WGM = 8;

__host__ __device__ __forceinline__ int lds_byte(int r, int c) { const int st = (r >> 4) * 2 + (c >> 5), rr = r & 15, cc = c & 31, ob = rr * 64 + cc * 2; return st * 1024 + (ob ^ (((ob >> 9) & 1) << 5)); }
__host__ __device__ __forceinline__ void stage_rc(int b, int& R, int& C) { const int st = b / 1024, sb = b % 1024, swz = sb ^ (((sb >> 9) & 1) << 5); R = (st >> 1) * 16 + swz / 64; C = (st & 1) * 32 + (swz % 64) / 2; }
__host__ __device__ __forceinline__ int perm32(int rho) { const int n = rho >> 4, i = rho & 15; return 8 * (i >> 2) + 4 * n + (i & 3); }

struct Unit { int pm, pn; };
struct Gemm { const bf16_t* A; const bf16_t* Bt; int M, N, K; };

struct StaticOrder {
    int nM, nN, nwg, G, c;
    __host__ __device__ void init(int M, int N, int G_, int c_) { nM = M / BM; nN = N / BM; nwg = nM * nN; G = G_; c = c_; }
    __host__ __device__ bool next(int i, Unit& u) const {
        const long L = (long)i * G + c; if (L >= nwg) return false;
        int wgid = (int)L; { const int q = nwg / NXCD, r = nwg % NXCD, xcd = wgid % NXCD, off = wgid / NXCD; wgid = (xcd < r ? xcd * (q + 1) : r * (q + 1) + (xcd - r) * q) + off; }
        const int nig = WGM * nN, gid = wgid / nig, fm = gid * WGM, gsz = (nM - fm) < WGM ? (nM - fm) : WGM;
        u.pm = fm + ((wgid % nig) % gsz); u.pn = (wgid % nig) / gsz; return true;
    }
    __device__ __forceinline__ void a_ready(const Unit&) const {}
    __device__ __forceinline__ void done(const Unit&) const {}
};

template <class Epi, class Sched, bool ALIGN_EPI = false, bool SP2 = false>
__device__ __forceinline__ void gemm_phase(PG8_LAS unsigned char* lds, const Gemm g, const Sched& S, const Epi& E) {
    const int tid = threadIdx.x, wid = __builtin_amdgcn_readfirstlane(tid >> 6), lane = tid & 63, wr = wid >> 2, wc = wid & 3, fr = lane & 15, fq = lane >> 4;
    const int K = g.K, nt = K / BK;
    unsigned voffA[2], voffB[2];
#pragma unroll
    for (int i = 0; i < 2; ++i) { int R, C; stage_rc(tid * 16 + i * 8192, R, C); const int Rb = Epi::PERM ? ((R & ~31) + perm32(R & 31)) : R;
        voffA[i] = (unsigned)(R * K + C) * 2u; voffB[i] = (unsigned)(Rb * K + C) * 2u; }
    const size_t kstep = (size_t)(BK * 2);
    const size_t hstep = (size_t)HALF * K * 2;
    const size_t tstep = 2 * hstep;
    const unsigned ldsw = (unsigned)wid * 1024u;
    const int aoff = lds_byte(wr * 64 + fr, fq * 8), boff = lds_byte(wc * 32 + fr, fq * 8);
#define PG8_SA(b, h) (((b) * 2 + (h)) * HTB)
#define PG8_SB(b, h) ((4 + (b) * 2 + (h)) * HTB)
#define PG8_STAGE(bufoff, gbase, voff) do { _Pragma("unroll") for (int _i = 0; _i < 2; ++_i) \
        __builtin_amdgcn_global_load_lds((const unsigned*)((const char*)(gbase) + (voff)[_i]), (PG8_LAS unsigned*)(lds + (bufoff) + ldsw + _i * 8192), 16, 0, 0); } while (0)
#define PG8_LDA(dst, b, h) do { _Pragma("unroll") for (int m = 0; m < 4; ++m) _Pragma("unroll") for (int k = 0; k < 2; ++k) dst[m][k] = *(const PG8_LAS bf16x8*)(lds + PG8_SA(b, h) + aoff + m * 2048 + k * 1024); } while (0)
#define PG8_LDB(dst, b, h) do { _Pragma("unroll") for (int n = 0; n < 2; ++n) _Pragma("unroll") for (int k = 0; k < 2; ++k) dst[n][k] = *(const PG8_LAS bf16x8*)(lds + PG8_SB(b, h) + boff + n * 2048 + k * 1024); } while (0)
#define PG8_MMA(ai, bj, At, Bt) do { __builtin_amdgcn_s_setprio(1); _Pragma("unroll") for (int m = 0; m < 4; ++m) _Pragma("unroll") for (int n = 0; n < 2; ++n) _Pragma("unroll") for (int k = 0; k < 2; ++k) \
        acc[ai][bj][m][n] = __builtin_amdgcn_mfma_f32_16x16x32_bf16(Bt[n][k], At[m][k], acc[ai][bj][m][n], 0, 0, 0); __builtin_amdgcn_s_setprio(0); } while (0)
#ifdef SAFE_WAITS
#define PG8_WAIT_V(n) asm volatile("s_waitcnt vmcnt(0)" ::: "memory")
#else
#define PG8_WAIT_V(n) asm volatile("s_waitcnt vmcnt(" #n ")" ::: "memory")
#endif
#define PG8_WAIT_L(n) asm volatile("s_waitcnt lgkmcnt(" #n ")" ::: "memory")
#define PG8_BAR __builtin_amdgcn_s_barrier()
#define PG8_SCHED __builtin_amdgcn_sched_barrier(0)
    Unit cur, nxt; int ui = 0;
    if (!S.next(0, cur)) return;
    f32x4 acc[2][2][4][2];
#pragma unroll
    for (int a = 0; a < 2; ++a)
#pragma unroll
        for (int b = 0; b < 2; ++b)
#pragma unroll
            for (int m = 0; m < 4; ++m)
#pragma unroll
                for (int n = 0; n < 2; ++n) acc[a][b][m][n] = (f32x4){0.f, 0.f, 0.f, 0.f};
    bf16x8 At[4][2], B0[2][2], B1[2][2];
    const char* cA = (const char*)g.A + (size_t)cur.pm * tstep; const char* cB = (const char*)g.Bt + (size_t)cur.pn * tstep;
    S.a_ready(cur);
    if constexpr (SP2) {
        PG8_STAGE(PG8_SB(0, 0), cB, voffB); PG8_STAGE(PG8_SB(0, 1), cB + hstep, voffB); PG8_STAGE(PG8_SA(0, 0), cA, voffA); PG8_STAGE(PG8_SA(0, 1), cA + hstep, voffA);
        if (wr == 1) PG8_BAR;
        PG8_WAIT_V(2); PG8_BAR;
        PG8_STAGE(PG8_SB(1, 0), cB + kstep, voffB); PG8_STAGE(PG8_SA(1, 0), cA + kstep, voffA); PG8_STAGE(PG8_SB(1, 1), cB + hstep + kstep, voffB);
        PG8_WAIT_V(6); PG8_BAR;
    } else {
        PG8_STAGE(PG8_SB(0, 0), cB, voffB); PG8_STAGE(PG8_SA(0, 0), cA, voffA); PG8_STAGE(PG8_SB(0, 1), cB + hstep, voffB); PG8_STAGE(PG8_SA(0, 1), cA + hstep, voffA);
        if (wr == 1) PG8_BAR;
        PG8_WAIT_V(4); PG8_BAR;
        PG8_STAGE(PG8_SB(1, 0), cB + kstep, voffB); PG8_STAGE(PG8_SA(1, 0), cA + kstep, voffA); PG8_STAGE(PG8_SB(1, 1), cB + hstep + kstep, voffB);
        PG8_WAIT_V(6); PG8_BAR;
    }
    for (;;) {
        const bool has_next = S.next(ui + 1, nxt);
        const char* nA = has_next ? (const char*)g.A + (size_t)nxt.pm * tstep : cA; const char* nB = has_next ? (const char*)g.Bt + (size_t)nxt.pn * tstep : cB;
        for (int t = 0; t < nt; t += 2) {
            const bool last = (t == nt - 2);
            const char* a1 = cA + (size_t)(t + 1) * kstep;
            const char* a2 = last ? nA : cA + (size_t)(t + 2) * kstep; const char* b2 = last ? nB : cB + (size_t)(t + 2) * kstep;
            const char* a3 = a2 + kstep; const char* b3 = b2 + kstep;
            if (last && has_next) S.a_ready(nxt);
            if constexpr (SP2) {
            PG8_LDB(B0, 0, 0); PG8_LDB(B1, 0, 1); PG8_SCHED; PG8_LDA(At, 0, 0); PG8_STAGE(PG8_SA(1, 1), a1 + hstep, voffA);
            PG8_WAIT_V(8); PG8_WAIT_L(0); PG8_BAR; PG8_MMA(0, 0, At, B0); PG8_MMA(0, 1, At, B1); PG8_BAR; PG8_SCHED;
            PG8_LDA(At, 0, 1); PG8_STAGE(PG8_SB(0, 0), b2, voffB); PG8_STAGE(PG8_SB(0, 1), b2 + hstep, voffB); PG8_STAGE(PG8_SA(0, 0), a2, voffA);
            PG8_WAIT_V(8); PG8_WAIT_L(0); PG8_BAR; PG8_MMA(1, 0, At, B0); PG8_MMA(1, 1, At, B1); PG8_BAR; PG8_SCHED;
            PG8_LDB(B0, 1, 0); PG8_LDB(B1, 1, 1); PG8_SCHED; PG8_LDA(At, 1, 0); PG8_STAGE(PG8_SA(0, 1), a2 + hstep, voffA);
            PG8_WAIT_V(8); PG8_WAIT_L(0); PG8_BAR; PG8_MMA(0, 0, At, B0); PG8_MMA(0, 1, At, B1); PG8_BAR; PG8_SCHED;
            PG8_LDA(At, 1, 1); PG8_STAGE(PG8_SB(1, 0), b3, voffB); PG8_STAGE(PG8_SB(1, 1), b3 + hstep, voffB); PG8_STAGE(PG8_SA(1, 0), a3, voffA);
            PG8_WAIT_V(8); PG8_WAIT_L(0); PG8_BAR; PG8_MMA(1, 0, At, B0); PG8_MMA(1, 1, At, B1); PG8_BAR; PG8_SCHED;
            } else {
            PG8_LDB(B0, 0, 0); PG8_SCHED; PG8_LDA(At, 0, 0); PG8_STAGE(PG8_SA(1, 1), a1 + hstep, voffA);
            PG8_WAIT_L(8); PG8_BAR; PG8_WAIT_L(0); PG8_MMA(0, 0, At, B0); PG8_BAR; PG8_SCHED;
            PG8_LDB(B1, 0, 1); PG8_STAGE(PG8_SB(0, 0), b2, voffB);
            PG8_BAR; PG8_WAIT_L(0); PG8_MMA(0, 1, At, B1); PG8_BAR;
            PG8_LDA(At, 0, 1); PG8_STAGE(PG8_SA(0, 0), a2, voffA);
            PG8_BAR; PG8_WAIT_L(0); PG8_MMA(1, 0, At, B0); PG8_BAR; PG8_SCHED;
            PG8_STAGE(PG8_SB(0, 1), b2 + hstep, voffB);
            PG8_WAIT_V(6); PG8_BAR; PG8_MMA(1, 1, At, B1); PG8_BAR;
            PG8_LDB(B0, 1, 0); PG8_SCHED; PG8_LDA(At, 1, 0); PG8_STAGE(PG8_SA(0, 1), a2 + hstep, voffA);
            PG8_WAIT_L(8); PG8_BAR; PG8_WAIT_L(0); PG8_MMA(0, 0, At, B0); PG8_BAR; PG8_SCHED;
            PG8_LDB(B1, 1, 1); PG8_STAGE(PG8_SB(1, 0), b3, voffB);
            PG8_BAR; PG8_WAIT_L(0); PG8_MMA(0, 1, At, B1); PG8_BAR;
            PG8_LDA(At, 1, 1); PG8_STAGE(PG8_SA(1, 0), a3, voffA);
            PG8_BAR; PG8_WAIT_L(0); PG8_MMA(1, 0, At, B0); PG8_BAR; PG8_SCHED;
            PG8_STAGE(PG8_SB(1, 1), b3 + hstep, voffB);
            PG8_WAIT_V(6); PG8_BAR; PG8_MMA(1, 1, At, B1); PG8_BAR;
            }
        }
        if constexpr (ALIGN_EPI) { if (wr == 0) PG8_BAR; }
        if constexpr (!Epi::AFTER_DRAIN) { E(acc, cur, wr, wc, fr, fq); S.done(cur); }
        if (!has_next) break;
#pragma unroll
        for (int a = 0; a < 2; ++a)
#pragma unroll
            for (int b = 0; b < 2; ++b)
#pragma unroll
                for (int m = 0; m < 4; ++m)
#pragma unroll
                    for (int n = 0; n < 2; ++n) acc[a][b][m][n] = (f32x4){0.f, 0.f, 0.f, 0.f};
        cur = nxt; cA = nA; cB = nB; ++ui;
        if constexpr (ALIGN_EPI) { if (wr == 1) PG8_BAR; }
    }
    PG8_WAIT_V(0);
    if constexpr (!ALIGN_EPI) { if (wr == 0) PG8_BAR; }
    PG8_BAR;
    if constexpr (Epi::AFTER_DRAIN) { E.fused(acc, cur, wr, wc, fr, fq, lds, wid, lane); S.done(cur); }
#undef PG8_SA
#undef PG8_SB
#undef PG8_STAGE
#undef PG8_LDA
#undef PG8_LDB
#undef PG8_MMA
#undef PG8_WAIT_V
#undef PG8_WAIT_L
#undef PG8_BAR
#undef PG8_SCHED
}
}
#ifndef PG8_SP2
#define PG8_SP2 true
#endif
#ifndef PG8_ALIGN
#define PG8_ALIGN true
#endif
constexpr int NWAVES = 8;
constexpr int DM = 1024, NBATCH = 16, SEQ = 2048, NMETA = 16, TT = SEQ + NMETA, DBATCH = 128, DSEQ = 8, PAST = 8192, PAGE = 128, NPAGES = 64;
constexpr int NHEAD = 8, QKN = 64, QKR = 32, QKH = 96, VHD = 128, QLORA = 384, KVL = 256, PW = 512, DFF = 4096, DIN = 3232;
constexpr int MP = NBATCH * SEQ, MS = DBATCH * DSEQ, MC = MP + MS, MCX = MC + 256;
constexpr int NIN = 3328, PFW = 1280;
constexpr int RB = NBATCH * TT;
constexpr float EPS = 1e-6f;
constexpr float SCALE_L2E = 0.10206207261596575f * 1.4426950408889634f;
constexpr size_t O_YP = 0, O_YS = O_YP + (size_t)MP * DM, O_CP = O_YS + (size_t)MS * DM, O_KRP = O_CP + (size_t)RB * KVL, O_PSP = O_KRP + (size_t)RB * QKR,
                 O_CS = O_PSP + (size_t)NBATCH * 15 * PW, O_KRS = O_CS + (size_t)MS * KVL, O_PSS = O_KRS + (size_t)MS * QKR, O_END = O_PSS + (size_t)DBATCH * 15 * PW;
static_assert(O_END == 45514752, "d_out size");
constexpr size_t al256(size_t x) { return (x + 255) & ~(size_t)255; }
constexpr size_t WS_CTL = 0, CTL_BYTES = 1u << 20;
constexpr size_t WS_WIN = CTL_BYTES;
constexpr size_t WS_WUQ = WS_WIN + al256((size_t)NIN * DM * 2);
constexpr size_t WS_WKV = WS_WUQ + al256((size_t)768 * 384 * 2);
constexpr size_t WS_WUK = WS_WKV + al256((size_t)1536 * 256 * 2);
constexpr size_t WS_WPL = WS_WUK + al256((size_t)512 * 256 * 2);
constexpr size_t WS_WO = WS_WPL + al256((size_t)1024 * 512 * 2);
constexpr size_t WS_W1 = WS_WO + al256((size_t)DM * DM * 2);
constexpr size_t WS_W2 = WS_W1 + al256((size_t)DFF * DM * 2);
constexpr size_t WS_ROPE = WS_W2 + al256((size_t)DFF * DM * 2);
constexpr size_t WS_XNM = WS_ROPE + al256((size_t)2072 * 32 * 4);
constexpr size_t WS_PFM = WS_XNM + al256(16 * 1024 * 2);
constexpr size_t WS_CM = WS_PFM + al256(16 * 1280 * 4);
constexpr size_t WS_KRM = WS_CM + al256(16 * 256 * 4);
constexpr size_t WS_KSM = WS_KRM + al256(16 * 32 * 4);
constexpr size_t WS_XN = WS_KSM + 256;
constexpr size_t WS_PF = WS_XN + al256((size_t)MCX * DM * 2);
constexpr size_t WS_GATE = WS_PF + al256((size_t)MCX * PFW * 4);
constexpr size_t WS_CB = WS_GATE + al256((size_t)MCX * 2048 * 2);
constexpr size_t WS_KRG = WS_CB + al256((size_t)MC * 256 * 2);
constexpr size_t WS_KSS = WS_KRG + al256((size_t)(RB + 64) * 32 * 2);
constexpr size_t WS_QL = WS_KSS + al256((size_t)(RB + 64) * 4);
constexpr size_t WS_DP = WS_QL + al256((size_t)MC * 384 * 2);
constexpr size_t WS_QR = WS_DP + al256((size_t)MC * 512 * 2);
constexpr size_t WS_KH = WS_QR + al256((size_t)MC * 768 * 2);
constexpr size_t WS_VH = WS_KH + al256((size_t)(RB + 64) * 768 * 2);
constexpr size_t WS_PG = WS_VH + al256((size_t)(RB + 64) * 1024 * 2);
constexpr size_t WS_AM = WS_PG + al256((size_t)MC * DM * 2);
constexpr size_t WS_SAC = WS_AM + al256((size_t)MC * DM * 2);
constexpr size_t WS_SAL = WS_SAC + al256((size_t)256 * 64 * 256 * 4);
constexpr size_t WS_H = WS_SAL + al256((size_t)256 * 64 * 4);
constexpr size_t WS_HN = WS_H + al256((size_t)MC * DM * 4);
constexpr size_t WS_Z = WS_HN + al256((size_t)MC * DM * 2);
constexpr size_t WS_WOS = WS_Z + al256((size_t)MC * DFF * 2);
constexpr size_t WS_W2S = WS_WOS + al256((size_t)DM * DM * 2);
constexpr size_t WS_AMS = WS_W2S + al256((size_t)DFF * DM * 2);
constexpr size_t WS_HS = WS_AMS + al256((size_t)MS * DM * 2);
constexpr size_t WS_ZS = WS_HS + al256((size_t)4 * MS * DM * 4);
constexpr size_t WS_YS = WS_ZS + al256((size_t)MS * DFF * 2);
constexpr size_t WS_PB = WS_YS + al256((size_t)8 * MS * DM * 4);
constexpr size_t WS_HB = WS_PB + al256((size_t)MCX * PFW * 2);
constexpr size_t WS_END = WS_HB + al256((size_t)MP * DM * 2);
constexpr int CW_TMO = 0, CW_CODE = 1, CW_BAR = 4096;
#ifdef SMALL_LDS
constexpr int RING_OFF = 0, RING_BYTES = 147456;
#else
constexpr int RING_OFF = 0, RING_BYTES = 161792;
#endif
constexpr int LDSCTL_OFF = RING_BYTES, MISC_OFF = LDSCTL_OFF + 320;
constexpr int LDS_BYTES = RING_BYTES + 512;
static_assert(LDS_BYTES <= 163840, "LDS");

#define GAS __attribute__((address_space(1)))
#define LAS __attribute__((address_space(3)))
typedef unsigned short bf16;
typedef unsigned v4u __attribute__((ext_vector_type(4)));
typedef unsigned v2u __attribute__((ext_vector_type(2)));
typedef float f32x4 __attribute__((ext_vector_type(4)));
typedef float f32x2 __attribute__((ext_vector_type(2)));
typedef float f32x16 __attribute__((ext_vector_type(16)));
typedef short bf16x8 __attribute__((ext_vector_type(8)));
typedef short s16x4 __attribute__((ext_vector_type(4)));
typedef GAS unsigned gu32;
#define RLX_AGENT __ATOMIC_RELAXED, __HIP_MEMORY_SCOPE_AGENT
#define LDS_WAIT() asm volatile("s_waitcnt lgkmcnt(0)" ::: "memory")
#define VM_WAIT() asm volatile("s_waitcnt vmcnt(0)" ::: "memory")
#define SBAR() __builtin_amdgcn_sched_barrier(0)
__device__ __forceinline__ unsigned f2bf(float f) { unsigned u = __builtin_bit_cast(unsigned, f); return (u + 0x7fffu + ((u >> 16) & 1u)) >> 16; }
typedef float f32x2_t __attribute__((ext_vector_type(2))); typedef __bf16 bf16x2_t __attribute__((ext_vector_type(2)));
__device__ __forceinline__ unsigned pk2(float lo, float hi) { const f32x2_t v = {lo, hi}; const bf16x2_t b = __builtin_convertvector(v, bf16x2_t); return __builtin_bit_cast(unsigned, b); }
__device__ __forceinline__ float bflo(unsigned u) { return __builtin_bit_cast(float, u << 16); }
__device__ __forceinline__ float bfhi(unsigned u) { return __builtin_bit_cast(float, u & 0xffff0000u); }
template <int CTRL> __device__ __forceinline__ float dppf(float v) { return __builtin_bit_cast(float, __builtin_amdgcn_update_dpp(0, __builtin_bit_cast(int, v), CTRL, 0xf, 0xf, true)); }
__device__ __forceinline__ float sum_x16(float v) { const unsigned u = __float_as_uint(v); auto r = __builtin_amdgcn_permlane16_swap(u, u, false, false); return __uint_as_float(r[0]) + __uint_as_float(r[1]); }
__device__ __forceinline__ float sum_x32(float v) { const unsigned u = __float_as_uint(v); auto r = __builtin_amdgcn_permlane32_swap(u, u, false, false); return __uint_as_float(r[0]) + __uint_as_float(r[1]); }
__device__ __forceinline__ float max_x16(float v) { const unsigned u = __float_as_uint(v); auto r = __builtin_amdgcn_permlane16_swap(u, u, false, false); return fmaxf(__uint_as_float(r[0]), __uint_as_float(r[1])); }
__device__ __forceinline__ float max_x32(float v) { const unsigned u = __float_as_uint(v); auto r = __builtin_amdgcn_permlane32_swap(u, u, false, false); return fmaxf(__uint_as_float(r[0]), __uint_as_float(r[1])); }
__device__ __forceinline__ float sum_quad(float v) { v += dppf<0xB1>(v); v += dppf<0x4E>(v); return v; }
__device__ __forceinline__ float sum_oct(float v) { v = sum_quad(v); v += dppf<0x141>(v); return v; }
__device__ __forceinline__ float sum_row16(float v) { v = sum_oct(v); v += dppf<0x140>(v); return v; }
__device__ __forceinline__ float wave_sum(float v) { return sum_x32(sum_x16(sum_row16(v))); }
__device__ __forceinline__ float wave_max(float v) { v = fmaxf(v, dppf<0xB1>(v)); v = fmaxf(v, dppf<0x4E>(v)); v = fmaxf(v, dppf<0x141>(v)); v = fmaxf(v, dppf<0x140>(v)); return max_x32(max_x16(v)); }
__device__ __forceinline__ float frsqrt(float x) { return 1.0f / sqrtf(x); }
__constant__ double ROPE_INV[16] = { 1.0, 0.5623413251903491, 0.31622776601683794, 0.1778279410038923, 0.1, 0.05623413251903491, 0.03162277660168379, 0.01778279410038923,
    0.01, 0.005623413251903491, 0.0031622776601683794, 0.001778279410038923, 0.001, 0.0005623413251903491, 0.00031622776601683794, 0.0001778279410038923 };
#define XB_TMO      128
#define XB_XCNT(j)  (256  + 64 * (j))
#define XB_XSUB(j)  (1280 + 64 * (j))
#define XB_XGEN(j)  (2304 + 64 * (j))
#define XB_TOP      3328
#define XB_TOPGEN   3392
#define XCD_BAR_WORDS 3456
#define XB_SPIN_CAP (1u << 18)

__device__ __forceinline__ unsigned xb_ld(unsigned* p)              { return __hip_atomic_load(p, __ATOMIC_RELAXED, __HIP_MEMORY_SCOPE_AGENT); }
__device__ __forceinline__ unsigned xb_add(unsigned* p, unsigned v) { return __hip_atomic_fetch_add(p, v, __ATOMIC_RELAXED, __HIP_MEMORY_SCOPE_AGENT); }
__device__ __forceinline__ unsigned xb_xcc_id() { return (unsigned)__builtin_amdgcn_s_getreg((3 << 11) | 20) & 0xFu; }
#define XB_SPIN(cond, bar) do { unsigned _sp = 0; while (cond) { __builtin_amdgcn_s_sleep(1); \
    if ((++_sp & 255u) == 0u) { if (xb_ld(&(bar)[XB_TMO])) break; if (_sp > XB_SPIN_CAP) { atomicAdd(&(bar)[XB_TMO], 1u); break; } } } } while (0)

struct XcdBarrier {
    unsigned* bar; unsigned x;
    volatile LAS unsigned* st;
};

__device__ __forceinline__ XcdBarrier xcd_barrier_post(unsigned* bar, volatile LAS unsigned* st) {
    XcdBarrier b; b.bar = bar; b.x = xb_xcc_id(); b.st = st;
    if (threadIdx.x == 0) (void)xb_add(&bar[XB_XCNT(b.x)], 1u);
    return b;
}
__device__ __forceinline__ void xcd_barrier_complete(unsigned* bar, unsigned x, unsigned& nloc, unsigned& nx) {
    const unsigned G = gridDim.x * gridDim.y * gridDim.z;
    unsigned sum, cnt, mine, sp = 0u;
    for (;;) {
        sum = 0u; cnt = 0u; mine = 0u;
#pragma unroll
        for (unsigned j = 0; j < 16; ++j) { const unsigned c = xb_ld(&bar[XB_XCNT(j)]); sum += c; cnt += (c > 0u) ? 1u : 0u; mine = (j == x) ? c : mine; }
        if (sum == G) break;
        __builtin_amdgcn_s_sleep(1);
        if ((++sp & 255u) == 0u) { if (xb_ld(&bar[XB_TMO])) break; if (sp > XB_SPIN_CAP) { atomicAdd(&bar[XB_TMO], 1u); break; } }
    }
    nloc = mine > 0u ? mine : 1u; nx = cnt > 0u ? cnt : 1u;
}

__device__ __forceinline__ void xcd_barrier(const XcdBarrier& b) {
    asm volatile("s_waitcnt vmcnt(0)" ::: "memory");
    __syncthreads();
    if (threadIdx.x == 0) {
        unsigned* bar = b.bar;
        __builtin_amdgcn_s_waitcnt(0);
        unsigned nloc = b.st[0], nx = b.st[1];
        if (nloc == 0u) { xcd_barrier_complete(bar, b.x, nloc, nx); b.st[0] = nloc; b.st[1] = nx; }
        const unsigned old = xb_add(&bar[XB_XSUB(b.x)], 1u);
        const unsigned gen = old / nloc;
        if (old + 1u == (gen + 1u) * nloc) {
            __builtin_amdgcn_fence(__ATOMIC_RELEASE, "agent");
            asm volatile("s_waitcnt vmcnt(0)" ::: "memory");
            const unsigned og = xb_add(&bar[XB_TOP], 1u);
            const unsigned tg = og / nx;
            if (og + 1u == (tg + 1u) * nx) xb_add(&bar[XB_TOPGEN], 1u);
            else XB_SPIN(xb_ld(&bar[XB_TOPGEN]) == tg, bar);
            __builtin_amdgcn_fence(__ATOMIC_ACQUIRE, "agent");
            xb_add(&bar[XB_XGEN(b.x)], 1u);
            asm volatile("s_waitcnt vmcnt(0)" ::: "memory");
        } else {
            XB_SPIN(xb_ld(&bar[XB_XGEN(b.x)]) == gen, bar);
            __builtin_amdgcn_fence(__ATOMIC_ACQUIRE, "agent");
            asm volatile("s_waitcnt vmcnt(0)" ::: "memory");
        }
    }
    __syncthreads();
}
struct Frame {
    LAS unsigned char* lds;
    volatile LAS unsigned* MISC;
    gu32* ctl;
    int tid, lane, wave, vcu, G;
    const float *x_prompt, *x_sample, *cache_c, *cache_kr, *state_pool; const int* page_table;
    const float *meta_tokens, *g_attn, *w_in, *g_q_lat, *w_uq, *g_kv_lat, *g_qn_nope, *g_qn_rope, *w_uk, *g_kn_nope, *g_kn_rope, *w_uv, *w_pool_map, *pool_scale, *w_o, *g_mlp, *w_ff1, *w_ff2;
    float* out; unsigned char* ws;
};
#define WSP(T, off) ((T*)(F.ws + (off)))

__device__ __forceinline__ void p0_tr_block(const float* W, int ldw, bf16* dst, bf16* dst2, int pitch, int pitch2, bool zero, LAS float* scr, int lane) {
    const int c = lane & 7;
    if (zero) {
#pragma unroll
        for (int j = 0; j < 4; ++j) { const int n = (lane >> 3) + 8 * j; *(GAS v4u*)(dst + (size_t)n * pitch + 8 * c) = (v4u){0u, 0u, 0u, 0u}; }
        return;
    }
    {
        const int r8 = lane >> 3, c4 = lane & 7; const float* wp = W + (size_t)r8 * ldw + 4 * c4;
        f32x4 v[8];
#pragma unroll
        for (int i = 0; i < 8; ++i) v[i] = __builtin_nontemporal_load((const GAS f32x4*)(wp + (size_t)(8 * i) * ldw));
#pragma unroll
        for (int i = 0; i < 8; ++i) { LAS float* s = scr + (8 * i + r8) * 33 + 4 * c4; s[0] = v[i].x; s[1] = v[i].y; s[2] = v[i].z; s[3] = v[i].w; }
    }
    LDS_WAIT(); asm volatile("" ::: "memory");
#pragma unroll
    for (int j = 0; j < 4; ++j) { const int n = (lane >> 3) + 8 * j; const LAS float* s = scr + (8 * c) * 33 + n;
        v4u o; o.x = pk2(s[0 * 33], s[1 * 33]); o.y = pk2(s[2 * 33], s[3 * 33]); o.z = pk2(s[4 * 33], s[5 * 33]); o.w = pk2(s[6 * 33], s[7 * 33]);
        *(GAS v4u*)(dst + (size_t)n * pitch + 8 * c) = o;
        if (dst2) *(GAS v4u*)(dst2 + (size_t)n * pitch2 + 8 * c) = o; }
    LDS_WAIT(); asm volatile("" ::: "memory");
}
__device__ __forceinline__ int in_row(int n0) { return n0 < 512 ? 256 + n0 : (n0 < 896 ? 768 + (n0 - 512) : (n0 < 1152 ? n0 - 896 : (n0 < 1184 ? n0 : 1280 + (n0 - 1184)))); }

__device__ __forceinline__ void p0_weights(Frame& F, int it0, int it1, int gw, int NGW) {
    LAS float* scr = (LAS float*)(F.lds + RING_OFF + F.wave * 16384);
    const int lane = F.lane;
    bf16* Win_t = WSP(bf16, WS_WIN); bf16* Wuq_t = WSP(bf16, WS_WUQ); bf16* Wkv_t = WSP(bf16, WS_WKV); bf16* Wuk_t = WSP(bf16, WS_WUK); bf16* Wpl_t = WSP(bf16, WS_WPL);
    bf16* Wo_t = WSP(bf16, WS_WO); bf16* W1_t = WSP(bf16, WS_W1); bf16* W2_t = WSP(bf16, WS_W2);
    constexpr int I_1 = 16 * 128, I_2 = 64 * 32, I_O = 16 * 32, I_IN = 16 * 101, I_PL = 2 * 32, I_UQ = 6 * 24, I_UV = 4 * 32, I_UK = 4 * 16, I_INZ = 16 * 3;
    for (int it = it0 + gw; it < it1; it += NGW) {
        int r = it; const float* W; int ldw, pitch, pitch2 = 0; bf16* dst; bf16* dst2 = nullptr; bool zero = false;
        if (r < I_1) { const int kb = r / 128, nb = r % 128; W = F.w_ff1 + (size_t)(64 * kb) * DFF + 32 * nb; ldw = DFF; pitch = DM; dst = W1_t + (size_t)(32 * nb) * DM + 64 * kb; }
        else if ((r -= I_1) < I_2) { const int kb = r / 32, nb = r % 32; W = F.w_ff2 + (size_t)(64 * kb) * DM + 32 * nb; ldw = DM; pitch = DFF; dst = W2_t + (size_t)(32 * nb) * DFF + 64 * kb;
            dst2 = WSP(bf16, WS_W2S) + ((size_t)(kb >> 3) * DM + 32 * nb) * 512 + 64 * (kb & 7); pitch2 = 512; }
        else if ((r -= I_2) < I_O) { const int kb = r / 32, nb = r % 32; W = F.w_o + (size_t)(64 * kb) * DM + 32 * nb; ldw = DM; pitch = DM; dst = Wo_t + (size_t)(32 * nb) * DM + 64 * kb;
            dst2 = WSP(bf16, WS_WOS) + ((size_t)(kb >> 2) * DM + 32 * nb) * 256 + 64 * (kb & 3); pitch2 = 256; }
        else if ((r -= I_O) < I_IN) { const int kb = r / 101, nb = r % 101; W = F.w_in + (size_t)(64 * kb) * DIN + 32 * nb; ldw = DIN; pitch = DM; dst = Win_t + (size_t)in_row(32 * nb) * DM + 64 * kb; }
        else if ((r -= I_IN) < I_PL) { const int kb = r / 32, nb = r % 32, g = nb / 8;
            pitch = 128; dst = Wpl_t + (size_t)(32 * nb) * 128 + 64 * kb; ldw = 256;
            W = F.w_pool_map + (size_t)g * 128 * 256 + (size_t)(64 * kb) * 256 + (32 * nb - 256 * g); }
        else if ((r -= I_PL) < I_UQ) { const int kb = r / 24, nb = r % 24; W = F.w_uq + (size_t)(64 * kb) * 768 + 32 * nb; ldw = 768; pitch = QLORA; dst = Wuq_t + (size_t)(32 * nb) * QLORA + 64 * kb; }
        else if ((r -= I_UQ) < I_UV) { const int kb = r / 32, nb = r % 32; W = F.w_uv + (size_t)(64 * kb) * 1024 + 32 * nb; ldw = 1024; pitch = KVL; dst = Wkv_t + (size_t)(512 + 32 * nb) * KVL + 64 * kb; }
        else if ((r -= I_UV) < I_UK) { const int kb = r / 16, nb = r % 16, h = nb >> 1, d0 = (nb & 1) * 32; W = F.w_uk + (size_t)(64 * kb) * 512 + 32 * nb; ldw = 512; pitch = KVL;
            dst = Wkv_t + (size_t)(256 * (h >> 2) + 128 * (d0 >> 5) + 32 * (h & 3)) * KVL + 64 * kb; dst2 = Wuk_t + (size_t)(32 * nb) * KVL + 64 * kb; pitch2 = KVL; }
        else { r -= I_UK; const int kb = r / 3, nb = r % 3; W = F.w_in; ldw = DIN; pitch = DM; dst = Win_t + (size_t)(1184 + 32 * nb) * DM + 64 * kb; zero = true; }
        p0_tr_block(W, ldw, dst, dst2, pitch, pitch2, zero, scr, lane);
    }
}
constexpr int P0_LATE_ITEMS = 16 * 128 + 64 * 32 + 16 * 32, P0_ALL_ITEMS = P0_LATE_ITEMS + 16 * 101 + 2 * 32 + 6 * 24 + 4 * 32 + 4 * 16 + 16 * 3;
__device__ __forceinline__ void p0_prologue(Frame& F) {
    const int gw = F.vcu * NWAVES + F.wave, NGW = F.G * NWAVES, lane = F.lane;
    p0_weights(F, P0_LATE_ITEMS, P0_ALL_ITEMS, gw, NGW);
    bf16* XN = WSP(bf16, WS_XN);
    f32x4 g4[4];
#pragma unroll
    for (int j = 0; j < 4; ++j) g4[j] = *((const GAS f32x4*)F.g_attn + lane + 64 * j);
    for (int m = gw; m < MC + NMETA; m += NGW) {
        const float* xrow = m < MP ? F.x_prompt + (size_t)m * DM : (m < MC ? F.x_sample + (size_t)(m - MP) * DM : F.meta_tokens + (size_t)(m - MC) * DM);
        bf16* orow = XN + (size_t)m * DM;
        const GAS f32x4* xr = (const GAS f32x4*)xrow + lane;
        f32x4 v[4]; float s = 0.f;
#pragma unroll
        for (int j = 0; j < 4; ++j) { v[j] = __builtin_nontemporal_load(xr + 64 * j); s += (v[j].x * v[j].x + v[j].y * v[j].y) + (v[j].z * v[j].z + v[j].w * v[j].w); }
        const float rstd = frsqrt(wave_sum(s) * (1.f / DM) + EPS);
        GAS v2u* o8 = (GAS v2u*)orow + lane;
#pragma unroll
        for (int j = 0; j < 4; ++j) { v2u o; o.x = pk2(v[j].x * rstd * g4[j].x, v[j].y * rstd * g4[j].y); o.y = pk2(v[j].z * rstd * g4[j].z, v[j].w * rstd * g4[j].w); o8[64 * j] = o; }
    }
    { GAS v4u* zp = (GAS v4u*)(XN + (size_t)(MC + NMETA) * DM);
      for (int e = (F.vcu * NWAVES * 64) + F.tid; e < (MCX - MC - NMETA) * DM / 8; e += F.G * NWAVES * 64) zp[e] = (v4u){0u, 0u, 0u, 0u}; }
    float* ROPE = WSP(float, WS_ROPE);
    for (int e = (F.vcu * NWAVES * 64) + F.tid; e < 2072 * 16; e += F.G * NWAVES * 64) {
        const int p = e >> 4, i = e & 15; const int pos = p < TT ? p : PAST + (p - TT);
        const double ang = (double)pos * ROPE_INV[i];
        const double k = __builtin_rint(ang * 0.15915494309189535);
        const double r = __builtin_fma(-k, 6.283185307179586, ang) - k * 2.4492935982947064e-16;
        const float rf = (float)r;
        ROPE[p * 32 + i] = cosf(rf); ROPE[p * 32 + 16 + i] = sinf(rf);
    }
    { GAS v4u* kp = (GAS v4u*)(WSP(bf16, WS_KH) + (size_t)RB * 768); GAS v4u* vp = (GAS v4u*)(WSP(bf16, WS_VH) + (size_t)RB * 1024);
      for (int e = (F.vcu * NWAVES * 64) + F.tid; e < 64 * 768 / 8 + 64 * 1024 / 8; e += F.G * NWAVES * 64) { if (e < 64 * 768 / 8) kp[e] = (v4u){0u, 0u, 0u, 0u}; else vp[e - 64 * 768 / 8] = (v4u){0u, 0u, 0u, 0u}; } }
}

__device__ __forceinline__ void p1_meta(Frame& F) {
    const int gw = F.vcu * NWAVES + F.wave, NGW = F.G * NWAVES, lane = F.lane;
    const bf16* Win_t = WSP(bf16, WS_WIN); const bf16* XNM = WSP(bf16, WS_XNM); float* PFM = WSP(float, WS_PFM);
    for (int t = gw; t < 800; t += NGW) {
        const int n = t < 768 ? t : 1152 + (t - 768);
        const GAS v4u* wp = (const GAS v4u*)(Win_t + (size_t)n * DM + lane * 16);
        const v4u w0 = wp[0], w1 = wp[1];
        float wf[16];
        wf[0] = bflo(w0.x); wf[1] = bfhi(w0.x); wf[2] = bflo(w0.y); wf[3] = bfhi(w0.y); wf[4] = bflo(w0.z); wf[5] = bfhi(w0.z); wf[6] = bflo(w0.w); wf[7] = bfhi(w0.w);
        wf[8] = bflo(w1.x); wf[9] = bfhi(w1.x); wf[10] = bflo(w1.y); wf[11] = bfhi(w1.y); wf[12] = bflo(w1.z); wf[13] = bfhi(w1.z); wf[14] = bflo(w1.w); wf[15] = bfhi(w1.w);
        float mine = 0.f;
#pragma unroll 4
        for (int i = 0; i < 16; ++i) {
            const GAS v4u* xp = (const GAS v4u*)(XNM + (size_t)i * DM + lane * 16);
            const v4u x0 = xp[0], x1 = xp[1];
            float a = bflo(x0.x) * wf[0] + bfhi(x0.x) * wf[1] + bflo(x0.y) * wf[2] + bfhi(x0.y) * wf[3] + bflo(x0.z) * wf[4] + bfhi(x0.z) * wf[5] + bflo(x0.w) * wf[6] + bfhi(x0.w) * wf[7]
                    + bflo(x1.x) * wf[8] + bfhi(x1.x) * wf[9] + bflo(x1.y) * wf[10] + bfhi(x1.y) * wf[11] + bflo(x1.z) * wf[12] + bfhi(x1.z) * wf[13] + bflo(x1.w) * wf[14] + bfhi(x1.w) * wf[15];
            a = wave_sum(a);
            mine = (lane == i) ? a : mine;
        }
        if (lane < 16) PFM[lane * PFW + n] = mine;
    }
}

__device__ __forceinline__ void p2_rows(Frame& F) {
    const int gw = F.vcu * NWAVES + F.wave, NGW = F.G * NWAVES, lane = F.lane;
    const bf16* PB = WSP(bf16, WS_PB); const float* ROPE = WSP(float, WS_ROPE);
    bf16* CB = WSP(bf16, WS_CB); bf16* KRG = WSP(bf16, WS_KRG); float* KSS = WSP(float, WS_KSS); bf16* QL = WSP(bf16, WS_QL);
    float* CM = WSP(float, WS_CM); float* KRM = WSP(float, WS_KRM); float* KSM = WSP(float, WS_KSM);
    const f32x4 gkv = *((const GAS f32x4*)F.g_kv_lat + lane);
    const f32x4 gqa = *((const GAS f32x4*)F.g_q_lat + lane);
    const f32x2 gqb = *((const GAS f32x2*)(F.g_q_lat + 256) + lane);
    const float gkr = F.g_kn_rope[lane & 15];
    struct RowIn { v2u c; unsigned short k1, k2; float cs, sn; v2u qa; unsigned qb; };
    auto row_load = [&](int m, RowIn& r) {
        const bool meta = m >= MC, samp = !meta && m >= MP;
        const bf16* pf = PB + (size_t)m * PFW;
        const int pos = meta ? m - MC : (samp ? PAST + ((m - MP) & 7) : (m & (SEQ - 1)) + NMETA);
        const int ridx = pos < TT ? pos : TT + (pos - PAST);
        r.c = __builtin_nontemporal_load((const GAS v2u*)pf + lane);
        r.k1 = 0; r.k2 = 0; r.cs = 1.f; r.sn = 0.f;
        if (lane < 16) { r.k1 = pf[1152 + lane]; r.k2 = pf[1152 + 16 + lane]; r.cs = ROPE[ridx * 32 + lane]; r.sn = ROPE[ridx * 32 + 16 + lane]; }
        r.qa = (v2u){0u, 0u}; r.qb = 0u;
        if (!meta) { r.qa = __builtin_nontemporal_load((const GAS v2u*)(pf + 768) + lane); r.qb = __builtin_nontemporal_load((const GAS unsigned*)(pf + 1024) + lane); }
    };
    auto row_do = [&](int m, const RowIn& r) {
        const bool meta = m >= MC, samp = !meta && m >= MP;
        const f32x4 c4 = (f32x4){bflo(r.c.x), bfhi(r.c.x), bflo(r.c.y), bfhi(r.c.y)};
        const float x1 = bflo((unsigned)r.k1), x2 = bflo((unsigned)r.k2), cs = r.cs, sn = r.sn;
        const f32x4 qa = (f32x4){bflo(r.qa.x), bfhi(r.qa.x), bflo(r.qa.y), bfhi(r.qa.y)}; const f32x2 qb = (f32x2){bflo(r.qb), bfhi(r.qb)};
        float sc = (c4.x * c4.x + c4.y * c4.y) + (c4.z * c4.z + c4.w * c4.w), sk = x1 * x1 + x2 * x2, sq = (qa.x * qa.x + qa.y * qa.y) + (qa.z * qa.z + qa.w * qa.w) + (qb.x * qb.x + qb.y * qb.y);
        sc = wave_sum(sc); sk = wave_sum(sk); sq = wave_sum(sq);
        const float rc = frsqrt(sc * (1.f / KVL) + EPS), rq = frsqrt(sq * (1.f / QLORA) + EPS);
        const f32x4 cn = (f32x4){c4.x * rc * gkv.x, c4.y * rc * gkv.y, c4.z * rc * gkv.z, c4.w * rc * gkv.w};
        const float o1 = x1 * cs - x2 * sn, o2 = x2 * cs + x1 * sn;
        if (meta) {
            const int i = m - MC;
            *((GAS f32x4*)(CM + (size_t)i * KVL) + lane) = cn;
            if (lane < 16) { KRM[i * 32 + lane] = o1 * gkr; KRM[i * 32 + 16 + lane] = o2 * gkr; }
            if (lane == 0) KSM[i] = sk;
#pragma unroll 4
            for (int b = 0; b < NBATCH; ++b) { const size_t R = (size_t)b * TT + i;
                *((GAS f32x4*)(F.out + O_CP + R * KVL) + lane) = cn;
                if (lane < 16) { F.out[O_KRP + R * QKR + lane] = o1; F.out[O_KRP + R * QKR + 16 + lane] = o2;
                    KRG[R * 32 + lane] = (bf16)f2bf(o1 * gkr); KRG[R * 32 + 16 + lane] = (bf16)f2bf(o2 * gkr); }
                if (lane == 0) KSS[R] = sk; }
        } else {
            v2u cb; cb.x = pk2(cn.x, cn.y); cb.y = pk2(cn.z, cn.w);
            *((GAS v2u*)(CB + (size_t)m * KVL) + lane) = cb;
            if (!samp) { const size_t R = (size_t)m + NMETA * ((m >> 11) + 1);
                *((GAS f32x4*)(F.out + O_CP + R * KVL) + lane) = cn;
                if (lane < 16) { F.out[O_KRP + R * QKR + lane] = o1; F.out[O_KRP + R * QKR + 16 + lane] = o2;
                    KRG[R * 32 + lane] = (bf16)f2bf(o1 * gkr); KRG[R * 32 + 16 + lane] = (bf16)f2bf(o2 * gkr); }
                if (lane == 0) KSS[R] = sk;
            } else { const size_t R = (size_t)(m - MP);
                *((GAS f32x4*)(F.out + O_CS + R * KVL) + lane) = cn;
                if (lane < 16) { F.out[O_KRS + R * QKR + lane] = o1; F.out[O_KRS + R * QKR + 16 + lane] = o2; } }
            v2u qo; qo.x = pk2(qa.x * rq * gqa.x, qa.y * rq * gqa.y); qo.y = pk2(qa.z * rq * gqa.z, qa.w * rq * gqa.w);
            *((GAS v2u*)(QL + (size_t)m * QLORA) + lane) = qo;
            *((GAS unsigned*)(QL + (size_t)m * QLORA + 256) + lane) = pk2(qb.x * rq * gqb.x, qb.y * rq * gqb.y);
        }
    };
    {
        RowIn ra, rb; int m = gw;
        if (m < MC + NMETA) row_load(m, ra);
        for (; m < MC + NMETA; m += 2 * NGW) {
            const int m2 = m + NGW, m3 = m + 2 * NGW;
            if (m2 < MC + NMETA) row_load(m2, rb);
            row_do(m, ra);
            if (m3 < MC + NMETA) row_load(m3, ra);
            if (m2 < MC + NMETA) row_do(m2, rb);
        }
    }
}
__device__ __forceinline__ void ldu8(const bf16* p, f32x4& a, f32x4& b) { const v4u v = *(const GAS v4u*)p;
    a = (f32x4){bflo(v.x), bfhi(v.x), bflo(v.y), bfhi(v.y)}; b = (f32x4){bflo(v.z), bfhi(v.z), bflo(v.w), bfhi(v.w)}; }
__device__ __forceinline__ void p2_pool(Frame& F) {
    const int gw = F.vcu * NWAVES + F.wave, NGW = F.G * NWAVES, lane = F.lane;
    const bf16* PB = WSP(bf16, WS_PB); bf16* DP = WSP(bf16, WS_DP);
    const int w = 2 << (lane >> 4); const float iw = 1.0f / (float)w; const int col = 256 + 8 * lane;
    for (int t = gw; t < MP / 16; t += NGW) {
        const int b = t >> 7, t0 = (t & 127) * 16;
        const bf16* base = PB + (size_t)b * SEQ * PFW + col;
#define UROW(tp) (((tp) >= 0) ? base + (size_t)(tp) * PFW : PB + (size_t)(MC + (tp) + NMETA) * PFW + col)
        f32x4 ra = (f32x4){0.f, 0.f, 0.f, 0.f}, rb = ra;
#pragma unroll
        for (int j = 1; j < 16; ++j) { f32x4 a, bq; ldu8(UROW(t0 - j), a, bq); if (j < w) { ra += a; rb += bq; } }
#pragma unroll 8
        for (int r = 0; r < 16; ++r) {
            f32x4 ca, cb, oa, ob; ldu8(UROW(t0 + r), ca, cb); ldu8(UROW(t0 + r - w + 1), oa, ob);
            ra += ca; rb += cb;
            const f32x4 da = ra * iw - ca, db = rb * iw - cb;
            v4u o; o.x = pk2(da.x, da.y); o.y = pk2(da.z, da.w); o.z = pk2(db.x, db.y); o.w = pk2(db.z, db.w);
            *((GAS v4u*)(DP + ((size_t)(lane >> 4) * MC + (b * SEQ + t0 + r)) * 128) + (lane & 15)) = o;
            ra -= oa; rb -= ob;
        }
#undef UROW
    }
    for (int db = gw; db < DBATCH; db += NGW) {
        const float* sp = F.state_pool + (size_t)db * 15 * PW + 8 * lane; const bf16* base = PB + (size_t)(MP + db * DSEQ) * PFW + col;
#define ULOAD(s, A, B) do { if ((s) >= 0) ldu8(base + (size_t)(s) * PFW, A, B); else { const float* p_ = sp + (size_t)(15 + (s)) * PW; A = *(const GAS f32x4*)p_; B = *(const GAS f32x4*)(p_ + 4); } } while (0)
        f32x4 ra = (f32x4){0.f, 0.f, 0.f, 0.f}, rb = ra;
#pragma unroll 5
        for (int j = 1; j < 16; ++j) { f32x4 a, bq; ULOAD(-j, a, bq); if (j < w) { ra += a; rb += bq; } }
#pragma unroll
        for (int r = 0; r < DSEQ; ++r) {
            f32x4 ca, cb, oa, ob; ULOAD(r, ca, cb); ULOAD(r - w + 1, oa, ob);
            ra += ca; rb += cb;
            const f32x4 da = ra * iw - ca, dbv = rb * iw - cb;
            v4u o; o.x = pk2(da.x, da.y); o.y = pk2(da.z, da.w); o.z = pk2(dbv.x, dbv.y); o.w = pk2(dbv.z, dbv.w);
            *((GAS v4u*)(DP + ((size_t)(lane >> 4) * MC + (MP + db * DSEQ + r)) * 128) + (lane & 15)) = o;
            ra -= oa; rb -= ob;
        }
#undef ULOAD
    }
    const int gt = F.vcu * NWAVES * 64 + F.tid, NGT = F.G * NWAVES * 64;
    for (int e = gt; e < NBATCH * 15 * (PW / 4); e += NGT) { const int c4 = e & 127, j = (e >> 7) % 15, b = e / (128 * 15);
        const v2u v = *((const GAS v2u*)(PB + (size_t)(b * SEQ + SEQ - 15 + j) * PFW + 256) + c4);
        *((GAS f32x4*)(F.out + O_PSP) + e) = (f32x4){bflo(v.x), bfhi(v.x), bflo(v.y), bfhi(v.y)}; }
    for (int e = gt; e < DBATCH * 15 * (PW / 4); e += NGT) { const int c4 = e & 127, j = (e >> 7) % 15, db = e / (128 * 15);
        f32x4 v;
        if (j < 7) v = *((const GAS f32x4*)(F.state_pool + (size_t)(db * 15 + 8 + j) * PW) + c4);
        else { const v2u q = *((const GAS v2u*)(PB + (size_t)(MP + db * DSEQ + j - 7) * PFW + 256) + c4); v = (f32x4){bflo(q.x), bfhi(q.x), bflo(q.y), bfhi(q.y)}; }
        *((GAS f32x4*)(F.out + O_PSS) + e) = v; }
}
using pg8::Unit;
__device__ __forceinline__ float sigmoidf_fast(float x) { return __builtin_amdgcn_rcpf(1.0f + __builtin_amdgcn_exp2f(-1.4426950408889634f * x)); }

struct EpiInProj {
    static constexpr bool PERM = true, AFTER_DRAIN = false;
    float* PF; bf16* GATE; bf16* PB;
    __device__ __forceinline__ void operator()(const f32x4 (&acc)[2][2][4][2], const Unit& u, int wr, int wc, int fr, int fq) const {
        const int row0 = u.pm * 256 + wr * 64 + fr, cw = wc * 32 + 8 * fq;
        if (u.pn < 5) {
#pragma unroll
            for (int ai = 0; ai < 2; ++ai)
#pragma unroll
                for (int m = 0; m < 4; ++m) { bf16* rowp = PB + (size_t)(row0 + ai * 128 + m * 16) * PFW + u.pn * 256 + cw;
#pragma unroll
                    for (int bj = 0; bj < 2; ++bj) { const f32x4 v0 = acc[ai][bj][m][0], v1 = acc[ai][bj][m][1]; v4u w;
                        w.x = pk2(v0[0], v0[1]); w.y = pk2(v0[2], v0[3]); w.z = pk2(v1[0], v1[1]); w.w = pk2(v1[2], v1[3]);
                        *(GAS v4u*)(rowp + bj * 128) = w; } }
        } else {
#pragma unroll
            for (int ai = 0; ai < 2; ++ai)
#pragma unroll
                for (int m = 0; m < 4; ++m) { bf16* rowp = GATE + (size_t)(row0 + ai * 128 + m * 16) * 2048 + (u.pn - 5) * 256 + cw;
#pragma unroll
                    for (int bj = 0; bj < 2; ++bj) { const f32x4 v0 = acc[ai][bj][m][0], v1 = acc[ai][bj][m][1]; v4u w;
                        w.x = pk2(sigmoidf_fast(v0[0]), sigmoidf_fast(v0[1])); w.y = pk2(sigmoidf_fast(v0[2]), sigmoidf_fast(v0[3]));
                        w.z = pk2(sigmoidf_fast(v1[0]), sigmoidf_fast(v1[1])); w.w = pk2(sigmoidf_fast(v1[2]), sigmoidf_fast(v1[3]));
                        *(GAS v4u*)(rowp + bj * 128) = w; } }
        }
    }
};
struct EpiInProjScalar {
    static constexpr bool PERM = true, AFTER_DRAIN = false;
    float* PF; bf16* GATE;
    __device__ __forceinline__ void operator()(const f32x4 (&acc)[2][2][4][2], const Unit& u, int wr, int wc, int fr, int fq) const {
        const int row0 = u.pm * 256 + wr * 64 + fr, cw = wc * 32 + 8 * fq;
#pragma unroll
        for (int ai = 0; ai < 2; ++ai)
#pragma unroll
            for (int m = 0; m < 4; ++m)
#pragma unroll
                for (int bj = 0; bj < 2; ++bj)
#pragma unroll
                    for (int n = 0; n < 2; ++n)
#pragma unroll
                        for (int e = 0; e < 4; ++e) { const size_t r = (size_t)(row0 + ai * 128 + m * 16); const int c = u.pn * 256 + bj * 128 + cw + 4 * n + e; const float v = acc[ai][bj][m][n][e];
                            if (c < PFW) PF[r * PFW + c] = v; else GATE[r * 2048 + (c - PFW)] = (bf16)f2bf(sigmoidf_fast(v)); }
    }
};
struct EpiPlainBf16 {
    static constexpr bool PERM = true, AFTER_DRAIN = false;
    bf16* O; int ldc;
    __device__ __forceinline__ void operator()(const f32x4 (&acc)[2][2][4][2], const Unit& u, int wr, int wc, int fr, int fq) const {
        const int row0 = u.pm * 256 + wr * 64 + fr, col0 = u.pn * 256 + wc * 32 + 8 * fq;
#pragma unroll
        for (int ai = 0; ai < 2; ++ai)
#pragma unroll
            for (int m = 0; m < 4; ++m) { bf16* rowp = O + (size_t)(row0 + ai * 128 + m * 16) * ldc + col0;
#pragma unroll
                for (int bj = 0; bj < 2; ++bj) { const f32x4 v0 = acc[ai][bj][m][0], v1 = acc[ai][bj][m][1]; v4u w;
                    w.x = pk2(v0[0], v0[1]); w.y = pk2(v0[2], v0[3]); w.z = pk2(v1[0], v1[1]); w.w = pk2(v1[2], v1[3]); *(GAS v4u*)(rowp + bj * 128) = w; } }
    }
};
struct EpiKV {
    static constexpr bool PERM = true, AFTER_DRAIN = false;
    bf16* KH; bf16* VH; const bf16* KRG; const float* KSS; const float* gkn;
    __device__ __forceinline__ void operator()(const f32x4 (&acc)[2][2][4][2], const Unit& u, int wr, int wc, int fr, int fq) const {
        const int row0 = u.pm * 256 + wr * 64 + fr, roff = NMETA * ((u.pm >> 3) + 1);
        if (u.pn < 2) {
            const int head = u.pn * 4 + wc;
            f32x4 g[2][2];
#pragma unroll
            for (int bj = 0; bj < 2; ++bj)
#pragma unroll
                for (int n = 0; n < 2; ++n) g[bj][n] = *(const GAS f32x4*)(gkn + 32 * bj + 8 * fq + 4 * n);
            float kss[2][4]; v4u krv[2][4];
#pragma unroll
            for (int ai = 0; ai < 2; ++ai)
#pragma unroll
                for (int m = 0; m < 4; ++m) { const size_t R = (size_t)(row0 + ai * 128 + m * 16 + roff); const float* ps_ = KSS + R; const bf16* pk_ = KRG + R * 32 + 8 * fq;
                    asm volatile("global_load_dword %0, %1, off nt" : "=v"(kss[ai][m]) : "v"(ps_)); asm volatile("global_load_dwordx4 %0, %1, off nt" : "=v"(krv[ai][m]) : "v"(pk_)); }
            asm volatile("s_waitcnt vmcnt(0)" : "+v"(kss[0][0]), "+v"(kss[0][1]), "+v"(kss[0][2]), "+v"(kss[0][3]), "+v"(kss[1][0]), "+v"(kss[1][1]), "+v"(kss[1][2]), "+v"(kss[1][3]),
                                                "+v"(krv[0][0]), "+v"(krv[0][1]), "+v"(krv[0][2]), "+v"(krv[0][3]), "+v"(krv[1][0]), "+v"(krv[1][1]), "+v"(krv[1][2]), "+v"(krv[1][3]));
#pragma unroll
            for (int ai = 0; ai < 2; ++ai)
#pragma unroll
                for (int m = 0; m < 4; ++m) { const size_t R = (size_t)(row0 + ai * 128 + m * 16 + roff);
                    float ss = 0.f;
#pragma unroll
                    for (int bj = 0; bj < 2; ++bj)
#pragma unroll
                        for (int n = 0; n < 2; ++n) { const f32x4 v = acc[ai][bj][m][n]; ss += (v[0] * v[0] + v[1] * v[1]) + (v[2] * v[2] + v[3] * v[3]); }
                    ss = sum_x32(sum_x16(ss));
                    const float rstd = frsqrt((ss + kss[ai][m]) * (1.f / QKH) + EPS);
                    bf16* kp = KH + R * 768 + head * QKH;
#pragma unroll
                    for (int bj = 0; bj < 2; ++bj) { const f32x4 v0 = acc[ai][bj][m][0] * g[bj][0] * rstd, v1 = acc[ai][bj][m][1] * g[bj][1] * rstd; v4u w;
                        w.x = pk2(v0[0], v0[1]); w.y = pk2(v0[2], v0[3]); w.z = pk2(v1[0], v1[1]); w.w = pk2(v1[2], v1[3]); *(GAS v4u*)(kp + 32 * bj + 8 * fq) = w; }
                    const v4u kr = krv[ai][m]; v4u w;
                    w.x = pk2(bflo(kr.x) * rstd, bfhi(kr.x) * rstd); w.y = pk2(bflo(kr.y) * rstd, bfhi(kr.y) * rstd); w.z = pk2(bflo(kr.z) * rstd, bfhi(kr.z) * rstd); w.w = pk2(bflo(kr.w) * rstd, bfhi(kr.w) * rstd);
                    *(GAS v4u*)(kp + 64 + 8 * fq) = w; }
        } else {
            const int col0 = (u.pn - 2) * 256 + wc * 32 + 8 * fq;
#pragma unroll
            for (int ai = 0; ai < 2; ++ai)
#pragma unroll
                for (int m = 0; m < 4; ++m) { bf16* rowp = VH + (size_t)(row0 + ai * 128 + m * 16 + roff) * 1024 + col0;
#pragma unroll
                    for (int bj = 0; bj < 2; ++bj) { const f32x4 v0 = acc[ai][bj][m][0], v1 = acc[ai][bj][m][1]; v4u w;
                        w.x = pk2(v0[0], v0[1]); w.y = pk2(v0[2], v0[3]); w.z = pk2(v1[0], v1[1]); w.w = pk2(v1[2], v1[3]); *(GAS v4u*)(rowp + bj * 128) = w; } }
        }
    }
};
struct PoolOrder {
    int G, c;
    __device__ __forceinline__ bool next(int i, Unit& u) const { const int L = i * G + c; if (L >= 4 * (MC / 256)) return false; const int pn = L & 3, pm = L >> 2; u.pm = pn * (MC / 256) + pm; u.pn = pn; return true; }
    __device__ __forceinline__ void a_ready(const Unit&) const {}
    __device__ __forceinline__ void done(const Unit&) const {}
};
struct EpiPool {
    static constexpr bool PERM = true, AFTER_DRAIN = false;
    bf16* PG; const bf16* GATE; const float* pscale;
    __device__ __forceinline__ void operator()(const f32x4 (&acc)[2][2][4][2], const Unit& u, int wr, int wc, int fr, int fq) const {
        const int row0 = (u.pm - u.pn * (MC / 256)) * 256 + wr * 64 + fr, col0 = u.pn * 256 + wc * 32 + 8 * fq;
        f32x4 ps[2][2];
#pragma unroll
        for (int bj = 0; bj < 2; ++bj)
#pragma unroll
            for (int n = 0; n < 2; ++n) ps[bj][n] = *(const GAS f32x4*)(pscale + col0 + bj * 128 + 4 * n);
        v4u gt[2][4][2];
#pragma unroll
        for (int ai = 0; ai < 2; ++ai)
#pragma unroll
            for (int m = 0; m < 4; ++m) { const bf16* p = GATE + (size_t)(row0 + ai * 128 + m * 16) * 2048 + col0;
                asm volatile("global_load_dwordx4 %0, %1, off nt" : "=v"(gt[ai][m][0]) : "v"(p));
                asm volatile("global_load_dwordx4 %0, %1, off offset:256 nt" : "=v"(gt[ai][m][1]) : "v"(p)); }
        asm volatile("s_waitcnt vmcnt(0)" : "+v"(gt[0][0][0]), "+v"(gt[0][0][1]), "+v"(gt[0][1][0]), "+v"(gt[0][1][1]), "+v"(gt[0][2][0]), "+v"(gt[0][2][1]), "+v"(gt[0][3][0]), "+v"(gt[0][3][1]),
                                            "+v"(gt[1][0][0]), "+v"(gt[1][0][1]), "+v"(gt[1][1][0]), "+v"(gt[1][1][1]), "+v"(gt[1][2][0]), "+v"(gt[1][2][1]), "+v"(gt[1][3][0]), "+v"(gt[1][3][1]));
#pragma unroll
        for (int ai = 0; ai < 2; ++ai)
#pragma unroll
            for (int m = 0; m < 4; ++m) { const size_t r = (size_t)(row0 + ai * 128 + m * 16);
#pragma unroll
                for (int bj = 0; bj < 2; ++bj) { const v4u g = gt[ai][m][bj];
                    const f32x4 v0 = acc[ai][bj][m][0] * ps[bj][0], v1 = acc[ai][bj][m][1] * ps[bj][1]; v4u w;
                    w.x = pk2(v0[0] * bflo(g.x), v0[1] * bfhi(g.x)); w.y = pk2(v0[2] * bflo(g.y), v0[3] * bfhi(g.y)); w.z = pk2(v1[0] * bflo(g.z), v1[1] * bfhi(g.z)); w.w = pk2(v1[2] * bflo(g.w), v1[3] * bfhi(g.w));
                    *(GAS v4u*)(PG + r * DM + col0 + bj * 128) = w; } }
    }
};
struct EpiResF32 {
    static constexpr bool PERM = true, AFTER_DRAIN = false;
    float* C; const float* R0; const float* R1; int split_pm;
    __device__ __forceinline__ void operator()(const f32x4 (&acc)[2][2][4][2], const Unit& u, int wr, int wc, int fr, int fq) const {
        const int row0 = u.pm * 256 + wr * 64 + fr, col0 = u.pn * 256 + wc * 32 + 8 * fq;
        const float* rb = u.pm < split_pm ? R0 : R1 - (size_t)split_pm * 256 * DM;
#pragma unroll
        for (int ai = 0; ai < 2; ++ai)
#pragma unroll
            for (int m = 0; m < 4; ++m) { const size_t o = (size_t)(row0 + ai * 128 + m * 16) * DM + col0;
#pragma unroll
                for (int bj = 0; bj < 2; ++bj) { const f32x4 r0 = *(const GAS f32x4*)(rb + o + bj * 128), r1 = *(const GAS f32x4*)(rb + o + bj * 128 + 4);
                    *(GAS f32x4*)(C + o + bj * 128) = acc[ai][bj][m][0] + r0; *(GAS f32x4*)(C + o + bj * 128 + 4) = acc[ai][bj][m][1] + r1; } }
    }
};
struct EpiResToBf16 {
    static constexpr bool PERM = true, AFTER_DRAIN = false;
    bf16* C; const float* R;
    __device__ __forceinline__ void operator()(const f32x4 (&acc)[2][2][4][2], const Unit& u, int wr, int wc, int fr, int fq) const {
        const int row0 = u.pm * 256 + wr * 64 + fr, col0 = u.pn * 256 + wc * 32 + 8 * fq;
#pragma unroll
        for (int ai = 0; ai < 2; ++ai) {
            f32x4 r[4][4];
#pragma unroll
            for (int m = 0; m < 4; ++m) { const float* p = R + (size_t)(row0 + ai * 128 + m * 16) * DM + col0;
                asm volatile("global_load_dwordx4 %0, %1, off nt" : "=v"(r[m][0]) : "v"(p));
                asm volatile("global_load_dwordx4 %0, %1, off offset:16 nt" : "=v"(r[m][1]) : "v"(p));
                asm volatile("global_load_dwordx4 %0, %1, off offset:512 nt" : "=v"(r[m][2]) : "v"(p));
                asm volatile("global_load_dwordx4 %0, %1, off offset:528 nt" : "=v"(r[m][3]) : "v"(p)); }
            asm volatile("s_waitcnt vmcnt(0)" : "+v"(r[0][0]), "+v"(r[0][1]), "+v"(r[0][2]), "+v"(r[0][3]), "+v"(r[1][0]), "+v"(r[1][1]), "+v"(r[1][2]), "+v"(r[1][3]),
                                                "+v"(r[2][0]), "+v"(r[2][1]), "+v"(r[2][2]), "+v"(r[2][3]), "+v"(r[3][0]), "+v"(r[3][1]), "+v"(r[3][2]), "+v"(r[3][3]));
#pragma unroll
            for (int m = 0; m < 4; ++m) { const size_t o = (size_t)(row0 + ai * 128 + m * 16) * DM + col0;
#pragma unroll
                for (int bj = 0; bj < 2; ++bj) { const f32x4 a = acc[ai][bj][m][0] + r[m][2 * bj], b = acc[ai][bj][m][1] + r[m][2 * bj + 1]; v4u w;
                    w.x = pk2(a[0], a[1]); w.y = pk2(a[2], a[3]); w.z = pk2(b[0], b[1]); w.w = pk2(b[2], b[3]);
                    *(GAS v4u*)(C + o + bj * 128) = w; } }
        }
    }
};
struct EpiResFromBf16 {
    static constexpr bool PERM = true, AFTER_DRAIN = false;
    float* C; const bf16* R;
    __device__ __forceinline__ void operator()(const f32x4 (&acc)[2][2][4][2], const Unit& u, int wr, int wc, int fr, int fq) const {
        const int row0 = u.pm * 256 + wr * 64 + fr, col0 = u.pn * 256 + wc * 32 + 8 * fq;
        v4u r[2][4][2];
#pragma unroll
        for (int ai = 0; ai < 2; ++ai)
#pragma unroll
            for (int m = 0; m < 4; ++m) { const bf16* p = R + (size_t)(row0 + ai * 128 + m * 16) * DM + col0;
                asm volatile("global_load_dwordx4 %0, %1, off nt" : "=v"(r[ai][m][0]) : "v"(p));
                asm volatile("global_load_dwordx4 %0, %1, off offset:256 nt" : "=v"(r[ai][m][1]) : "v"(p)); }
        asm volatile("s_waitcnt vmcnt(0)" : "+v"(r[0][0][0]), "+v"(r[0][0][1]), "+v"(r[0][1][0]), "+v"(r[0][1][1]), "+v"(r[0][2][0]), "+v"(r[0][2][1]), "+v"(r[0][3][0]), "+v"(r[0][3][1]),
                                            "+v"(r[1][0][0]), "+v"(r[1][0][1]), "+v"(r[1][1][0]), "+v"(r[1][1][1]), "+v"(r[1][2][0]), "+v"(r[1][2][1]), "+v"(r[1][3][0]), "+v"(r[1][3][1]));
#pragma unroll
        for (int ai = 0; ai < 2; ++ai)
#pragma unroll
            for (int m = 0; m < 4; ++m) { const size_t o = (size_t)(row0 + ai * 128 + m * 16) * DM + col0;
#pragma unroll
                for (int bj = 0; bj < 2; ++bj) { const v4u t = r[ai][m][bj];
                    *(GAS f32x4*)(C + o + bj * 128) = acc[ai][bj][m][0] + (f32x4){bflo(t.x), bfhi(t.x), bflo(t.y), bfhi(t.y)};
                    *(GAS f32x4*)(C + o + bj * 128 + 4) = acc[ai][bj][m][1] + (f32x4){bflo(t.z), bfhi(t.z), bflo(t.w), bfhi(t.w)}; } }
    }
};
struct SliceOrder {
    int NS, G, c;
    __device__ __forceinline__ bool next(int i, Unit& u) const { const int L = i * G + c; if (L >= NS * 16) return false; const int s = L >> 4; u.pm = 4 * s + ((L >> 2) & 3); u.pn = 4 * s + (L & 3); return true; }
    __device__ __forceinline__ void a_ready(const Unit&) const {}
    __device__ __forceinline__ void done(const Unit&) const {}
};
struct EpiSlab {
    static constexpr bool PERM = true, AFTER_DRAIN = false;
    float* S;
    __device__ __forceinline__ void operator()(const f32x4 (&acc)[2][2][4][2], const Unit& u, int wr, int wc, int fr, int fq) const {
        const int row0 = (u.pm & 3) * 256 + wr * 64 + fr, col0 = (u.pn & 3) * 256 + wc * 32 + 8 * fq; float* base = S + (size_t)(u.pm >> 2) * MS * DM;
#pragma unroll
        for (int ai = 0; ai < 2; ++ai)
#pragma unroll
            for (int m = 0; m < 4; ++m) { const size_t o = (size_t)(row0 + ai * 128 + m * 16) * DM + col0;
#pragma unroll
                for (int bj = 0; bj < 2; ++bj) { *(GAS f32x4*)(base + o + bj * 128) = acc[ai][bj][m][0]; *(GAS f32x4*)(base + o + bj * 128 + 4) = acc[ai][bj][m][1]; } }
    }
};
struct EpiRelu2 {
    static constexpr bool PERM = true, AFTER_DRAIN = false;
    bf16* Z; bf16* ZS;
    __device__ __forceinline__ void operator()(const f32x4 (&acc)[2][2][4][2], const Unit& u, int wr, int wc, int fr, int fq) const {
        const int row0 = u.pm * 256 + wr * 64 + fr, col0 = u.pn * 256 + wc * 32 + 8 * fq;
        const bool smp = u.pm >= MP / 256;
        bf16* zb = smp ? ZS + ((size_t)(col0 >> 9) * MS - MP) * 512 + (col0 & 511) : Z + col0; const int zp = smp ? 512 : DFF;
#pragma unroll
        for (int ai = 0; ai < 2; ++ai)
#pragma unroll
            for (int m = 0; m < 4; ++m) { bf16* rowp = zb + (size_t)(row0 + ai * 128 + m * 16) * zp;
#pragma unroll
                for (int bj = 0; bj < 2; ++bj) { f32x4 v0 = acc[ai][bj][m][0], v1 = acc[ai][bj][m][1];
#pragma unroll
                    for (int j = 0; j < 4; ++j) { const float a = fmaxf(v0[j], 0.f), b = fmaxf(v1[j], 0.f); v0[j] = a * a; v1[j] = b * b; }
                    v4u w; w.x = pk2(v0[0], v0[1]); w.y = pk2(v0[2], v0[3]); w.z = pk2(v1[0], v1[1]); w.w = pk2(v1[2], v1[3]); *(GAS v4u*)(rowp + bj * 128) = w; } }
    }
};
namespace pa {
constexpr int SHM = 16384;
#define PA_KSWZ(row, colB) ((row) * 256 + ((colB) ^ (((row) & 7) << 4)))
__device__ __forceinline__ int v_st(int k, int c) { const int kk = (k & ~0xC) | ((k & 4) << 1) | ((k & 8) >> 1); return ((kk >> 3) * 4 + (c >> 5)) * 512 + ((kk & 7) * 32 + (c & 31)) * 2; }
__device__ __forceinline__ int v_rd_base(int lane) { return ((lane & 3) << 3) | (((lane >> 2) & 3) << 6) | (((lane >> 4) & 1) << 5) | (((lane >> 5) & 1) << 8); }
constexpr int v_rd_off(int d0, int ks, int half) { return d0 * 512 + ks * 4096 + half * 2048; }
__device__ __forceinline__ int crow(int r, int hi) { return (r & 3) + 8 * (r >> 2) + 4 * hi; }

template <int KB>
__device__ __forceinline__ void qkt(f32x16& p0, f32x16& p1, const char* K_lds, int r32, int hi, const bf16x8* qr) {
    p0 = f32x16{}; p1 = f32x16{};
    const char* kb[4];
#pragma unroll
    for (int dd = 0; dd < 4; ++dd) kb[dd] = K_lds + KB * SHM + PA_KSWZ(r32, (dd * 16 + hi * 8) * 2);
#pragma unroll
    for (int d0 = 0; d0 < 6; ++d0) { const char* a = kb[d0 & 3] + (d0 >> 2) * 128;
        const bf16x8 b0 = *reinterpret_cast<const bf16x8*>(a);
        const bf16x8 b1 = *reinterpret_cast<const bf16x8*>(a + 32 * 256);
        p0 = __builtin_amdgcn_mfma_f32_32x32x16_bf16(b0, qr[d0], p0, 0, 0, 0);
        p1 = __builtin_amdgcn_mfma_f32_32x32x16_bf16(b1, qr[d0], p1, 0, 0, 0); }
}
template <int VB>
__device__ __forceinline__ void pv_tile(f32x16* o, int vb0, bf16x8 pa0, bf16x8 pa1, bf16x8 pa2, bf16x8 pa3) {
#define TRRD(dst, off) asm volatile("ds_read_b64_tr_b16 %0, %1 offset:%2" : "=&v"(dst) : "v"(vb0), "i"(off) : "memory")
#define PV_D0(d0) do { s16x4 l0, l1, l2, l3, h0, h1, h2, h3; constexpr int b_ = VB * SHM + v_rd_off(d0, 0, 0); \
        TRRD(l0, b_); TRRD(h0, b_ + 2048); TRRD(l1, b_ + 4096); TRRD(h1, b_ + 6144); TRRD(l2, b_ + 8192); TRRD(h2, b_ + 10240); TRRD(l3, b_ + 12288); TRRD(h3, b_ + 14336); \
        asm volatile("s_waitcnt lgkmcnt(0)" ::: "memory"); SBAR(); \
        o[d0] = __builtin_amdgcn_mfma_f32_32x32x16_bf16(pa0, (bf16x8){l0[0], l0[1], l0[2], l0[3], h0[0], h0[1], h0[2], h0[3]}, o[d0], 0, 0, 0); \
        o[d0] = __builtin_amdgcn_mfma_f32_32x32x16_bf16(pa1, (bf16x8){l1[0], l1[1], l1[2], l1[3], h1[0], h1[1], h1[2], h1[3]}, o[d0], 0, 0, 0); \
        o[d0] = __builtin_amdgcn_mfma_f32_32x32x16_bf16(pa2, (bf16x8){l2[0], l2[1], l2[2], l2[3], h2[0], h2[1], h2[2], h2[3]}, o[d0], 0, 0, 0); \
        o[d0] = __builtin_amdgcn_mfma_f32_32x32x16_bf16(pa3, (bf16x8){l3[0], l3[1], l3[2], l3[3], h3[0], h3[1], h3[2], h3[3]}, o[d0], 0, 0, 0); } while (0)
    PV_D0(0); PV_D0(1); PV_D0(2); PV_D0(3);
#undef PV_D0
#undef TRRD
}
__device__ __forceinline__ void mask_tile(f32x16& p0, f32x16& p1, int dq) {
    const float NEG = -__builtin_inff();
#pragma unroll
    for (int r = 0; r < 16; ++r) { const int c = (r & 3) + 8 * (r >> 2);
        if (dq - c < 0) p0[r] = NEG;
        if (dq - c - 32 < 0) p1[r] = NEG; }
}
__device__ __forceinline__ void exp_half(f32x16& p, float b2) {
#pragma unroll
    for (int r = 0; r < 16; ++r) p[r] = __builtin_amdgcn_exp2f(p[r] - b2);
}
__device__ __forceinline__ void finish(f32x16& p0, f32x16& p1, float b2, float& l_reg, bf16x8& pa0, bf16x8& pa1, bf16x8& pa2, bf16x8& pa3) {
    exp_half(p1, b2);
    float ps = 0.f;
#pragma unroll
    for (int r = 0; r < 16; ++r) ps += p0[r];
#pragma unroll
    for (int r = 0; r < 16; ++r) ps += p1[r];
    ps = sum_x32(ps);
    l_reg += ps;
#define PK4(P, B_, OUT) do { unsigned a0 = pk2(P[B_ + 0], P[B_ + 1]), a1 = pk2(P[B_ + 2], P[B_ + 3]); unsigned b0 = pk2(P[B_ + 4], P[B_ + 5]), b1 = pk2(P[B_ + 6], P[B_ + 7]); \
        auto r0 = __builtin_amdgcn_permlane32_swap(a0, b0, false, false); auto r1 = __builtin_amdgcn_permlane32_swap(a1, b1, false, false); \
        v4u w = {r0[0], r1[0], r0[1], r1[1]}; OUT = *reinterpret_cast<bf16x8*>(&w); } while (0)
    PK4(p0, 0, pa0); PK4(p0, 8, pa1); PK4(p1, 0, pa2); PK4(p1, 8, pa3);
#undef PK4
}
struct Ctx { const bf16* QR; const bf16* KH; const bf16* VH; const bf16* PG; const bf16* GATE; bf16* AM; const float* ROPE; const float* gqn; const float* gqr; float b2; };

__device__ __forceinline__ void unit(const Ctx& C, int b, int h, int j, char* lds, LAS unsigned char* F_lds) {
    int tid = threadIdx.x; asm volatile("" : "+v"(tid));
    const int wid = __builtin_amdgcn_readfirstlane(tid >> 6), lane = tid & 63, r32 = lane & 31, hi = lane >> 5;
    const int P0 = NMETA + 256 * j, NT = 4 * j + 5;
    const int m0 = b * SEQ + 256 * j;
    char* V_lds = lds; char* K_lds = lds + 3 * SHM; float* li_l = (float*)(lds + 5 * SHM) + wid * 64;
    const bf16* Kh = C.KH + (size_t)b * TT * 768 + h * QKH; const bf16* Vh = C.VH + (size_t)b * TT * 1024 + h * VHD;
    bf16x8 qr[6];
    { const int mrow = m0 + wid * 32 + r32, pos = P0 + wid * 32 + r32;
      const bf16* qp = C.QR + (size_t)mrow * 768 + h * QKH + hi * 8;
      float f[6][8]; float ss = 0.f;
#pragma unroll
      for (int d0 = 0; d0 < 6; ++d0) { const v4u q = *(const GAS v4u*)(qp + d0 * 16);
          f[d0][0] = bflo(q.x); f[d0][1] = bfhi(q.x); f[d0][2] = bflo(q.y); f[d0][3] = bfhi(q.y); f[d0][4] = bflo(q.z); f[d0][5] = bfhi(q.z); f[d0][6] = bflo(q.w); f[d0][7] = bfhi(q.w);
#pragma unroll
          for (int e = 0; e < 8; ++e) ss += f[d0][e] * f[d0][e]; }
      ss = sum_x32(ss);
      const float rs = frsqrt(ss * (1.f / QKH) + EPS) * SCALE_L2E;
      const float* rp = C.ROPE + (size_t)pos * 32 + hi * 8;
#pragma unroll
      for (int e = 0; e < 8; ++e) { const float cs = rp[e], sn = rp[16 + e], x1 = f[4][e], x2 = f[5][e], g = C.gqr[hi * 8 + e] * rs;
          f[4][e] = (x1 * cs - x2 * sn) * g; f[5][e] = (x2 * cs + x1 * sn) * g; }
#pragma unroll
      for (int d0 = 0; d0 < 4; ++d0)
#pragma unroll
          for (int e = 0; e < 8; ++e) f[d0][e] *= C.gqn[d0 * 16 + hi * 8 + e] * rs;
#pragma unroll
      for (int d0 = 0; d0 < 6; ++d0) { v4u w; w.x = pk2(f[d0][0], f[d0][1]); w.y = pk2(f[d0][2], f[d0][3]); w.z = pk2(f[d0][4], f[d0][5]); w.w = pk2(f[d0][6], f[d0][7]); qr[d0] = *reinterpret_cast<bf16x8*>(&w); }
    }
    const int sr = tid >> 4, sc = (tid & 15) * 8, vst0 = v_st(sr, sc), vst1 = v_st(32 + sr, sc), kws = PA_KSWZ(sr, sc * 2);
    const int vb0 = (int)(uintptr_t)V_lds + v_rd_base(lane);
    const int qpos = P0 + wid * 32 + r32 - 4 * hi, qlo = P0 + wid * 32;
    const float b2 = C.b2;
    bf16x8 st_v0, st_v1, st_k0, st_k1;
    const unsigned kvo = (unsigned)(sr * 768 + sc) * 2u, vvo = (unsigned)(sr * 1024 + sc) * 2u;
#define SLOAD(k0) do { const char* kt_ = (const char*)Kh + (size_t)(k0) * 1536; const char* vt_ = (const char*)Vh + (size_t)(k0) * 2048; \
        st_v0 = *(const GAS bf16x8*)(vt_ + vvo); st_v1 = *(const GAS bf16x8*)(vt_ + 65536 + vvo); st_k0 = *(const GAS bf16x8*)(kt_ + kvo); st_k1 = *(const GAS bf16x8*)(kt_ + 49152 + kvo); } while (0)
#define SWRITE(kbf, voff) do { *(bf16x8*)(V_lds + (voff) + vst0) = st_v0; *(bf16x8*)(V_lds + (voff) + vst1) = st_v1; *(bf16x8*)(K_lds + (kbf) * SHM + kws) = st_k0; *(bf16x8*)(K_lds + (kbf) * SHM + kws + 32 * 256) = st_k1; } while (0)
#define MASKT(PX0, PX1, t) do { const int kb_ = (t) * 64; if (kb_ + 63 > qlo) mask_tile(PX0, PX1, qpos - kb_); } while (0)
    float l_reg = 0.f; f32x16 o[4] = {};
    f32x16 pA0, pA1, pB0, pB1; bf16x8 pa0, pa1, pa2, pa3;
    SLOAD(0); VM_WAIT(); SWRITE(0, 0); SBAR();
    SLOAD(64);
    __syncthreads();
    SBAR(); qkt<0>(pA0, pA1, K_lds, r32, hi, qr);
    MASKT(pA0, pA1, 0); exp_half(pA0, b2);
    VM_WAIT(); SWRITE(1, SHM);
    __syncthreads();
    int vr = 0;
#define HALF_STEP(PX0, PX1, PY0, PY1, t, KB, SB) do { \
        if ((t) + 1 < NT) { SLOAD(((t) + 1) * 64); }   \
        SBAR(); qkt<KB>(PX0, PX1, K_lds, r32, hi, qr); \
        finish(PY0, PY1, b2, l_reg, pa0, pa1, pa2, pa3); SBAR(); \
        pv_tile<0>(o, vb0 + vr, pa0, pa1, pa2, pa3); MASKT(PX0, PX1, (t)); exp_half(PX0, b2); \
        { const int vw = (vr >= SHM) ? vr - SHM : vr + 2 * SHM;                  \
          if ((t) + 1 < NT) { VM_WAIT(); SWRITE(SB, vw); } } \
        vr = (vr == 2 * SHM) ? 0 : vr + SHM; \
        __syncthreads(); } while (0)
    for (int t = 1; t + 1 < NT; t += 2) {
        HALF_STEP(pB0, pB1, pA0, pA1, t, 1, 0);
        HALF_STEP(pA0, pA1, pB0, pB1, t + 1, 0, 1);
    }
    finish(pA0, pA1, b2, l_reg, pa0, pa1, pa2, pa3); SBAR();
    pv_tile<0>(o, vb0 + vr, pa0, pa1, pa2, pa3);
    if (hi == 0) li_l[r32] = l_reg;
    asm volatile("s_waitcnt lgkmcnt(0)" ::: "memory");
    float rli[16];
#pragma unroll
    for (int r = 0; r < 16; ++r) rli[r] = __builtin_amdgcn_rcpf(li_l[crow(r, hi)]);
    __syncthreads();
    {
        LAS float* ot = (LAS float*)F_lds + wid * (32 * 132);
#pragma unroll
        for (int r = 0; r < 16; ++r)
#pragma unroll
            for (int d0 = 0; d0 < 4; ++d0) ot[crow(r, hi) * 132 + d0 * 32 + r32] = o[d0][r] * rli[r];
        asm volatile("s_waitcnt lgkmcnt(0)" ::: "memory");
        const int row = lane & 31, hf = lane >> 5; const size_t mrow = (size_t)(m0 + wid * 32 + row); const int col0 = h * VHD + hf * 64;
        const GAS v4u* gp = (const GAS v4u*)(C.GATE + mrow * 2048 + DM + col0); const GAS v4u* pp = (const GAS v4u*)(C.PG + mrow * DM + col0); GAS v4u* ap = (GAS v4u*)(C.AM + mrow * DM + col0);
        const LAS f32x4* orow = (const LAS f32x4*)(ot + row * 132 + hf * 64);
#pragma unroll
        for (int c = 0; c < 8; ++c) { const v4u g = gp[c], q = pp[c]; const f32x4 a = orow[2 * c], b = orow[2 * c + 1]; v4u w;
            w.x = pk2(bflo(q.x) + bflo(g.x) * a.x, bfhi(q.x) + bfhi(g.x) * a.y); w.y = pk2(bflo(q.y) + bflo(g.y) * a.z, bfhi(q.y) + bfhi(g.y) * a.w);
            w.z = pk2(bflo(q.z) + bflo(g.z) * b.x, bfhi(q.z) + bfhi(g.z) * b.y); w.w = pk2(bflo(q.w) + bflo(g.w) * b.z, bfhi(q.w) + bfhi(g.w) * b.w);
            ap[c] = w; }
    }
    __syncthreads();
#undef HALF_STEP
#undef MASKT
#undef SWRITE
#undef SLOAD
}
}
namespace sa {
constexpr int TK = 32, CT_HALF = 8192, CT_BYTES = 16384, KRT_PITCH = 80, KRT_BYTES = TK * KRT_PITCH, PL_PITCH = 96, PL_BYTES = 72 * PL_PITCH  , LZ_BYTES = 32768 + 4096;
constexpr int OFF_CT = 0, OFF_LZ = 3 * CT_BYTES, OFF_KRT = OFF_LZ + 2 * LZ_BYTES, OFF_KSS = OFF_KRT + 3 * KRT_BYTES, OFF_PL = OFF_KSS + 3 * 128, OFF_PT = OFF_PL + 2 * PL_BYTES,
              OFF_QF = OFF_PT + 256, OFF_END = OFF_QF + 8 * 1536;
#ifndef SMALL_LDS
static_assert(OFF_END <= RING_BYTES, "sample attention LDS");
#endif
__device__ __forceinline__ unsigned off_b(unsigned row, unsigned ch) { return 256u * row + 16u * (ch ^ (((row & 3) << 2) | ((0u - (row >> 2)) & 3))); }
typedef float f32x4_t __attribute__((ext_vector_type(4)));
struct Ctx { const float* cache_c; const float* cache_kr; const int* page_table; const float* new_c; const float* new_kr; const bf16* QR; const bf16* Wuk_t; const float* ROPE;
             const float *gqn, *gqr, *gkn, *gkr; float* SAC; float* SAL; float b2; };

typedef short v4i16_t __attribute__((ext_vector_type(4)));
__device__ __forceinline__ s16x4 tr_read(unsigned addr) { return __builtin_bit_cast(s16x4, __builtin_amdgcn_ds_read_tr16_b64_v4i16((__attribute__((address_space(3))) v4i16_t*)(uintptr_t)addr)); }

__device__ __forceinline__ void item(const Ctx& C, int db, int hf, LAS unsigned char* lds) {
    int tid = threadIdx.x; asm volatile("" : "+v"(tid));
    const int wid = __builtin_amdgcn_readfirstlane(tid >> 6), lane = tid & 63, fr = lane & 15, fq = lane >> 4;
    const int h = wid;
    volatile LAS int* pt = (volatile LAS int*)(lds + OFF_PT);
    { const int* ptg = C.page_table + db * NPAGES + hf * 32; asm volatile("" : "+s"(ptg)); if (tid < 32) pt[tid] = ptg[tid]; }
    {
        bf16x8 Aq0, Aq1, Aqr;
        const int s = fr & 7; const int mrow = MP + db * DSEQ + s;
        const bf16* qrb = C.QR; asm volatile("" : "+s"(qrb));
        const bf16* qp = qrb + (size_t)mrow * 768 + h * QKH;
        float qn[2][8], qro[8], ss = 0.f;
#pragma unroll
        for (int ii = 0; ii < 2; ++ii)
#pragma unroll
            for (int j = 0; j < 8; ++j) { const int d = 16 * (2 * ii + (j >> 2)) + 4 * fq + (j & 3); const float v = bflo((unsigned)qp[d]); qn[ii][j] = v; ss += v * v; }
        const float* rp = C.ROPE + (size_t)(TT + s) * 32;
#pragma unroll
        for (int j = 0; j < 8; ++j) { const int i = 8 * fq + j, i2 = i & 15; const float own = bflo((unsigned)qp[64 + i]), oth = bflo((unsigned)qp[64 + (i ^ 16)]);
            ss += own * own;
            const float cs = rp[i2], sn = rp[16 + i2];
            qro[j] = (i < 16) ? own * cs - oth * sn : own * cs + oth * sn; }
        ss = sum_x32(sum_x16(ss));
        const float rs = (fr < 8) ? frsqrt(ss * (1.f / QKH) + EPS) * SCALE_L2E : 0.f;
#pragma unroll
        for (int ii = 0; ii < 2; ++ii)
#pragma unroll
            for (int j = 0; j < 8; ++j) { const int d = 16 * (2 * ii + (j >> 2)) + 4 * fq + (j & 3); qn[ii][j] *= rs * C.gqn[d] * C.gkn[d]; }
#pragma unroll
        for (int j = 0; j < 8; ++j) { const int i2 = (8 * fq + j) & 15; qro[j] *= rs * C.gqr[i2] * C.gkr[i2]; }
        v4u w; w.x = pk2(qn[0][0], qn[0][1]); w.y = pk2(qn[0][2], qn[0][3]); w.z = pk2(qn[0][4], qn[0][5]); w.w = pk2(qn[0][6], qn[0][7]); Aq0 = *reinterpret_cast<bf16x8*>(&w);
        w.x = pk2(qn[1][0], qn[1][1]); w.y = pk2(qn[1][2], qn[1][3]); w.z = pk2(qn[1][4], qn[1][5]); w.w = pk2(qn[1][6], qn[1][7]); Aq1 = *reinterpret_cast<bf16x8*>(&w);
        w.x = pk2(qro[0], qro[1]); w.y = pk2(qro[2], qro[3]); w.z = pk2(qro[4], qro[5]); w.w = pk2(qro[6], qro[7]); Aqr = *reinterpret_cast<bf16x8*>(&w);
        if (fr < 8) { LAS bf16x8* qf = (LAS bf16x8*)(lds + OFF_QF + wid * 1536) + fq * 8 + fr; qf[0] = Aq0; qf[32] = Aq1; qf[64] = Aqr; }
    }
    __syncthreads();
    bf16x8 Wf[4][8];
    { const bf16* wp = C.Wuk_t + (size_t)(h * 64 + fr) * KVL + 8 * fq;
#pragma unroll
      for (int i = 0; i < 4; ++i)
#pragma unroll
          for (int ks = 0; ks < 8; ++ks) Wf[i][ks] = *(const GAS bf16x8*)(wp + (size_t)(16 * i) * KVL + 32 * ks);
#pragma unroll
      for (int i = 0; i < 4; ++i)
#pragma unroll
          for (int ks = 0; ks < 8; ++ks) asm volatile("" : "+v"(Wf[i][ks])); }
    const int NT = hf ? 129 : 128;
    const unsigned xr = ((fr & 3) << 2) | ((0u - (unsigned)(fr >> 2)) & 3);
#define SA_DMA(uu) do { const int u_ = (uu); LAS unsigned char* lz_ = lds + OFF_LZ + (u_ & 1) * LZ_BYTES; \
        if (u_ < 128) { const size_t phys = (size_t)__builtin_amdgcn_readfirstlane(pt[u_ >> 2]);     const float* cp = C.cache_c + (phys * PAGE + (u_ & 3) * TK) * KVL + lane * 4; \
            _Pragma("unroll") for (int i = 0; i < 4; ++i) __builtin_amdgcn_global_load_lds((const unsigned*)(cp + (size_t)(i * 8 + wid) * KVL), (LAS unsigned*)(lz_ + (i * 8 + wid) * 1024), 16, 0, 2); \
            if (wid < 4) { const float* kp = C.cache_kr + (phys * PAGE + (u_ & 3) * TK) * QKR + (wid * 64 + lane) * 4; __builtin_amdgcn_global_load_lds((const unsigned*)kp, (LAS unsigned*)(lz_ + 32768 + wid * 1024), 16, 0, 2); } } \
        else { int ln_ = lane; asm volatile("" : "+v"(ln_));   \
            const float* sp_ = C.new_c + (size_t)(db * DSEQ + wid) * KVL + ln_ * 4; \
            _Pragma("unroll") for (int i = 0; i < 4; ++i) __builtin_amdgcn_global_load_lds((const unsigned*)sp_, (LAS unsigned*)(lz_ + (i * 8 + wid) * 1024), 16, 0, 0); \
            if (wid < 4) __builtin_amdgcn_global_load_lds((const unsigned*)(C.new_kr + (size_t)db * DSEQ * QKR + ln_ * 4), (LAS unsigned*)(lz_ + 32768 + wid * 1024), 16, 0, 0); } } while (0)
#define SA_CONVERT(uu, bb) do { const int u_ = (uu); const unsigned lz_ = (unsigned)(uintptr_t)(lds + OFF_LZ) + (u_ & 1) * LZ_BYTES + wid * 1024 + lane * 16; \
        LAS unsigned char* ct_ = lds + OFF_CT + (bb) * CT_BYTES + (lane >> 5) * CT_HALF; const unsigned co_ = ((lane & 31) >> 1), cb_ = 8 * (lane & 1); \
        f32x4 v0_, v1_, v2_, v3_, k_;   \
        asm volatile("ds_read_b128 %0, %1" : "=v"(v0_) : "v"(lz_)); asm volatile("ds_read_b128 %0, %1 offset:8192" : "=v"(v1_) : "v"(lz_)); \
        asm volatile("ds_read_b128 %0, %1 offset:16384" : "=v"(v2_) : "v"(lz_)); asm volatile("ds_read_b128 %0, %1 offset:24576" : "=v"(v3_) : "v"(lz_)); \
        if (wid < 4) asm volatile("ds_read_b128 %0, %1 offset:32768" : "=v"(k_) : "v"(lz_)); \
        asm volatile("s_waitcnt lgkmcnt(0)" : "+v"(v0_), "+v"(v1_), "+v"(v2_), "+v"(v3_)); \
        if (u_ >= 128) { v1_ = v1_ * 0.f; v2_ = v2_ * 0.f; v3_ = v3_ * 0.f; } \
        { v2u w_; w_.x = pk2(v0_.x, v0_.y); w_.y = pk2(v0_.z, v0_.w); *(LAS v2u*)(ct_ + off_b(wid, co_) + cb_) = w_; } \
        { v2u w_; w_.x = pk2(v1_.x, v1_.y); w_.y = pk2(v1_.z, v1_.w); *(LAS v2u*)(ct_ + off_b(8 + wid, co_) + cb_) = w_; } \
        { v2u w_; w_.x = pk2(v2_.x, v2_.y); w_.y = pk2(v2_.z, v2_.w); *(LAS v2u*)(ct_ + off_b(16 + wid, co_) + cb_) = w_; } \
        { v2u w_; w_.x = pk2(v3_.x, v3_.y); w_.y = pk2(v3_.z, v3_.w); *(LAS v2u*)(ct_ + off_b(24 + wid, co_) + cb_) = w_; } \
        if (wid < 4) { asm volatile("" : "+v"(k_)); if (u_ >= 128 && wid > 0) k_ = k_ * 0.f; \
          v2u w_; w_.x = pk2(k_.x, k_.y); w_.y = pk2(k_.z, k_.w); *(LAS v2u*)(lds + OFF_KRT + (bb) * KRT_BYTES + (wid * 8 + (lane >> 3)) * KRT_PITCH + (lane & 7) * 8) = w_; \
          float s_ = (k_.x * k_.x + k_.y * k_.y) + (k_.z * k_.z + k_.w * k_.w); s_ = sum_oct(s_); if ((lane & 7) == 0) *(LAS float*)(lds + OFF_KSS + (bb) * 128 + (wid * 8 + (lane >> 3)) * 4) = s_; } } while (0)
#define SA_BAR() do { asm volatile("s_waitcnt lgkmcnt(0)" ::: "memory"); __builtin_amdgcn_s_barrier(); asm volatile("" ::: "memory"); } while (0)
#define SA_WAIT_OLDER() do { if (wid < 4) asm volatile("s_waitcnt vmcnt(5)" ::: "memory"); else asm volatile("s_waitcnt vmcnt(4)" ::: "memory"); } while (0)
#define SA_CTX(bb, pb) do { int lc_ = lane; asm volatile("" : "+v"(lc_)); const int frc = lc_ & 15, fqc = lc_ >> 4; \
        const unsigned ctb = (unsigned)(uintptr_t)(lds + OFF_CT) + (bb) * CT_BYTES + hh * CT_HALF; \
        const LAS unsigned char* plb = lds + OFF_PL + (pb) * PL_BYTES + frc * PL_PITCH + fqc * 16; \
        s16x4 tv[2][2]; \
        { const unsigned row = 8 * fqc + (frc >> 2), pp = lc_ & 3; const unsigned a0_ = ctb + off_b(row, 2 * c0 + (pp >> 1)) + 8 * (pp & 1); \
            \
          const unsigned a1_ = a0_ ^ 0x20u, a2_ = a0_ ^ 0x30u, a3_ = a0_ ^ 0x10u; \
          asm volatile("ds_read_b64_tr_b16 %0, %1" : "=&v"(tv[0][0]) : "v"(a0_) : "memory"); asm volatile("ds_read_b64_tr_b16 %0, %1 offset:1024" : "=&v"(tv[0][1]) : "v"(a2_) : "memory"); \
          asm volatile("ds_read_b64_tr_b16 %0, %1" : "=&v"(tv[1][0]) : "v"(a1_) : "memory"); asm volatile("ds_read_b64_tr_b16 %0, %1 offset:1024" : "=&v"(tv[1][1]) : "v"(a3_) : "memory"); } \
        bf16x8 A[4]; _Pragma("unroll") for (int rt = 0; rt < 4; ++rt) A[rt] = *(const LAS bf16x8*)(plb + rt * 16 * PL_PITCH); \
        const bf16x8 Al = *(const LAS bf16x8*)(plb + srt * 16 * PL_PITCH); \
        asm volatile("s_waitcnt lgkmcnt(0)" ::: "memory"); __builtin_amdgcn_sched_barrier(0); \
        const bf16x8 B0 = (bf16x8){tv[0][0][0], tv[0][0][1], tv[0][0][2], tv[0][0][3], tv[0][1][0], tv[0][1][1], tv[0][1][2], tv[0][1][3]}; \
        const bf16x8 B1 = (bf16x8){tv[1][0][0], tv[1][0][1], tv[1][0][2], tv[1][0][3], tv[1][1][0], tv[1][1][1], tv[1][1][2], tv[1][1][3]}; \
        _Pragma("unroll") for (int rt = 0; rt < 4; ++rt) { ctx[rt][0] = __builtin_amdgcn_mfma_f32_16x16x32_bf16(A[rt], B0, ctx[rt][0], 0, 0, 0); \
                                                            ctx[rt][1] = __builtin_amdgcn_mfma_f32_16x16x32_bf16(A[rt], B1, ctx[rt][1], 0, 0, 0); } \
        { const v4u au = *reinterpret_cast<const v4u*>(&Al); \
          lacc += ((bflo(au.x) + bfhi(au.x)) + (bflo(au.y) + bfhi(au.y))) + ((bflo(au.z) + bfhi(au.z)) + (bflo(au.w) + bfhi(au.w))); } } while (0)
    f32x4 ctx[4][2];
#pragma unroll
    for (int rt = 0; rt < 4; ++rt) { ctx[rt][0] = (f32x4){0.f, 0.f, 0.f, 0.f}; ctx[rt][1] = (f32x4){0.f, 0.f, 0.f, 0.f}; }
    float lacc = 0.f;
    const float b2 = C.b2;
    const int hh = wid >> 2, c0 = 2 * (wid & 3), srt = wid >> 1;
    const int prow = (fq < 2) ? h * 8 + 4 * fq : 64 + 4 * (fq - 2);
    SA_DMA(0); SA_DMA(1); SA_WAIT_OLDER(); SA_CONVERT(0, 0); SA_DMA(2);
#ifdef SYNTH_MFMA
    {
        f32x4 Y[4]; for (int i = 0; i < 4; ++i) Y[i] = (f32x4){0.f, 0.f, 0.f, 0.f};
        bf16x8 Bs = Wf[0][0]; int nsy_ = 258; asm volatile("" : "+s"(nsy_));
        for (int r = 0; r < nsy_; ++r) {
#if SYNTH_MFMA == 2
            { const unsigned a_ = (unsigned)(uintptr_t)(lds + OFF_CT) + 256 * fr + 16 * (fq ^ xr); asm volatile("ds_read_b128 %0, %1\n\ts_waitcnt lgkmcnt(0)" : "=v"(Bs) : "v"(a_)); }
#endif
#pragma unroll
            for (int ks = 0; ks < 8; ++ks) {
#pragma unroll
                for (int i = 0; i < 4; ++i) Y[i] = __builtin_amdgcn_mfma_f32_16x16x32_bf16(Wf[i][ks], Bs, Y[i], 0, 0, 0); }
            asm volatile("" : "+v"(Bs));
        }
        float z_ = 0.f; asm volatile("" : "+v"(z_));
        lacc += (Y[0].x + Y[1].x + Y[2].x + Y[3].x) * z_;
    }
#endif
    SA_BAR();
#ifndef SA_NO_PRIO
    if (wid < 4) __builtin_amdgcn_s_setprio(2);
#endif
    int bc = 0;
    for (int u = 0; u < NT; ++u) {
        const int bn = (bc == 2) ? 0 : bc + 1, bp = (bc == 0) ? 2 : bc - 1;
        const int pb = u & 1;
        const int qlim = (u == 128) ? 0 : 1000;
        if (wid >= 4) { if (u > 0) SA_CTX(bp, pb ^ 1); }
        unsigned ba[4];
#pragma unroll
        for (int j = 0; j < 4; ++j) ba[j] = (unsigned)(uintptr_t)(lds + OFF_CT) + bc * CT_BYTES + 256 * fr + 16 * ((j * 4 + fq) ^ xr);
#define SA_RD(dst, j, off_) asm volatile("ds_read_b128 %0, %1 offset:%2" : "=v"(dst) : "v"(ba[j]), "i"(off_))
#define SA_WT(n, b) asm volatile("s_waitcnt lgkmcnt(" #n ")" : "+v"(b))
#define SA_MF(X, ks, b) do { _Pragma("unroll") for (int i = 0; i < 4; ++i) X[i] = __builtin_amdgcn_mfma_f32_16x16x32_bf16(Wf[i][ks], b, X[i], 0, 0, 0); } while (0)
#define SA_PRE(KO, B0, B1, B2) do { SA_RD(B0, 0, KO); SA_RD(B1, 1, KO); SA_RD(B2, 2, KO); } while (0)
#define SA_BURST(KO, X, B0, B1, B2) do { \
            SA_WT(2, B0); SA_MF(X, 0, B0); SA_RD(B0, 3, KO); \
            SA_WT(2, B1); SA_MF(X, 1, B1); SA_RD(B1, 0, KO + CT_HALF); \
            SA_WT(2, B2); SA_MF(X, 2, B2); SA_RD(B2, 1, KO + CT_HALF); \
            SA_WT(2, B0); SA_MF(X, 3, B0); SA_RD(B0, 2, KO + CT_HALF); \
            SA_WT(2, B1); SA_MF(X, 4, B1); SA_RD(B1, 3, KO + CT_HALF); \
            SA_WT(2, B2); SA_MF(X, 5, B2); \
            SA_WT(1, B0); SA_MF(X, 6, B0); \
            SA_WT(0, B1); SA_MF(X, 7, B1); } while (0)
#define SA_TAIL(kg, X) do { \
            float ss = 0.f; \
            _Pragma("unroll") for (int i = 0; i < 4; ++i) ss += (X[i].x * X[i].x + X[i].y * X[i].y) + (X[i].z * X[i].z + X[i].w * X[i].w); \
            ss = sum_x32(sum_x16(ss)); \
            const float krss = *(const LAS float*)(lds + OFF_KSS + bc * 128 + (kg * 16 + fr) * 4); \
            const float rstd = __builtin_amdgcn_rsqf((ss + krss) * (1.f / QKH) + EPS); \
            v4u w0, w1; w0.x = pk2(X[0].x, X[0].y); w0.y = pk2(X[0].z, X[0].w); w0.z = pk2(X[1].x, X[1].y); w0.w = pk2(X[1].z, X[1].w); \
            w1.x = pk2(X[2].x, X[2].y); w1.y = pk2(X[2].z, X[2].w); w1.z = pk2(X[3].x, X[3].y); w1.w = pk2(X[3].z, X[3].w); \
            const bf16x8 krf = *(const LAS bf16x8*)(lds + OFF_KRT + bc * KRT_BYTES + (kg * 16 + fr) * KRT_PITCH + fq * 16); \
            f32x4 S = (f32x4){0.f, 0.f, 0.f, 0.f}; \
            const LAS bf16x8* qf = (const LAS bf16x8*)(lds + OFF_QF + wid * 1536) + fq * 8 + (fr & 7); \
            const bf16x8 Aq0 = qf[0], Aq1 = qf[32], Aqr = qf[64];                \
            S = __builtin_amdgcn_mfma_f32_16x16x32_bf16(Aq0, *reinterpret_cast<bf16x8*>(&w0), S, 0, 0, 0); \
            S = __builtin_amdgcn_mfma_f32_16x16x32_bf16(Aq1, *reinterpret_cast<bf16x8*>(&w1), S, 0, 0, 0); \
            S = __builtin_amdgcn_mfma_f32_16x16x32_bf16(Aqr, krf, S, 0, 0, 0); \
            f32x4 p; \
            _Pragma("unroll") for (int e = 0; e < 4; ++e) p[e] = __builtin_amdgcn_exp2f(S[e] * rstd - b2); \
            { const int kk = kg * 16 + fr - 4 * fq;                               \
              _Pragma("unroll") for (int e = 0; e < 4; ++e) p[e] = (kk > e + qlim) ? 0.f : p[e]; } \
            { LAS bf16* pl = (LAS bf16*)(lds + OFF_PL + pb * PL_BYTES + prow * PL_PITCH) + kg * 16 + fr;     \
              _Pragma("unroll") for (int e = 0; e < 4; ++e) pl[e * (PL_PITCH / 2)] = (bf16)pk2(p[e], 0.f); } } while (0)
#ifdef SA_REP_SCORE
        int nrs_ = 2; asm volatile("" : "+s"(nrs_)); for (int rs_ = 0; rs_ < nrs_; ++rs_)
#endif
        {
            f32x4 Xa[4], Xb[4];
#pragma unroll
            for (int i = 0; i < 4; ++i) { Xa[i] = (f32x4){0.f, 0.f, 0.f, 0.f}; Xb[i] = (f32x4){0.f, 0.f, 0.f, 0.f}; }
            bf16x8 Ba0, Ba1, Ba2, Bb0, Bb1, Bb2;
            SA_PRE(0, Ba0, Ba1, Ba2);
            SA_BURST(0, Xa, Ba0, Ba1, Ba2);
            SA_PRE(4096, Bb0, Bb1, Bb2);
            SA_BURST(4096, Xb, Bb0, Bb1, Bb2);
            SA_TAIL(0, Xa);
            SA_TAIL(1, Xb);
#ifdef SA_REP_TAIL
            { int nt_ = 1; asm volatile("" : "+s"(nt_)); for (int r_ = 0; r_ < nt_; ++r_) { asm volatile("" : "+v"(Xb[0]), "+v"(Xb[1]), "+v"(Xb[2]), "+v"(Xb[3])); SA_TAIL(1, Xb); } }
#endif
        }
#undef SA_RD
#undef SA_WT
#undef SA_MF
#undef SA_PRE
#undef SA_BURST
#undef SA_TAIL
        if (wid < 4) { if (u > 0) SA_CTX(bp, pb ^ 1); }
        if (u + 1 < NT) {
            if (u + 2 < NT) SA_WAIT_OLDER(); else VM_WAIT();
            SA_CONVERT(u + 1, bn);
            if (u + 3 < NT) SA_DMA(u + 3);
        }
        SA_BAR();
        bc = bn;
    }
    { const int bl = (bc == 0) ? 2 : bc - 1; SA_CTX(bl, (NT - 1) & 1); }
#ifndef SA_NO_PRIO
    __builtin_amdgcn_s_setprio(0);
#endif
    const int it = db * 2 + hf;
    lacc = sum_x32(sum_x16(lacc));
    if (fq == 0 && (fr >> 3) == (wid & 1)) C.SAL[(size_t)it * 64 + h * 8 + (fr & 7)] = lacc;
    float* cp = C.SAC + (size_t)it * 64 * 256;
#pragma unroll
    for (int rt = 0; rt < 4; ++rt)
#pragma unroll
        for (int cb = 0; cb < 2; ++cb)
#pragma unroll
            for (int e = 0; e < 4; ++e) cp[(size_t)(rt * 16 + 4 * fq + e) * 256 + hh * 128 + 16 * (c0 + cb) + fr] = ctx[rt][cb][e];
    __syncthreads();
#undef SA_DMA
#undef SA_CONVERT
#undef SA_BAR
#undef SA_WAIT_OLDER
#undef SA_CTX
}
}
namespace g2 {
using pg8::Unit; using pg8::Gemm;
constexpr int TILE_BYTES = 32768, BUF_BYTES = 65536;
template <class Epi, class Sched>
__device__ __forceinline__ void gemm_phase(LAS unsigned char* lds, const Gemm g, const Sched& S, const Epi& E) {
    int tid = threadIdx.x; asm volatile("" : "+v"(tid));
    const int wid = __builtin_amdgcn_readfirstlane(tid >> 6), lane = tid & 63, wr = wid >> 2, wc = wid & 3, fr = lane & 15, fq = lane >> 4;
    const int K = g.K, nt = K / 64;
    Unit cur, nxt;
    if (!S.next(0, cur)) return;
    const int srow = tid >> 3, sch = tid & 7;
    const int rb0 = Epi::PERM ? ((srow & ~31) + pg8::perm32(srow & 31)) : srow;
    const unsigned goffA0 = (unsigned)(srow * K + sch * 8) * 2u, goffB0 = (unsigned)(rb0 * K + sch * 8) * 2u, loff0 = (unsigned)(srow * 128 + ((sch ^ (srow & 7)) << 4));
    const size_t rstep = (size_t)64 * K * 2;
    const size_t tstep = (size_t)256 * K * 2;
    const unsigned cx0 = (unsigned)(((0 + fq) ^ (fr & 7)) << 4), cx1 = (unsigned)(((4 + fq) ^ (fr & 7)) << 4);
    const unsigned abase = (unsigned)((64 * wr + fr) * 128), bbase = (unsigned)(TILE_BYTES + (32 * wc + fr) * 128);
    v4u sa[4], sb[4];
#define G2_LOAD(pa, pb, kt) do { const char* a_ = (pa) + (size_t)(kt) * 128; const char* b_ = (pb) + (size_t)(kt) * 128; \
        _Pragma("unroll") for (int i = 0; i < 4; ++i) { sa[i] = *(const GAS v4u*)(a_ + i * rstep + goffA0); sb[i] = *(const GAS v4u*)(b_ + i * rstep + goffB0); } } while (0)
#define G2_WRITE(buf) do { LAS unsigned char* d_ = lds + (buf) * BUF_BYTES; \
        _Pragma("unroll") for (int i = 0; i < 4; ++i) { *(LAS v4u*)(d_ + i * 8192 + loff0) = sa[i]; *(LAS v4u*)(d_ + TILE_BYTES + i * 8192 + loff0) = sb[i]; } } while (0)
    pg8::f32x4 acc[2][2][4][2];
#define G2_ZERO() do { _Pragma("unroll") for (int a = 0; a < 2; ++a) _Pragma("unroll") for (int b = 0; b < 2; ++b) _Pragma("unroll") for (int m = 0; m < 4; ++m) _Pragma("unroll") for (int n = 0; n < 2; ++n) acc[a][b][m][n] = (pg8::f32x4){0.f, 0.f, 0.f, 0.f}; } while (0)
    G2_ZERO();
    const char* cA = (const char*)g.A + (size_t)cur.pm * tstep; const char* cB = (const char*)g.Bt + (size_t)cur.pn * tstep;
    G2_LOAD(cA, cB, 0); VM_WAIT(); G2_WRITE(0);
    __syncthreads();
    int buf = 0, ui = 0;
    for (;;) {
        const bool has_next = S.next(ui + 1, nxt);
        const char* nA = has_next ? (const char*)g.A + (size_t)nxt.pm * tstep : cA; const char* nB = has_next ? (const char*)g.Bt + (size_t)nxt.pn * tstep : cB;
        for (int kt = 0; kt < nt; ++kt) {
            const bool last = (kt == nt - 1);
            const bool pre = !last || has_next;
            if (pre) { if (last) G2_LOAD(nA, nB, 0); else G2_LOAD(cA, cB, kt + 1); }
            const LAS unsigned char* tb = lds + buf * BUF_BYTES;
#pragma unroll
            for (int ks = 0; ks < 2; ++ks) {
                const unsigned cx = ks ? cx1 : cx0;
                pg8::bf16x8 bf[2][2];
#pragma unroll
                for (int bj = 0; bj < 2; ++bj)
#pragma unroll
                    for (int n = 0; n < 2; ++n) bf[bj][n] = *(const LAS pg8::bf16x8*)(tb + bbase + (128 * bj + 16 * n) * 128 + cx);
#pragma unroll
                for (int ai = 0; ai < 2; ++ai) {
                    pg8::bf16x8 af[4];
#pragma unroll
                    for (int m = 0; m < 4; ++m) af[m] = *(const LAS pg8::bf16x8*)(tb + abase + (128 * ai + 16 * m) * 128 + cx);
#pragma unroll
                    for (int bj = 0; bj < 2; ++bj)
#pragma unroll
                        for (int m = 0; m < 4; ++m)
#pragma unroll
                            for (int n = 0; n < 2; ++n) acc[ai][bj][m][n] = __builtin_amdgcn_mfma_f32_16x16x32_bf16(bf[bj][n], af[m], acc[ai][bj][m][n], 0, 0, 0);
                }
            }
#ifdef G2_SINGLE_BUF
            __syncthreads();
            if (pre) { VM_WAIT(); G2_WRITE(0); }
            __syncthreads();
#else
            if (pre) { VM_WAIT(); G2_WRITE(buf ^ 1); }
            __syncthreads();
            buf ^= 1;
#endif
        }
        E(acc, cur, wr, wc, fr, fq);
        if (!has_next) break;
        G2_ZERO();
        cur = nxt; cA = nA; cB = nB; ++ui;
    }
    __syncthreads();
#undef G2_LOAD
#undef G2_WRITE
#undef G2_ZERO
}
}
__device__ __forceinline__ void p3_meta_kv(Frame& F) {
    const int lane = F.lane, wv = F.wave;
    const float* CM = WSP(float, WS_CM); const float* KRM = WSP(float, WS_KRM); const float* KSM = WSP(float, WS_KSM);
    bf16* KH = WSP(bf16, WS_KH); bf16* VH = WSP(bf16, WS_VH);
    LAS float* part = (LAS float*)F.lds;
    for (int t = F.vcu; t < 256; t += F.G) {
        const int i = (t >> 3) & 15, h = t & 7; const float* c = CM + i * KVL + 32 * wv;
        float a0 = 0.f, a1 = 0.f;
        if (t < 128) {
#pragma unroll
            for (int r = 0; r < 32; ++r) a0 += c[r] * F.w_uk[(size_t)(32 * wv + r) * 512 + h * 64 + lane];
        } else {
#pragma unroll
            for (int r = 0; r < 32; ++r) { const float cr = c[r]; a0 += cr * F.w_uv[(size_t)(32 * wv + r) * 1024 + h * 128 + lane]; a1 += cr * F.w_uv[(size_t)(32 * wv + r) * 1024 + h * 128 + 64 + lane]; }
        }
        part[wv * 128 + lane] = a0; part[wv * 128 + 64 + lane] = a1;
        __syncthreads();
        if (wv == 0) {
            float s0 = 0.f, s1 = 0.f;
#pragma unroll
            for (int w = 0; w < 8; ++w) { s0 += part[w * 128 + lane]; s1 += part[w * 128 + 64 + lane]; }
            if (t < 128) {
                const float ss = wave_sum(s0 * s0);
                const float rstd = frsqrt((ss + KSM[i]) * (1.f / QKH) + EPS);
                const bf16 kv = (bf16)f2bf(s0 * rstd * F.g_kn_nope[lane]);
                const bf16 kr = (bf16)f2bf(KRM[i * 32 + (lane & 31)] * rstd);
                for (int b = 0; b < NBATCH; ++b) { bf16* kp = KH + (size_t)(b * TT + i) * 768 + h * QKH; kp[lane] = kv; if (lane < 32) kp[64 + lane] = kr; }
            } else {
                const bf16 v0 = (bf16)f2bf(s0), v1 = (bf16)f2bf(s1);
                for (int b = 0; b < NBATCH; ++b) { bf16* vp = VH + (size_t)(b * TT + i) * 1024 + h * VHD; vp[lane] = v0; vp[64 + lane] = v1; }
            }
        }
        __syncthreads();
    }
}
__device__ __forceinline__ void p1_naive(Frame& F) {
    const bf16* XN = WSP(bf16, WS_XN); const bf16* Win_t = WSP(bf16, WS_WIN); float* PF = WSP(float, WS_PF); bf16* GATE = WSP(bf16, WS_GATE);
    const size_t gt = (size_t)F.vcu * NWAVES * 64 + F.tid, NGT = (size_t)F.G * NWAVES * 64;
    for (size_t idx = gt; idx < (size_t)MC * (NIN / 8); idx += NGT) {
        const size_t m = idx / (NIN / 8); const int n0 = (int)(idx % (NIN / 8)) * 8;
        float acc[8];
#pragma unroll
        for (int j = 0; j < 8; ++j) acc[j] = 0.f;
        for (int k = 0; k < DM; k += 8) {
            const v4u x = *(const GAS v4u*)(XN + m * DM + k);
            const float xf[8] = {bflo(x.x), bfhi(x.x), bflo(x.y), bfhi(x.y), bflo(x.z), bfhi(x.z), bflo(x.w), bfhi(x.w)};
#pragma unroll
            for (int j = 0; j < 8; ++j) { const v4u w = *(const GAS v4u*)(Win_t + (size_t)(n0 + j) * DM + k);
                acc[j] += xf[0] * bflo(w.x) + xf[1] * bfhi(w.x) + xf[2] * bflo(w.y) + xf[3] * bfhi(w.y) + xf[4] * bflo(w.z) + xf[5] * bfhi(w.z) + xf[6] * bflo(w.w) + xf[7] * bfhi(w.w); }
        }
        if (n0 < PFW) {
#pragma unroll
            for (int j = 0; j < 8; ++j) PF[m * PFW + n0 + j] = acc[j];
        } else {
#pragma unroll
            for (int j = 0; j < 8; ++j) GATE[m * 2048 + (n0 - PFW) + j] = (bf16)f2bf(sigmoidf_fast(acc[j]));
        }
    }
}
__device__ __forceinline__ void p5_unit(Frame& F, int h, int tb) {
    constexpr int PITCH = 528;
    const int tid = F.tid, lane = F.lane, wid = F.wave, fr = lane & 15, fq = lane >> 4;
    LAS unsigned char* At = F.lds; LAS unsigned char* Bt = F.lds + 32 * PITCH;
    const float* SAC = WSP(float, WS_SAC); const float* SAL = WSP(float, WS_SAL); const bf16* Wuv_t = WSP(bf16, WS_WKV) + (size_t)512 * KVL;
    for (int e = tid; e < 32 * 64; e += NWAVES * 64) { const int row = e >> 6, c4 = e & 63, tok = tb * 32 + row, db = tok >> 3, r = h * 8 + (tok & 7);
        const f32x4 a = *((const GAS f32x4*)(SAC + ((size_t)(2 * db) * 64 + r) * 256) + c4), b = *((const GAS f32x4*)(SAC + ((size_t)(2 * db + 1) * 64 + r) * 256) + c4);
        const float il = 1.0f / (SAL[(2 * db) * 64 + r] + SAL[(2 * db + 1) * 64 + r]);
        v2u w; w.x = pk2((a.x + b.x) * il, (a.y + b.y) * il); w.y = pk2((a.z + b.z) * il, (a.w + b.w) * il);
        *(LAS v2u*)(At + row * PITCH + c4 * 8) = w; }
    for (int e = tid; e < 128 * 32; e += NWAVES * 64) { const int row = e >> 5, ch = e & 31;
        *(LAS v4u*)(Bt + row * PITCH + ch * 16) = *(const GAS v4u*)(Wuv_t + (size_t)(h * 128 + row) * KVL + ch * 8); }
    __syncthreads();
    f32x4 acc[2];
    acc[0] = (f32x4){0.f, 0.f, 0.f, 0.f}; acc[1] = (f32x4){0.f, 0.f, 0.f, 0.f};
    const int cbase = wid * 16;
#pragma unroll
    for (int ks = 0; ks < 8; ++ks) {
        const bf16x8 bfm = *(const LAS bf16x8*)(Bt + (cbase + fr) * PITCH + (32 * ks + 8 * fq) * 2);
#pragma unroll
        for (int rt = 0; rt < 2; ++rt) { const bf16x8 af = *(const LAS bf16x8*)(At + (rt * 16 + fr) * PITCH + (32 * ks + 8 * fq) * 2);
            acc[rt] = __builtin_amdgcn_mfma_f32_16x16x32_bf16(af, bfm, acc[rt], 0, 0, 0); }
    }
    const bf16* PG = WSP(bf16, WS_PG); const bf16* GATE = WSP(bf16, WS_GATE); bf16* AMS = WSP(bf16, WS_AMS);
    const int col = h * VHD + cbase + fr;
#pragma unroll
    for (int rt = 0; rt < 2; ++rt)
#pragma unroll
        for (int e = 0; e < 4; ++e) { const int tok = tb * 32 + rt * 16 + 4 * fq + e; const size_t m = (size_t)(MP + tok);
            const float g = bflo((unsigned)GATE[m * 2048 + DM + col]), pg = bflo((unsigned)PG[m * DM + col]);
            AMS[((size_t)(col >> 8) * MS + tok) * 256 + (col & 255)] = (bf16)f2bf(pg + g * acc[rt][e]); }
    __syncthreads();
}
__device__ __forceinline__ void p7_hn(Frame& F) {
    const int gw = F.vcu * NWAVES + F.wave, NGW = F.G * NWAVES, lane = F.lane;
    const float* H = WSP(float, WS_H); bf16* HN = WSP(bf16, WS_HN);
    f32x4 g4[4];
#pragma unroll
    for (int j = 0; j < 4; ++j) g4[j] = *((const GAS f32x4*)F.g_mlp + lane + 64 * j);
    for (int m = gw; m < MC; m += NGW) {
        const GAS f32x4* xr = (const GAS f32x4*)(H + (size_t)m * DM) + lane;
        f32x4 v[4]; float s = 0.f;
        if (m >= MP) {
            const GAS f32x4* xs = (const GAS f32x4*)(F.x_sample + (size_t)(m - MP) * DM) + lane; const float* HS = WSP(float, WS_HS);
#pragma unroll
            for (int j = 0; j < 4; ++j) { f32x4 a = xs[64 * j];
#pragma unroll
                for (int sl = 0; sl < 4; ++sl) a += *((const GAS f32x4*)(HS + ((size_t)sl * MS + (m - MP)) * DM) + lane + 64 * j);
                v[j] = a; *((GAS f32x4*)(H + (size_t)m * DM) + lane + 64 * j) = a; s += (a.x * a.x + a.y * a.y) + (a.z * a.z + a.w * a.w); }
        } else {
            const GAS v2u* hb = (const GAS v2u*)(WSP(bf16, WS_HB) + (size_t)m * DM) + lane;
#pragma unroll
            for (int j = 0; j < 4; ++j) { const v2u t = __builtin_nontemporal_load(hb + 64 * j); v[j] = (f32x4){bflo(t.x), bfhi(t.x), bflo(t.y), bfhi(t.y)}; s += (v[j].x * v[j].x + v[j].y * v[j].y) + (v[j].z * v[j].z + v[j].w * v[j].w); }
        }
        const float rstd = frsqrt(wave_sum(s) * (1.f / DM) + EPS);
        GAS v2u* o8 = (GAS v2u*)(HN + (size_t)m * DM) + lane;
#pragma unroll
        for (int j = 0; j < 4; ++j) { v2u o; o.x = pk2(v[j].x * rstd * g4[j].x, v[j].y * rstd * g4[j].y); o.y = pk2(v[j].z * rstd * g4[j].z, v[j].w * rstd * g4[j].w); o8[64 * j] = o; }
    }
}

struct Args { const void* in[24]; float* out; unsigned char* ws; int ph_lo, ph_hi; };
#ifdef USE_PG8
#define GEMM_PHASE(EPI) pg8::gemm_phase<EPI, pg8::StaticOrder, PG8_ALIGN, PG8_SP2>
#define SLICE_PHASE(EPI) pg8::gemm_phase<EPI, SliceOrder, PG8_ALIGN, PG8_SP2>
#else
#define GEMM_PHASE(EPI) g2::gemm_phase<EPI, pg8::StaticOrder>
#define SLICE_PHASE(EPI) g2::gemm_phase<EPI, SliceOrder>
#endif
__device__ __forceinline__ int opaque(int v) { asm volatile("" : "+s"(v)); return v; }
__global__ void __launch_bounds__(NWAVES * 64, 2) mk_fwd(Args args) {
    extern __shared__ __attribute__((aligned(16))) unsigned char lds[];
    Frame F;
    F.lds = (LAS unsigned char*)lds;
    F.MISC = (volatile LAS unsigned*)(F.lds + MISC_OFF);
    F.tid = threadIdx.x; F.lane = F.tid & 63; F.wave = __builtin_amdgcn_readfirstlane(F.tid >> 6);
    F.G = gridDim.x; { const int bx = blockIdx.x; F.vcu = (F.G % 8 == 0) ? (bx % 8) * (F.G / 8) + bx / 8 : bx; }
    F.ws = args.ws; F.out = args.out; F.ctl = (gu32*)(args.ws + WS_CTL);
#define INP(k) ((const float*)args.in[opaque(k)])
    for (int u = F.tid; u < (LDS_BYTES - LDSCTL_OFF) / 4; u += NWAVES * 64) ((LAS unsigned*)(F.lds + LDSCTL_OFF))[u] = 0u;
    __syncthreads();
#ifdef ENTRY_FENCE
    if (F.tid == 0) { __builtin_amdgcn_fence(__ATOMIC_ACQ_REL, "agent"); asm volatile("s_waitcnt vmcnt(0)" ::: "memory"); }
    __syncthreads();
#endif
    XcdBarrier bar = xcd_barrier_post((unsigned*)(F.ctl + CW_BAR), F.MISC + 8);
    const int lo = args.ph_lo, hi = args.ph_hi;
#ifndef PHMASK
#define PHMASK 0x3ff
#endif
#define IN(k) ((((PHMASK) >> (k)) & 1) && lo <= (k) && (k) < hi)
#define SEAM(k) do { if (IN(k) && IN((k) + 1)) xcd_barrier(bar); } while (0)
#ifndef REPEAT_PHASE
#define REPEAT_PHASE -1
#endif
#define REP(k) for (int rep_ = 0; rep_ < ((REPEAT_PHASE == (k)) ? 2 : 1); ++rep_, ((REPEAT_PHASE == (k)) && rep_ == 1 ? (xcd_barrier(bar), 0) : 0))
    const int bx = (int)blockIdx.x;
#ifdef STAMP_IDX
    unsigned long long stamp_[16]; int nst_ = 0;
#define STAMP() do { stamp_[nst_ < 15 ? nst_ : 15] = __builtin_amdgcn_s_memrealtime(); ++nst_; } while (0)
    STAMP();
#else
#define STAMP() do { } while (0)
#endif

    if (IN(0)) REP(0) { F.x_prompt = INP(0); F.x_sample = INP(1); F.meta_tokens = INP(6); F.g_attn = INP(7); F.w_in = INP(8); F.w_uq = INP(10); F.w_uk = INP(14); F.w_uv = INP(17); F.w_pool_map = INP(18);
        F.w_o = INP(20); F.w_ff1 = INP(22); F.w_ff2 = INP(23); p0_prologue(F); }
    SEAM(0); STAMP();
    if (IN(1)) REP(1) {
#ifdef TOUCH_P1
        { const size_t gt = (size_t)F.vcu * NWAVES * 64 + F.tid, NGT = (size_t)F.G * NWAVES * 64; unsigned acc_ = 0;
          const GAS v4u* a_ = (const GAS v4u*)WSP(bf16, WS_XN); const GAS v4u* b_ = (const GAS v4u*)WSP(bf16, WS_WIN);
          for (size_t i = gt; i < (size_t)MC * DM / 8; i += NGT) { const v4u v = a_[i]; acc_ += v.x ^ v.y ^ v.z ^ v.w; }
          for (size_t i = gt; i < (size_t)NIN * DM / 8; i += NGT) { const v4u v = b_[i]; acc_ += v.x ^ v.y ^ v.z ^ v.w; }
          if (acc_ == 0x12345678u) F.ctl[8] = acc_; VM_WAIT(); __syncthreads(); }
#endif
#ifdef ZERO_LDS_P1
        for (int u = F.tid; u < 131072 / 16; u += NWAVES * 64) ((LAS v4u*)F.lds)[u] = (v4u){0u, 0u, 0u, 0u};
        __syncthreads();
#endif
#ifdef DELAY_P1
        { const unsigned long long t0 = __builtin_amdgcn_s_memrealtime(); while (__builtin_amdgcn_s_memrealtime() - t0 < 3000000ull) __builtin_amdgcn_s_sleep(8); }
#endif
#ifdef NAIVE_P1
        p1_naive(F);
#else
#ifdef P1_SHAPE_TEST
        pg8::Gemm g{WSP(bf16, WS_XN), WSP(bf16, WS_WIN), MP, 3072, DM}; pg8::StaticOrder S; S.init(MP, 3072, F.G, bx);
#else
        pg8::Gemm g{WSP(bf16, WS_XN), WSP(bf16, WS_WIN), MCX, NIN, DM}; pg8::StaticOrder S; S.init(MCX, NIN, F.G, bx);
#endif
#ifdef SCALAR_EPI
        EpiInProjScalar E{WSP(float, WS_PF), WSP(bf16, WS_GATE)};
        GEMM_PHASE(EpiInProjScalar)(F.lds + RING_OFF, g, S, E);
#else
        EpiInProj E{WSP(float, WS_PF), WSP(bf16, WS_GATE), WSP(bf16, WS_PB)};
        GEMM_PHASE(EpiInProj)(F.lds + RING_OFF, g, S, E);
#endif
#ifdef TWICE_P1
        __syncthreads();
        GEMM_PHASE(EpiInProj)(F.lds + RING_OFF, g, S, E);
#endif
#ifdef TWICE_DUMMY
        __syncthreads();
        { EpiInProj E2{WSP(float, WS_Z), WSP(bf16, WS_H), WSP(bf16, WS_HN)}; GEMM_PHASE(EpiInProj)(F.lds + RING_OFF, g, S, E2); }
#endif
#endif
    }
    SEAM(1); STAMP();
    if (IN(2)) REP(2) { F.g_kv_lat = INP(11); F.g_q_lat = INP(9); F.g_kn_rope = INP(16); F.state_pool = INP(4); p2_rows(F); p2_pool(F); }
    SEAM(2); STAMP();
    if (IN(3)) REP(3)
#ifdef REPEAT_P3
    for (int r3_ = 0, n3_ = opaque(2); r3_ < n3_; ++r3_, (r3_ < n3_ ? (xcd_barrier(bar), 0) : 0))
#endif
    {
        F.w_uk = INP(14); F.w_uv = INP(17); F.g_kn_nope = INP(15); F.pool_scale = INP(19);
#ifndef NO_P3M
#ifdef REPEAT_P3M
        for (int rm_ = 0, nm_ = opaque(2); rm_ < nm_; ++rm_)
#endif
        p3_meta_kv(F);
#endif
#ifdef REPEAT_P3Q
        for (int rq_ = 0, nq_ = opaque(2); rq_ < nq_; ++rq_)
#endif
#ifndef NO_P3Q
        { pg8::Gemm g{WSP(bf16, WS_QL), WSP(bf16, WS_WUQ), MC, 768, opaque(QLORA)}; pg8::StaticOrder S; S.init(MC, 768, F.G, bx);
          EpiPlainBf16 E{WSP(bf16, WS_QR), 768};
          GEMM_PHASE(EpiPlainBf16)(F.lds + RING_OFF, g, S, E); }
        __syncthreads();
#endif
#ifdef STAMP_P3
        STAMP();
#endif
#ifdef REPEAT_P3K
        for (int rk_ = 0, nk_ = opaque(2); rk_ < nk_; ++rk_)
#endif
#ifndef NO_P3K
        { pg8::Gemm g{WSP(bf16, WS_CB), WSP(bf16, WS_WKV), MP, 1536, opaque(KVL)}; pg8::StaticOrder S; S.init(MP, 1536, F.G, bx);
          EpiKV E{WSP(bf16, WS_KH), WSP(bf16, WS_VH), WSP(bf16, WS_KRG), WSP(float, WS_KSS), F.g_kn_nope};
          GEMM_PHASE(EpiKV)(F.lds + RING_OFF, g, S, E); }
        __syncthreads();
#endif
#ifdef STAMP_P3
        STAMP();
#endif
#ifdef REPEAT_P3P
        for (int rp_ = 0, np_ = opaque(2); rp_ < np_; ++rp_)
#endif
#ifndef NO_P3P
        { pg8::Gemm g{WSP(bf16, WS_DP), WSP(bf16, WS_WPL), 4 * MC, DM, opaque(128)}; PoolOrder S{F.G, (F.G == 256) ? ((F.vcu + 116) & 255) : F.vcu};
          EpiPool E{WSP(bf16, WS_PG), WSP(bf16, WS_GATE), F.pool_scale};
          pg8::gemm_phase<EpiPool, PoolOrder, PG8_ALIGN, PG8_SP2>(F.lds + RING_OFF, g, S, E); }
#endif
    }
    SEAM(3); STAMP();
    if (IN(4)) REP(4) {
        F.g_qn_nope = INP(12); F.g_qn_rope = INP(13); F.g_kn_nope = INP(15); F.g_kn_rope = INP(16);
        const float gq = fmaxf(wave_max(fabsf(F.g_qn_nope[F.lane])), wave_max(fabsf(F.g_qn_rope[F.lane & 15])));
        const float gk = fmaxf(wave_max(fabsf(F.g_kn_nope[F.lane])), wave_max(fabsf(F.g_kn_rope[F.lane & 15])));
        const float b2 = (float)QKH * SCALE_L2E * gq * gk;
#ifndef NO_PA
        {
            pa::Ctx C{WSP(bf16, WS_QR), WSP(bf16, WS_KH), WSP(bf16, WS_VH), WSP(bf16, WS_PG), WSP(bf16, WS_GATE), WSP(bf16, WS_AM), WSP(float, WS_ROPE), F.g_qn_nope, F.g_qn_rope, b2};
#ifdef REPEAT_PA
            for (int rpa_ = 0, npa_ = opaque(2); rpa_ < npa_; ++rpa_)
#endif
            for (int pr0 = F.vcu * 2; pr0 < 512; pr0 += 2 * F.G) {
#pragma unroll 1
                for (int k = 0; k < 4; ++k) {
                    const int pr = pr0 + (k >> 1); const int bh = pr >> 2, p = pr & 3, j = (k & 1) ? 7 - p : p;
                    pa::unit(C, bh >> 3, bh & 7, j, (char*)lds, F.lds);
                }
            }
        }
#endif
        STAMP();
#ifndef NO_SA
        {
            sa::Ctx C{INP(2), INP(3), (const int*)INP(5), F.out + O_CS, F.out + O_KRS, WSP(bf16, WS_QR), WSP(bf16, WS_WUK), WSP(float, WS_ROPE), F.g_qn_nope, F.g_qn_rope, F.g_kn_nope, F.g_kn_rope,
                      WSP(float, WS_SAC), WSP(float, WS_SAL), b2};
#ifdef REPEAT_SA
            for (int rsa_ = 0, nsa_ = opaque(2); rsa_ < nsa_; ++rsa_)
#endif
            for (int it = F.vcu; it < 256; it += F.G) sa::item(C, it >> 1, it & 1, F.lds);
        }
#endif
    }
    SEAM(4); STAMP();
    if (IN(5)) REP(5) {
        for (int u = F.vcu; u < 256; u += F.G) p5_unit(F, u >> 5, u & 31);
        F.w_o = INP(20); F.w_ff1 = INP(22); F.w_ff2 = INP(23); p0_weights(F, 0, P0_LATE_ITEMS, F.vcu * NWAVES + F.wave, F.G * NWAVES);
    }
    SEAM(5); STAMP();
    if (IN(6)) REP(6) {
        { pg8::Gemm g{WSP(bf16, WS_AM), WSP(bf16, WS_WO), MP, DM, opaque(DM)}; pg8::StaticOrder S; S.init(MP, DM, F.G, bx);
          EpiResToBf16 E{WSP(bf16, WS_HB), INP(0)};
          GEMM_PHASE(EpiResToBf16)(F.lds + RING_OFF, g, S, E); }
        __syncthreads();
        { pg8::Gemm g{WSP(bf16, WS_AMS), WSP(bf16, WS_WOS), 4 * MS, 4 * DM, opaque(256)}; SliceOrder S{4, F.G, F.vcu};
          EpiSlab E{WSP(float, WS_HS)};
          SLICE_PHASE(EpiSlab)(F.lds + RING_OFF, g, S, E); }
    }
    SEAM(6); STAMP();
    if (IN(7)) REP(7) { F.g_mlp = INP(21); F.x_sample = INP(1); p7_hn(F); }
    SEAM(7); STAMP();
    if (IN(8)) REP(8) {
        pg8::Gemm g{WSP(bf16, WS_HN), WSP(bf16, WS_W1), MC, DFF, opaque(DM)}; pg8::StaticOrder S; S.init(MC, DFF, F.G, bx);
        EpiRelu2 E{WSP(bf16, WS_Z), WSP(bf16, WS_ZS)};
#ifdef CLKP8
        const unsigned long long ck0_ = __builtin_amdgcn_s_memtime(), rt0_ = __builtin_amdgcn_s_memrealtime();
#endif
        GEMM_PHASE(EpiRelu2)(F.lds + RING_OFF, g, S, E);
#ifdef CLKP8
        { const unsigned long long ck1_ = __builtin_amdgcn_s_memtime(), rt1_ = __builtin_amdgcn_s_memrealtime();
          if (F.tid == 0) WSP(float, WS_CTL + 524288)[blockIdx.x] = (CLKP8 == 1) ? (float)(ck1_ - ck0_) / (float)(rt1_ - rt0_) * 3.f : (float)(rt1_ - rt0_) * 0.002f; }
#endif
    }
    SEAM(8); STAMP();
    if (IN(9)) REP(9) {
#ifdef REPEAT_P9M
        for (int r9_ = 0, n9_ = opaque(2); r9_ < n9_; ++r9_, __syncthreads())
#endif
        { pg8::Gemm g{WSP(bf16, WS_Z), WSP(bf16, WS_W2), MP, DM, opaque(DFF)}; pg8::StaticOrder S; S.init(MP, DM, F.G, bx);
          EpiResFromBf16 E{F.out + O_YP, WSP(bf16, WS_HB)};
          GEMM_PHASE(EpiResFromBf16)(F.lds + RING_OFF, g, S, E); }
        __syncthreads();
#ifdef REPEAT_P9T
        for (int r9_ = 0, n9_ = opaque(2); r9_ < n9_; ++r9_, __syncthreads())
#endif
        { pg8::Gemm g{WSP(bf16, WS_ZS), WSP(bf16, WS_W2S), 8 * MS, 8 * DM, opaque(512)}; SliceOrder S{8, F.G, F.vcu};
          EpiSlab E{WSP(float, WS_YS)};
          SLICE_PHASE(EpiSlab)(F.lds + RING_OFF, g, S, E); }
        xcd_barrier(bar);
        {
            const float* H = WSP(float, WS_H); const float* YS = WSP(float, WS_YS);
            for (size_t e = (size_t)F.vcu * NWAVES * 64 + F.tid; e < (size_t)MS * DM / 4; e += (size_t)F.G * NWAVES * 64) {
                f32x4 a = *((const GAS f32x4*)(H + (size_t)MP * DM) + e);
#pragma unroll
                for (int sl = 0; sl < 8; ++sl) a += *((const GAS f32x4*)(YS + (size_t)sl * MS * DM) + e);
                *((GAS f32x4*)(F.out + O_YS) + e) = a; }
        }
    }
#if defined(CLKPROBE) || defined(SEGPROBE) || defined(CLKP8)
#ifndef CLKPROBE
#define CLKPROBE 0
#endif
    if (IN(9)) { xcd_barrier(bar); if (blockIdx.x == 0 && F.tid == 0) F.out[0] = WSP(float, WS_CTL + 524288)[CLKPROBE]; }
#endif
#ifdef ENTRY_FENCE
    asm volatile("s_waitcnt vmcnt(0)" ::: "memory"); __syncthreads();
    if (F.tid == 0) { __builtin_amdgcn_fence(__ATOMIC_RELEASE, "agent"); asm volatile("s_waitcnt vmcnt(0)" ::: "memory"); }
    __syncthreads();
#endif
#ifdef TAG_SMALL
    if (IN(9)) {
        xcd_barrier(bar);
        const size_t gt = (size_t)F.vcu * NWAVES * 64 + F.tid, NGT = (size_t)F.G * NWAVES * 64;
        for (size_t i = O_CP + gt; i < O_END; i += NGT) F.out[i] *= (float)(TAG_SMALL);
    }
#endif
#ifdef CHECK_C
    if (IN(9)) {
        xcd_barrier(bar);
        if (blockIdx.x == 0) {
            const float* xp = INP(0); const float* mt = INP(6); const float* ga = INP(7); const float* win = INP(8); const float* gk = INP(11);
            LAS float* res = (LAS float*)F.lds;
            if (F.wave < 4) {
                const int b = (F.wave == 0) ? 2 : (F.wave == 1 ? 1 : (F.wave == 2 ? 15 : 0));
                const int t = (F.wave == 0) ? 3 : (F.wave == 1 ? 116 : (F.wave == 2 ? 2063 : 16));
                const float* xr = t < 16 ? mt + (size_t)t * DM : xp + ((size_t)b * SEQ + (t - 16)) * DM;
                float ss = 0.f; for (int k = F.lane; k < DM; k += 64) ss += xr[k] * xr[k];
                const float rs = frsqrt(wave_sum(ss) / DM + EPS);
                float c[4] = {0.f, 0.f, 0.f, 0.f};
                for (int k = 0; k < DM; ++k) { const float xn = xr[k] * rs * ga[k];
                    for (int j = 0; j < 4; ++j) c[j] += xn * win[(size_t)k * DIN + 896 + F.lane * 4 + j]; }
                float s2 = c[0] * c[0] + c[1] * c[1] + c[2] * c[2] + c[3] * c[3];
                const float r2 = frsqrt(wave_sum(s2) / KVL + EPS);
                float err = 0.f, refn = 0.f;
                for (int j = 0; j < 4; ++j) { const float ref = c[j] * r2 * gk[F.lane * 4 + j]; const float got = F.out[O_CP + ((size_t)b * TT + t) * KVL + F.lane * 4 + j]; err += (got - ref) * (got - ref); refn += ref * ref; }
                err = wave_sum(err); refn = wave_sum(refn);
                if (F.lane == 0) res[F.wave] = (err > 0.0004f * refn) ? 1.f : 0.f;
            }
            __syncthreads();
            if (F.tid == 0) F.out[O_YP] = 1000.f * (1.f + res[0] + 2.f * res[1] + 4.f * res[2] + 8.f * res[3]);
        }
    }
#endif
#ifdef CHECK_PFM
    if (IN(9)) {
        xcd_barrier(bar);
        if (blockIdx.x == 0) {
            const float* mt = INP(6); const float* ga = INP(7); const float* win = INP(8);
            LAS float* res = (LAS float*)F.lds;
            if (F.wave < 4) {
                const int n = (F.wave == 0) ? 5 : (F.wave == 1 ? 300 : (F.wave == 2 ? 1160 : 200));
                const int col = n < 256 ? 896 + n : (n < 768 ? n - 256 : n);
                const float* xr = mt + (size_t)3 * DM;
                float ss = 0.f; for (int k = F.lane; k < DM; k += 64) ss += xr[k] * xr[k];
                const float rs = frsqrt(wave_sum(ss) / DM + EPS);
                float a = 0.f; for (int k = F.lane; k < DM; k += 64) a += xr[k] * rs * ga[k] * win[(size_t)k * DIN + col];
                a = wave_sum(a);
#if CHECK_PFM == 2
                { const bf16* XNM_ = WSP(bf16, WS_XNM); const bf16* W_ = WSP(bf16, WS_WIN); float a2 = 0.f;
                  for (int k = F.lane; k < DM; k += 64) a2 += bflo((unsigned)XNM_[3 * DM + k]) * bflo((unsigned)W_[(size_t)n * DM + k]);
                  a = wave_sum(a2); }
#elif CHECK_PFM == 3
                { const bf16* XNM_ = WSP(bf16, WS_XNM); float a2 = 0.f;
                  for (int k = F.lane; k < DM; k += 64) a2 += fabsf(bflo((unsigned)XNM_[3 * DM + k]) - xr[k] * rs * ga[k]);
                  a = wave_sum(a2); }
#endif
                const float got = (CHECK_PFM == 3) ? 0.f : WSP(float, WS_PFM)[3 * PFW + n];
                if (F.lane == 0) res[F.wave] = (fabsf(got - a) > 0.03f * fabsf(a) + 0.02f) ? 1.f : 0.f;
            }
            __syncthreads();
            if (F.tid == 0) F.out[O_YP] = 1000.f * (1.f + res[0] + 2.f * res[1] + 4.f * res[2] + 8.f * res[3]);
        }
    }
#endif
#ifdef CHECK_S
    if (IN(9)) {
        xcd_barrier(bar);
        if (blockIdx.x == 0) {
            const float* xp = INP(0); const float* xs = INP(1); const float* sp = INP(4); const float* mt = INP(6); const float* ga = INP(7); const float* win = INP(8); const float* gk = INP(11);
            LAS float* res = (LAS float*)F.lds;
            if (F.wave < 4) {
                const int w = F.wave + 4 * (CHECK_S - 1);
                const int kind = (w == 2 || w == 3 || w == 6 || w == 5) ? 1 : 0;
                const int b = (w == 0) ? 2 : (w == 1 ? 1 : (w == 2 ? 5 : (w == 3 ? 5 : (w == 4 ? 3 : (w == 5 ? 9 : (w == 6 ? 9 : 0))))));
                const int t = (w == 0) ? 3 : (w == 1 ? 116 : (w == 2 ? 3 : (w == 3 ? 3 : (w == 4 ? 2056 : (w == 5 ? 0 : (w == 6 ? 3 : 0))))));
                const float* xr = kind ? xs + ((size_t)b * DSEQ + t) * DM : (t < 16 ? mt + (size_t)t * DM : xp + ((size_t)b * SEQ + (t - 16)) * DM);
                const int pos = kind ? PAST + t : t;
                float ss = 0.f; for (int k = F.lane; k < DM; k += 64) ss += xr[k] * xr[k];
                const float rs = frsqrt(wave_sum(ss) / DM + EPS);
                float err = 0.f, refn = 0.f;
                if (w <= 2) {
                    float a1 = 0.f, a2 = 0.f; const int i = F.lane & 15;
                    for (int k = 0; k < DM; ++k) { const float xn = xr[k] * rs * ga[k]; a1 += xn * win[(size_t)k * DIN + 1152 + i]; a2 += xn * win[(size_t)k * DIN + 1168 + i]; }
                    const double ang = (double)pos * ROPE_INV[i]; const float cs = (float)cos(ang), sn = (float)sin(ang);
                    const float o1 = a1 * cs - a2 * sn, o2 = a2 * cs + a1 * sn;
                    const float* gp = kind ? F.out + O_KRS + ((size_t)b * DSEQ + t) * QKR : F.out + O_KRP + ((size_t)b * TT + t) * QKR;
                    if (F.lane < 16) { err = (gp[i] - o1) * (gp[i] - o1) + (gp[16 + i] - o2) * (gp[16 + i] - o2); refn = o1 * o1 + o2 * o2; }
                } else if (w == 3 || w == 5) {
                    float c[4] = {0.f, 0.f, 0.f, 0.f};
                    for (int k = 0; k < DM; ++k) { const float xn = xr[k] * rs * ga[k]; for (int j = 0; j < 4; ++j) c[j] += xn * win[(size_t)k * DIN + 896 + F.lane * 4 + j]; }
                    const float r2 = frsqrt(wave_sum(c[0] * c[0] + c[1] * c[1] + c[2] * c[2] + c[3] * c[3]) / KVL + EPS);
                    for (int j = 0; j < 4; ++j) { const float ref = c[j] * r2 * gk[F.lane * 4 + j]; const float got = F.out[O_CS + ((size_t)b * DSEQ + t) * KVL + F.lane * 4 + j]; err += (got - ref) * (got - ref); refn += ref * ref; }
                } else if (w == 4 || w == 6) {
                    float u[8] = {0.f, 0.f, 0.f, 0.f, 0.f, 0.f, 0.f, 0.f};
                    for (int k = 0; k < DM; ++k) { const float xn = xr[k] * rs * ga[k]; for (int j = 0; j < 8; ++j) u[j] += xn * win[(size_t)k * DIN + F.lane * 8 + j]; }
                    const float* gp = (w == 4) ? F.out + O_PSP + ((size_t)b * 15 + (t - 2049)) * PW : F.out + O_PSS + ((size_t)b * 15 + 7 + t) * PW;
                    for (int j = 0; j < 8; ++j) { const float got = gp[F.lane * 8 + j]; err += (got - u[j]) * (got - u[j]); refn += u[j] * u[j]; }
                } else if (w == 55) {
                    for (int j = 0; j < 8; ++j) { const float ref = sp[((size_t)b * 15 + 8 + 2) * PW + F.lane * 8 + j]; const float got = F.out[O_PSS + ((size_t)b * 15 + 2) * PW + F.lane * 8 + j]; err += (got - ref) * (got - ref); refn += ref * ref; }
                } else if (w == 7) {
                    const bf16* W_ = WSP(bf16, WS_WIN);
                    for (int j = 0; j < 8; ++j) { const int n = F.lane * 8 + j;
                        for (int k = 0; k < DM; ++k) { const float ref = win[(size_t)k * DIN + n], got = bflo((unsigned)W_[(size_t)(256 + n) * DM + k]); err += (got - ref) * (got - ref); refn += ref * ref; } }
                } else { err = 0.f; refn = 1.f; }
                err = wave_sum(err); refn = wave_sum(refn);
#ifdef CHECK_MAG
                if (F.lane == 0) res[F.wave] = floorf(200.f * sqrtf(err / refn) + 0.5f);
            }
            __syncthreads();
            if (F.tid == 0) F.out[O_YP] = 1000.f * (1.f + res[CHECK_MAG]);
#else
                if (F.lane == 0) res[F.wave] = (err > 0.0004f * refn) ? 1.f : 0.f;
            }
            __syncthreads();
            if (F.tid == 0) F.out[O_YP] = 1000.f * (1.f + res[0] + 2.f * res[1] + 4.f * res[2] + 8.f * res[3]);
#endif
        }
    }
#endif
#ifdef ZERO_META_C
    if (IN(9)) {
        xcd_barrier(bar);
        const size_t gt = (size_t)F.vcu * NWAVES * 64 + F.tid, NGT = (size_t)F.G * NWAVES * 64;
        for (size_t i = gt; i < (size_t)NBATCH * NMETA * KVL; i += NGT) { const size_t b = i / (NMETA * KVL), r = i % (NMETA * KVL); F.out[O_CP + b * TT * KVL + r] = 0.f; }
    }
#endif
#ifdef TAG_Y
    if (IN(9)) {
        xcd_barrier(bar);
        const size_t gt = (size_t)F.vcu * NWAVES * 64 + F.tid, NGT = (size_t)F.G * NWAVES * 64;
        for (size_t i = TAG_Y_LO + gt; i < TAG_Y_HI; i += NGT) F.out[i] *= 1.3f;
    }
#endif
#if defined(DUMP) && DUMP == 99
    if (lo <= 10 && 10 < hi) {
        unsigned e1 = 0, e2 = 0, e3 = 0;
        LAS unsigned* L = (LAS unsigned*)F.lds;
        for (int r = 0; r < 200; ++r) {
            const int slot = (F.tid * 33 + r * 4099) & 32767;
            L[F.tid + 512 * (r & 63)] = (unsigned)(F.tid * 2654435761u + r);
            __syncthreads();
            const int o = (F.tid + 257) & 511;
            if (L[o + 512 * (r & 63)] != (unsigned)(o * 2654435761u + r)) ++e1;
            __syncthreads();
            (void)slot;
        }
        {
            const int fr = F.lane & 15, fq = F.lane >> 4;
            pg8::bf16x8 a, b;
            for (int j = 0; j < 8; ++j) { const int k = 8 * fq + j; a[j] = (short)f2bf((float)((fr + k) % 5 - 2)); b[j] = (short)f2bf((float)((k * 3 + fr) % 7 - 3)); }
            pg8::f32x4 d = (pg8::f32x4){0.f, 0.f, 0.f, 0.f};
            for (int rep = 0; rep < 64; ++rep) d = __builtin_amdgcn_mfma_f32_16x16x32_bf16(a, b, d, 0, 0, 0);
            for (int e = 0; e < 4; ++e) { const int i = 4 * fq + e, jj = fr; float s = 0.f; for (int k = 0; k < 32; ++k) s += (float)((i + k) % 5 - 2) * (float)((k * 3 + jj) % 7 - 3);
                if (d[e] != 64.f * s) ++e2; }
        }
        if (blockDim.x != 512 || gridDim.x != 256 || blockDim.y != 1 || gridDim.y != 1) e3 = 1;
        unsigned e4 = 0, e5 = 0, e6 = 0;
        { const float v = (float)(F.lane + 1); if (wave_sum(v) != 2080.f) e4 = 1;
          const int row = F.lane >> 4; const float want16 = (float)(16 * (16 * row) + 136);
          if (sum_row16(v) != want16) e5 = 1;
          if (wave_max(v) != 64.f) e6 = 1; }
        const float code = (e1 ? 1000.f : 0.f) + (e2 ? 2000.f : 0.f) + (e3 ? 4000.f : 0.f) + (e4 ? 8000.f : 0.f) + (e5 ? 16000.f : 0.f) + (e6 ? 32000.f : 0.f) + 500.f;
#ifdef PROBE_VAL
        { const float v = (float)(F.lane + 1); float r_ = 0.f;
          if (PROBE_VAL == 1) r_ = wave_sum(v); else if (PROBE_VAL == 2) r_ = sum_x16(v); else if (PROBE_VAL == 3) r_ = sum_x32(v); else if (PROBE_VAL == 4) r_ = sum_x16(sum_row16(v)); else if (PROBE_VAL == 5) r_ = sum_x32(sum_row16(v));
          const int pl = PROBE_LANE;
          const float got = __shfl(r_, pl);
          for (int i = F.tid; i < 4096; i += 512) F.out[O_YP + (size_t)blockIdx.x * 4096 + i] = 10.f * got; }
#else
        for (int i = F.tid; i < 4096; i += 512) F.out[O_YP + (size_t)blockIdx.x * 4096 + i] = code;
#endif
    }
#elif defined(DUMP)
    if (lo <= 10 && 10 < hi) {
        const size_t gt = (size_t)F.vcu * NWAVES * 64 + F.tid, NGT = (size_t)F.G * NWAVES * 64;
        for (size_t i = gt; i < (size_t)MP * DM; i += NGT) {
            float v = 0.f;
#if DUMP == 1
            v = WSP(float, WS_PF)[i % ((size_t)MC * PFW)] + bflo((unsigned)WSP(bf16, WS_GATE)[i]) + bflo((unsigned)WSP(bf16, WS_GATE)[i + (size_t)MP * DM]);
#elif DUMP == 99
            v = 0.f;
#elif DUMP == 7
            v = bflo((unsigned)WSP(bf16, WS_XN)[i]) + bflo((unsigned)WSP(bf16, WS_WIN)[i % ((size_t)NIN * DM)]) + bflo((unsigned)WSP(bf16, WS_W1)[i % ((size_t)DFF * DM)]) + bflo((unsigned)WSP(bf16, WS_W2)[i % ((size_t)DFF * DM)])
              + bflo((unsigned)WSP(bf16, WS_WO)[i % ((size_t)DM * DM)]) + bflo((unsigned)WSP(bf16, WS_WKV)[i % ((size_t)1536 * 256)]) + bflo((unsigned)WSP(bf16, WS_WUK)[i % ((size_t)512 * 256)])
              + bflo((unsigned)WSP(bf16, WS_WPL)[i % ((size_t)1024 * 512)]) + bflo((unsigned)WSP(bf16, WS_WUQ)[i % ((size_t)768 * 384)]) + WSP(float, WS_ROPE)[i % (size_t)(2072 * 32)] + bflo((unsigned)WSP(bf16, WS_XNM)[i % (size_t)(16 * 1024)]);
#elif DUMP == 2
            v = bflo((unsigned)WSP(bf16, WS_CB)[i % ((size_t)MC * 256)]) + bflo((unsigned)WSP(bf16, WS_QL)[i % ((size_t)MC * 384)]) + bflo((unsigned)WSP(bf16, WS_DP)[i % ((size_t)MC * 512)])
              + bflo((unsigned)WSP(bf16, WS_KRG)[i % ((size_t)RB * 32)]) + WSP(float, WS_KSS)[i % (size_t)RB];
#elif DUMP == 3
            v = bflo((unsigned)WSP(bf16, WS_QR)[i % ((size_t)MC * 768)]) + bflo((unsigned)WSP(bf16, WS_KH)[i % ((size_t)RB * 768)]) + bflo((unsigned)WSP(bf16, WS_VH)[i % ((size_t)RB * 1024)]) + bflo((unsigned)WSP(bf16, WS_PG)[i]);
#elif DUMP == 4
            v = bflo((unsigned)WSP(bf16, WS_AM)[i]) + WSP(float, WS_SAC)[i % ((size_t)256 * 64 * 256)] + WSP(float, WS_SAL)[i % (size_t)(256 * 64)];
#elif DUMP == 5
            v = bflo((unsigned)WSP(bf16, WS_AM)[i + (size_t)MS * DM]);
#elif DUMP == 6
            v = WSP(float, WS_H)[i + (size_t)MS * DM];
#endif
            F.out[O_YP + i] = v;
        }
    }
#endif
#ifdef STAMP_IDX
    STAMP();
    if (blockIdx.x == 0 && F.tid == 0) { const unsigned long long d_ = stamp_[STAMP_IDX + 1] - stamp_[STAMP_IDX]; F.out[O_YP] = (float)d_ * 0.001f;     }
#endif
#undef IN
#undef SEAM
}

#ifndef MK_N_LAUNCHES
#define MK_N_LAUNCHES 1
#endif
extern "C" void kernel_launch(void* const* d_in, const int* in_sizes, int n_in, void* d_out, int out_size, void* d_ws, size_t ws_size, hipStream_t stream) {
    static int grid = 0;
    if (grid == 0) {
        if (n_in != 24 || out_size != (int)O_END || ws_size < WS_END) { fprintf(stderr, "kernel_launch: unexpected shapes (n_in %d out %d ws %zu need %zu); nothing launched\n", n_in, out_size, ws_size, (size_t)WS_END); grid = -1; return; }
        int dev = 0, cus = 0, per_cu = 0;
        if (hipGetDevice(&dev) != hipSuccess || hipDeviceGetAttribute(&cus, hipDeviceAttributeMultiprocessorCount, dev) != hipSuccess) { grid = -1; return; }
        if (hipFuncSetAttribute((const void*)mk_fwd, hipFuncAttributeMaxDynamicSharedMemorySize, LDS_BYTES) != hipSuccess) { fprintf(stderr, "kernel_launch: hipFuncSetAttribute failed\n"); grid = -1; return; }
        if (hipOccupancyMaxActiveBlocksPerMultiprocessor(&per_cu, (const void*)mk_fwd, NWAVES * 64, LDS_BYTES) != hipSuccess || per_cu < 1) { fprintf(stderr, "kernel_launch: occupancy query says %d blocks per CU\n", per_cu); }
        (void)hipGetLastError();
        grid = cus;
    }
    if (grid < 0) return;
    if (hipMemsetAsync((char*)d_ws + WS_CTL, 0, 32768, stream) != hipSuccess) return;
    Args a{};
    for (int i = 0; i < 24; ++i) a.in[i] = d_in[i];
    a.out = (float*)d_out; a.ws = (unsigned char*)d_ws;
#if MK_N_LAUNCHES == 1
#ifdef DUMP
    a.ph_lo = 0; a.ph_hi = 11;
#else
    a.ph_lo = 0; a.ph_hi = 10;
#endif
    hipLaunchKernelGGL(mk_fwd, dim3(grid), dim3(NWAVES * 64), LDS_BYTES, stream, a);
#else
#ifdef DUMP
    constexpr int NPH = 11;
#else
    constexpr int NPH = 10;
#endif
    for (int p = 0; p < NPH; ++p) { a.ph_lo = p; a.ph_hi = p + 1; hipLaunchKernelGGL(mk_fwd, dim3(grid), dim3(NWAVES * 64), LDS_BYTES, stream, a); }
#endif
}
```
